# Optimizing an MI355X kernel written in HIP

```python
import math
import jax, jax.numpy as jnp
from jax import lax
import numpy as np

D_MODEL = 1024
BATCH = 2
SEQ = 16384
DEPTH = 1
DEC_BATCH = 32
DEC_SEQ = 64
PAST_LEN = 1024

CHUNK = 64
N_META = 16
N_HEADS = 8
Q_LORA = 384
KV_LORA = 256
QK_NOPE = 128
QK_ROPE = 64
V_HEAD = 128
ATTN_WIDTH = N_HEADS * V_HEAD
POOL_WINDOWS = (2, 4, 8, 16)
N_POOL_GROUPS = 4
POOL_GROUP = 128
D_POOL = N_POOL_GROUPS * POOL_GROUP
POOL_HIST = max(POOL_WINDOWS) - 1
D_FF = 4 * D_MODEL
D_IN = Q_LORA + KV_LORA + QK_ROPE + D_POOL + 2 * D_MODEL
ROPE_BASE = 10000.0
EPS = 1e-6
Q_BLOCK = 128
SM_SCALE = (QK_NOPE + QK_ROPE) ** -0.5
NEG_INF = -1e30

kernel_name = 'mla_pool_gated_hybrid_stream_step'


def rmsnorm(x, g):
    xf = x.astype(jnp.float32)
    y = xf * lax.rsqrt(jnp.mean(xf * xf, axis=-1, keepdims=True) + EPS)
    return (y * g.astype(jnp.float32)).astype(x.dtype)


def rope(x, pos):
    half = QK_ROPE // 2
    inv_freq = jnp.exp(-math.log(ROPE_BASE) * jnp.arange(half, dtype=jnp.float32) / half)
    ang = pos.astype(jnp.float32)[:, None] * inv_freq[None, :]
    cos = jnp.cos(ang)[:, None, :]
    sin = jnp.sin(ang)[:, None, :]
    xf = x.astype(jnp.float32)
    x1, x2 = xf[..., :half], xf[..., half:]
    return jnp.concatenate([x1 * cos - x2 * sin, x1 * sin + x2 * cos], axis=-1).astype(x.dtype)


def mixer_inputs(xn, pos, w_in, g_kv):
    z = xn @ w_in
    idx = np.cumsum([Q_LORA, KV_LORA, QK_ROPE, D_POOL]).tolist()
    q_lat, kv_lat, k_raw, u_pool, gate_logits = jnp.split(z, idx, axis=-1)
    c_kv = rmsnorm(kv_lat, g_kv)
    k_pe = rope(k_raw[:, :, None, :], pos)[:, :, 0, :]
    return q_lat, c_kv, k_pe, u_pool, gate_logits


def queries(q_lat, pos, g_q, w_q_up, w_uk):
    B, T, _ = q_lat.shape
    q = (rmsnorm(q_lat, g_q) @ w_q_up).reshape(B, T, N_HEADS, QK_NOPE + QK_ROPE)
    q_abs = jnp.einsum('bthn,chn->bthc', q[..., :QK_NOPE], w_uk)
    q_pe = rope(q[..., QK_NOPE:], pos)
    return q_abs, q_pe


def attend(q_abs, q_pe, c_kv, k_pe, w_uv, mask=None):
    s = (jnp.einsum('bqhc,bkc->bhqk', q_abs, c_kv)
         + jnp.einsum('bqhr,bkr->bhqk', q_pe, k_pe)).astype(jnp.float32) * SM_SCALE
    if mask is not None:
        s = jnp.where(mask, s, NEG_INF)
    p = jax.nn.softmax(s, axis=-1).astype(c_kv.dtype)
    o_lat = jnp.einsum('bhqk,bkc->bqhc', p, c_kv)
    return jnp.einsum('bqhc,chv->bqhv', o_lat, w_uv)


def attention_prompt(q_abs, q_pe, c_kv, k_pe, w_uv, with_meta):
    B, L, _ = c_kv.shape
    n_frames = L - N_META
    key_chunk = jnp.concatenate([jnp.full((N_META,), -1, jnp.int32),
                                 jnp.arange(n_frames, dtype=jnp.int32) // CHUNK])
    q_off = N_META if with_meta else 0

    def block(i):
        start = q_off + i * Q_BLOCK
        qa = lax.dynamic_slice_in_dim(q_abs, start, Q_BLOCK, axis=1)
        qp = lax.dynamic_slice_in_dim(q_pe, start, Q_BLOCK, axis=1)
        q_chunk = (i * Q_BLOCK + jnp.arange(Q_BLOCK, dtype=jnp.int32)) // CHUNK
        mask = key_chunk[None, :] <= q_chunk[:, None]
        return attend(qa, qp, c_kv, k_pe, w_uv, mask)

    o = lax.map(block, jnp.arange(n_frames // Q_BLOCK, dtype=jnp.int32))
    o = jnp.moveaxis(o, 0, 1).reshape(B, n_frames, N_HEADS, V_HEAD)
    if with_meta:
        o_meta = attend(q_abs[:, :N_META], q_pe[:, :N_META], c_kv[:, :N_META], k_pe[:, :N_META], w_uv)
        o = jnp.concatenate([o_meta, o], axis=1)
    return o


def multiscale_pool(u_ext, n_hist, n_out, w_pool_grp, pool_scale):
    B, total, _ = u_ext.shape
    uf = u_ext.astype(jnp.float32)
    cs = jnp.concatenate([jnp.zeros((B, 1, D_POOL), jnp.float32), jnp.cumsum(uf, axis=1)], axis=1)
    j = jnp.arange(total - n_out, total, dtype=jnp.int32) - POOL_HIST
    outs = []
    for g, w in enumerate(POOL_WINDOWS):
        sl = slice(g * POOL_GROUP, (g + 1) * POOL_GROUP)
        win_sum = cs[:, total - n_out + 1:total + 1, sl] - cs[:, total - n_out + 1 - w:total + 1 - w, sl]
        cnt = jnp.minimum(w, n_hist + j + 1).astype(jnp.float32)
        outs.append(win_sum / cnt[None, :, None] - uf[:, total - n_out:, sl])
    pooled = jnp.stack(outs, axis=2).astype(u_ext.dtype)
    mixed = jnp.einsum('btgc,gcd->btgd', pooled, w_pool_grp)
    return mixed.reshape(B, n_out, D_POOL) * pool_scale


def merge_and_ffn(h, o_attn, pooled, gate_logits, w_attn_br, w_pool_br, w_out, g_norm_ffn, w_up, w_down):
    B, T, _ = h.shape
    a = o_attn.reshape(B, T, ATTN_WIDTH) @ w_attn_br
    p = pooled @ w_pool_br
    gates = jax.nn.sigmoid(gate_logits.astype(jnp.float32)).astype(h.dtype)
    g_a, g_p = gates[..., :D_MODEL], gates[..., D_MODEL:]
    h = h + (g_a * a + g_p * p) @ w_out
    hn = rmsnorm(h, g_norm_ffn)
    return h + jnp.square(jax.nn.relu(hn @ w_up)) @ w_down


def setup_inputs(seed: int = 0) -> dict:
    key = jax.random.key(seed)
    ks = jax.random.split(key, 24)
    nrm = lambda k, shape, s=1.0: jax.random.normal(k, shape, jnp.float32) * s
    gain = lambda k, shape: 1.0 + 0.1 * jax.random.normal(k, shape, jnp.float32)
    return {
        'x_prompt': nrm(ks[0], (BATCH, SEQ, D_MODEL)),
        'x_sample': nrm(ks[1], (DEC_BATCH, DEC_SEQ, D_MODEL)),
        'cache_kv_latent': nrm(ks[2], (DEPTH, DEC_BATCH, PAST_LEN, KV_LORA)),
        'cache_k_rope': nrm(ks[3], (DEPTH, DEC_BATCH, PAST_LEN, QK_ROPE)),
        'cache_pool': nrm(ks[4], (DEPTH, DEC_BATCH, POOL_HIST, D_POOL)),
        'meta_tokens': nrm(ks[5], (N_META, D_MODEL)),
        'w_in': nrm(ks[6], (DEPTH, D_MODEL, D_IN), D_MODEL ** -0.5),
        'g_norm_mix': gain(ks[7], (DEPTH, D_MODEL)),
        'g_q': gain(ks[8], (DEPTH, Q_LORA)),
        'g_kv': gain(ks[9], (DEPTH, KV_LORA)),
        'w_q_up': nrm(ks[10], (DEPTH, Q_LORA, N_HEADS * (QK_NOPE + QK_ROPE)), Q_LORA ** -0.5),
        'w_uk': nrm(ks[11], (DEPTH, KV_LORA, N_HEADS, QK_NOPE), KV_LORA ** -0.5),
        'w_uv': nrm(ks[12], (DEPTH, KV_LORA, N_HEADS, V_HEAD), KV_LORA ** -0.5),
        'w_attn_br': nrm(ks[13], (DEPTH, ATTN_WIDTH, D_MODEL), ATTN_WIDTH ** -0.5),
        'w_pool_grp': nrm(ks[14], (DEPTH, N_POOL_GROUPS, POOL_GROUP, POOL_GROUP), POOL_GROUP ** -0.5),
        'pool_scale': gain(ks[15], (DEPTH, D_POOL)),
        'w_pool_br': nrm(ks[16], (DEPTH, D_POOL, D_MODEL), D_POOL ** -0.5),
        'w_out': nrm(ks[17], (DEPTH, D_MODEL, D_MODEL), D_MODEL ** -0.5),
        'g_norm_ffn': gain(ks[18], (DEPTH, D_MODEL)),
        'w_up': nrm(ks[19], (DEPTH, D_MODEL, D_FF), D_MODEL ** -0.5),
        'w_down': nrm(ks[20], (DEPTH, D_FF, D_MODEL), D_FF ** -0.5),
        'g_final': gain(ks[21], (D_MODEL,)),
    }


def reference(x_prompt, x_sample, cache_kv_latent, cache_k_rope, cache_pool, meta_tokens,
              w_in, g_norm_mix, g_q, g_kv, w_q_up, w_uk, w_uv, w_attn_br, w_pool_grp,
              pool_scale, w_pool_br, w_out, g_norm_ffn, w_up, w_down, g_final):
    B, S, _ = x_prompt.shape
    Bd, T, _ = x_sample.shape
    past = cache_kv_latent.shape[2]
    hp = jnp.concatenate([jnp.broadcast_to(meta_tokens[None], (B, N_META, D_MODEL)).astype(x_prompt.dtype),
                          x_prompt], axis=1)
    pos_p = jnp.arange(N_META + S, dtype=jnp.int32)
    hs = x_sample
    pos_s = past + jnp.arange(T, dtype=jnp.int32)
    c_p, pe_p, pool_p, c_s, pe_s, pool_s = [], [], [], [], [], []
    for l in range(DEPTH):
        last = l == DEPTH - 1
        r = N_META if last else 0
        xn = rmsnorm(hp, g_norm_mix[l])
        q_lat, c_kv, k_pe, u_pool, gate_logits = mixer_inputs(xn, pos_p, w_in[l], g_kv[l])
        q_abs, q_pe = queries(q_lat[:, r:], pos_p[r:], g_q[l], w_q_up[l], w_uk[l])
        o = attention_prompt(q_abs, q_pe, c_kv, k_pe, w_uv[l], not last)
        u_ext = jnp.concatenate([jnp.zeros((B, POOL_HIST, D_POOL), u_pool.dtype), u_pool], axis=1)
        pooled = multiscale_pool(u_ext, 0, hp.shape[1] - r, w_pool_grp[l], pool_scale[l])
        hp = merge_and_ffn(hp[:, r:], o, pooled, gate_logits[:, r:], w_attn_br[l], w_pool_br[l],
                           w_out[l], g_norm_ffn[l], w_up[l], w_down[l])
        c_p.append(c_kv)
        pe_p.append(k_pe)
        pool_p.append(u_pool[:, -POOL_HIST:])
        xn = rmsnorm(hs, g_norm_mix[l])
        q_lat, c_new, pe_new, u_new, gl = mixer_inputs(xn, pos_s, w_in[l], g_kv[l])
        q_abs, q_pe = queries(q_lat, pos_s, g_q[l], w_q_up[l], w_uk[l])
        c_all = jnp.concatenate([cache_kv_latent[l], c_new], axis=1)
        pe_all = jnp.concatenate([cache_k_rope[l], pe_new], axis=1)
        o = attend(q_abs, q_pe, c_all, pe_all, w_uv[l])
        u_ext = jnp.concatenate([cache_pool[l], u_new], axis=1)
        pooled = multiscale_pool(u_ext, POOL_HIST, T, w_pool_grp[l], pool_scale[l])
        hs = merge_and_ffn(hs, o, pooled, gl, w_attn_br[l], w_pool_br[l],
                           w_out[l], g_norm_ffn[l], w_up[l], w_down[l])
        c_s.append(c_new)
        pe_s.append(pe_new)
        pool_s.append(u_ext[:, -POOL_HIST:])
    y_prompt = rmsnorm(hp, g_final)
    y_sample = rmsnorm(hs, g_final)
    return (y_prompt, y_sample, jnp.stack(c_p), jnp.stack(pe_p), jnp.stack(pool_p),
            jnp.stack(c_s), jnp.stack(pe_s), jnp.stack(pool_s))
```

```cpp
#include <hip/hip_runtime.h>
#include <hip/hip_cooperative_groups.h>
#include <cstdio>
#include <cstdint>
namespace cg = cooperative_groups;

#define DEVI __device__ __forceinline__
typedef unsigned short u16;
using bf16x8 = __attribute__((ext_vector_type(8))) short;
using f32x16 = __attribute__((ext_vector_type(16))) float;
using u32x4 = __attribute__((ext_vector_type(4))) unsigned;

constexpr int DM = 1024, SEQ = 16384, PAST = 1024, QL = 384, KVL = 256, ROPE = 64, DPOOL = 512, DFF = 4096;
constexpr int DIN = 3264, DIN_PAD = 3328;
constexpr int MP = 2 * SEQ;
constexpr int MS = 32 * 64;
constexpr int M = MP + MS;
constexpr int RALL = M + 256;
constexpr int LKP = 64 + SEQ;
constexpr int LKS = PAST + 64;
constexpr float EPS = 1e-6f;
constexpr float QS = 0.07216878364870322f * 1.4426950408889634f;
constexpr int ZW = 704;

constexpr size_t al256(size_t x) { return (x + 255) / 256 * 256; }
constexpr size_t W_WINT = 0;
constexpr size_t W_WQT  = W_WINT + (size_t)DIN_PAD * 1024 * 2;
constexpr size_t W_WUK  = W_WQT + (size_t)1536 * 384 * 2;
constexpr size_t W_WUVT = W_WUK + (size_t)256 * 1024 * 2;
constexpr size_t W_WABT = W_WUVT + (size_t)1024 * 256 * 2;
constexpr size_t W_WGT  = W_WABT + (size_t)1024 * 1024 * 2;
constexpr size_t W_WPBT = W_WGT + (size_t)4 * 128 * 128 * 2;
constexpr size_t W_WOT  = W_WPBT + (size_t)1024 * 512 * 2;
constexpr size_t W_WUPT = W_WOT + (size_t)1024 * 1024 * 2;
constexpr size_t W_WDT  = W_WUPT + (size_t)4096 * 1024 * 2;
constexpr size_t W_TAB  = W_WDT + (size_t)1024 * 4096 * 2;
constexpr size_t W_XN   = al256(W_TAB + (size_t)16400 * 32 * 8);
constexpr size_t W_KP   = al256(W_XN + (size_t)RALL * 1024 * 2);
constexpr size_t W_VTP  = W_KP + (size_t)2 * LKP * 320 * 2;
constexpr size_t W_COMBT = W_VTP;
constexpr size_t W_WQN  = W_VTP + (size_t)4 * 1024 * 1024;
constexpr size_t W_KS   = W_VTP + (size_t)2 * 256 * LKP * 2;
constexpr size_t W_VTS  = W_KS + (size_t)32 * LKS * 320 * 2;
constexpr size_t W_X    = al256(W_VTS + (size_t)32 * 256 * LKS * 2);
constexpr size_t X_Z    = W_X;
constexpr size_t X_UP   = X_Z + (size_t)RALL * ZW * 4;
constexpr size_t X_QB   = W_X;
constexpr size_t X_QN_  = W_X + (size_t)190 * 1024 * 1024;
constexpr size_t X_PIN  = X_QN_ + (size_t)M * 384 * 2;
constexpr size_t X_QNOPE= X_PIN + (size_t)M * 512 * 2;
constexpr size_t X_OL   = W_X + (size_t)M * 8 * 320 * 2;
constexpr size_t X_OB   = W_X;
constexpr size_t X_MG   = X_OL;
constexpr size_t X_U    = W_X;
constexpr size_t WS_END1 = X_OL + (size_t)M * 2048 * 2;
constexpr size_t WS_END2 = X_QNOPE + (size_t)M * 1024 * 2;
constexpr size_t WS_END3 = X_U + (size_t)M * 4096 * 2;
constexpr size_t WS_LIMIT = (size_t)512 * 1024 * 1024 - 4096;
constexpr size_t WS_BAR = WS_LIMIT;
static_assert(X_UP + (size_t)RALL * 512 * 4 <= X_QN_, "Z/Upool overlap qn");
static_assert(X_QB + (size_t)M * 8 * 320 * 2 <= X_QN_, "Qb overlaps qn");
static_assert(WS_END1 <= WS_LIMIT && WS_END2 <= WS_LIMIT && WS_END3 <= WS_LIMIT, "ws too small");

constexpr size_t O_Y = 0;
constexpr size_t O_KVP = (size_t)M * 1024;
constexpr size_t O_PEP = O_KVP + (size_t)2 * 16400 * 256;
constexpr size_t O_POOLP = O_PEP + (size_t)2 * 16400 * 64;
constexpr size_t O_KVS = O_POOLP + (size_t)2 * 15 * 512;
constexpr size_t O_PES = O_KVS + (size_t)32 * 64 * 256;
constexpr size_t O_POOLS = O_PES + (size_t)32 * 64 * 64;

constexpr int ABUF = 64 * 640 + 256 * 128;
constexpr int LDS_BYTES = 141568;

struct Params {
  const float *x_prompt, *x_sample, *cache_kv, *cache_rope, *cache_pool, *meta, *w_in, *g_mix, *g_q, *g_kv, *w_q_up, *w_uk, *w_uv,
      *w_attn_br, *w_pool_grp, *pool_scale, *w_pool_br, *w_out, *g_ffn, *w_up, *w_down, *g_final;
  float* out; char* ws;
};

DEVI unsigned cvtpk(float lo, float hi) { unsigned r; asm("v_cvt_pk_bf16_f32 %0, %1, %2" : "=v"(r) : "v"(lo), "v"(hi)); return r; }
DEVI u16 tobf(float x) { return (u16)(cvtpk(x, 0.f) & 0xffffu); }
DEVI uint2 pack4(float a, float b, float c, float d) { uint2 o; o.x = cvtpk(a, b); o.y = cvtpk(c, d); return o; }
DEVI int crow(int r, int hi) { return (r & 3) + 8 * (r >> 2) + 4 * hi; }
DEVI float wave_sum(float v) {
#pragma unroll
  for (int o = 32; o; o >>= 1) v += __shfl_xor(v, o, 64);
  return v;
}
DEVI f32x16 mfma(bf16x8 a, bf16x8 b, f32x16 c) { return __builtin_amdgcn_mfma_f32_32x32x16_bf16(a, b, c, 0, 0, 0); }
DEVI int fresh_tid(int ws) { int l; asm volatile("v_mbcnt_lo_u32_b32 %0, -1, 0\n\tv_mbcnt_hi_u32_b32 %0, -1, %0" : "=v"(l)); return ws * 64 + l; }
DEVI void grid_barrier(char* wsbase, unsigned k, int wvs) {
  unsigned* ctr = (unsigned*)(wsbase + ((size_t)512 * 1024 * 1024 - 4096));
  const unsigned target = k * gridDim.x;
  __threadfence();
  __syncthreads();
  if (fresh_tid(wvs) == 0) {
    __hip_atomic_fetch_add(ctr, 1u, __ATOMIC_RELAXED, __HIP_MEMORY_SCOPE_AGENT);
    while (__hip_atomic_load(ctr, __ATOMIC_RELAXED, __HIP_MEMORY_SCOPE_AGENT) < target) __builtin_amdgcn_s_sleep(2);
  }
  __syncthreads();
  __threadfence();
}


DEVI bf16x8 lds_rd128(int a, const int off) { bf16x8 r; asm volatile("ds_read_b128 %0, %1 offset:%2" : "=&v"(r) : "v"(a), "i"(off) : "memory"); return r; }
DEVI void glds16(const void* g, void* l) { __builtin_amdgcn_global_load_lds((const unsigned*)g, (unsigned*)l, 16, 0, 0); }
#define WAIT_VM0() asm volatile("s_waitcnt vmcnt(0)" ::: "memory")

template <int TM, int TN, int WR, int WC, int DEP = (TM + TN > 4 ? 1 : 2)>
DEVI void gemm_main_dma(f32x16 (&acc)[TM][TN], const u16* __restrict__ A, long lda, const u16* __restrict__ Bt, long ldb, int K, char* lds, const int tid,
                    const bool pre = false, const u16* __restrict__ nA = nullptr, const u16* __restrict__ nBt = nullptr) {
  static_assert(WR * WC == 8, "8 waves");
  constexpr int BM = 32 * TM * WR, BN = 32 * TN * WC, NA = BM / 64, NB = BN / 64, BUF = (BM + BN) * 128;
  const int lane = tid & 63, wid = tid >> 6, wr = wid / WC, wc = wid % WC, r32 = lane & 31, hi = lane >> 5;
  const int lrow = tid >> 3, lch = (tid & 7) ^ ((((tid >> 4) & 1) << 2) | ((tid >> 5) & 3));
  const u16* ag = A + (long)lrow * lda + lch * 8;
  const u16* bg = Bt + (long)lrow * ldb + lch * 8;
  char* lw = lds + wid * 1024;
#define G_ISSUE(kt_, buf_) do { \
    _Pragma("unroll") for (int i_ = 0; i_ < NA; ++i_) glds16(ag + (long)(64 * i_) * lda + (kt_) * 64, lw + (buf_) * BUF + i_ * 8192); \
    _Pragma("unroll") for (int i_ = 0; i_ < NB; ++i_) glds16(bg + (long)(64 * i_) * ldb + (kt_) * 64, lw + (buf_) * BUF + (NA + i_) * 8192); } while (0)
  const int fr = ((r32 & 2) << 1) | ((r32 >> 2) & 3);
  int o[4];
#pragma unroll
  for (int j = 0; j < 4; ++j) o[j] = ((2 * j + hi) ^ fr) * 16;
  const int KT = K / 64;
  if (!pre) G_ISSUE(0, 0);
  WAIT_VM0(); __syncthreads();
#pragma unroll 1
  for (int kt = 0; kt < KT; ++kt) {
    if (kt + 1 < KT) G_ISSUE(kt + 1, (kt + 1) & 1);
    const int abase = (int)(uintptr_t)lds + (kt & 1) * BUF + (wr * 32 * TM + r32) * 128;
    const int bbase = (int)(uintptr_t)lds + (kt & 1) * BUF + (BM + wc * 32 * TN + r32) * 128;
    bf16x8 fs[DEP + 1][TM + TN];
#define F_LOAD(set_, ks_) do { const int aa_ = abase + o[ks_], bb_ = bbase + o[ks_]; \
      _Pragma("unroll") for (int m_ = 0; m_ < TM; ++m_) fs[set_][m_] = lds_rd128(aa_, m_ * 4096); \
      _Pragma("unroll") for (int n_ = 0; n_ < TN; ++n_) fs[set_][TM + n_] = lds_rd128(bb_, n_ * 4096); } while (0)
#pragma unroll
    for (int pks = 0; pks < DEP; ++pks) F_LOAD(pks, pks);
#pragma unroll
    for (int ks = 0; ks < 4; ++ks) {
      if (ks + DEP < 4) F_LOAD((ks + DEP) % (DEP + 1), ks + DEP);
      constexpr int NF = TM + TN;
      const int ahead = (4 - 1 - ks) < DEP ? (4 - 1 - ks) : DEP;
      if (ahead == 2) asm volatile("s_waitcnt lgkmcnt(%0)" :: "n"(2 * NF) : "memory");
      else if (ahead == 1) asm volatile("s_waitcnt lgkmcnt(%0)" :: "n"(NF) : "memory");
      else asm volatile("s_waitcnt lgkmcnt(0)" ::: "memory");
      __builtin_amdgcn_sched_barrier(0);
#pragma unroll
      for (int m = 0; m < TM; ++m)
#pragma unroll
        for (int n = 0; n < TN; ++n) acc[m][n] = mfma(fs[ks % (DEP + 1)][m], fs[ks % (DEP + 1)][TM + n], acc[m][n]);
      __builtin_amdgcn_sched_barrier(0);
    }
#undef F_LOAD
    WAIT_VM0(); __syncthreads();
  }
  if (nA != nullptr) {
    const u16* ag2 = nA + (long)lrow * lda + lch * 8;
    const u16* bg2 = nBt + (long)lrow * ldb + lch * 8;
#pragma unroll
    for (int i = 0; i < NA; ++i) glds16(ag2 + (long)(64 * i) * lda, lw + i * 8192);
#pragma unroll
    for (int i = 0; i < NB; ++i) glds16(bg2 + (long)(64 * i) * ldb, lw + (NA + i) * 8192);
  }
#undef G_ISSUE
}
template <int TM, int TN, int WR, int WC, int DEP = (TM + TN > 4 ? 1 : 2)>
DEVI void gemm_main_reg(f32x16 (&acc)[TM][TN], const u16* __restrict__ A, long lda, const u16* __restrict__ Bt, long ldb, int K, char* lds, const int tid,
                    const bool pre = false, const u16* __restrict__ nA = nullptr, const u16* __restrict__ nBt = nullptr) {
  static_assert(WR * WC == 8, "8 waves");
  constexpr int BM = 32 * TM * WR, BN = 32 * TN * WC, NA = BM / 64, NB = BN / 64, BUF = (BM + BN) * 128;
  const int lane = tid & 63, wid = tid >> 6, wr = wid / WC, wc = wid % WC, r32 = lane & 31, hi = lane >> 5;
  const int lrow = tid >> 3, lpos = (tid & 7) ^ ((((tid >> 4) & 1) << 2) | ((tid >> 5) & 3));
  const u16* ag = A + (long)lrow * lda + (tid & 7) * 8;
  const u16* bg = Bt + (long)lrow * ldb + (tid & 7) * 8;
  char* lwr = lds + lrow * 128 + lpos * 16;
  u32x4 r0[NA + NB], r1[NA + NB];
#define G_LOAD(R_, kt_) do { \
    _Pragma("unroll") for (int i_ = 0; i_ < NA; ++i_) R_[i_] = *(const u32x4*)(ag + (long)(64 * i_) * lda + (kt_) * 64); \
    _Pragma("unroll") for (int i_ = 0; i_ < NB; ++i_) R_[NA + i_] = *(const u32x4*)(bg + (long)(64 * i_) * ldb + (kt_) * 64); } while (0)
#define S_WRITE(R_, buf_) do { _Pragma("unroll") for (int i_ = 0; i_ < NA + NB; ++i_) *(u32x4*)(lwr + (buf_) * BUF + i_ * 8192) = R_[i_]; } while (0)
  const int fr = ((r32 & 2) << 1) | ((r32 >> 2) & 3);
  int o[4];
#pragma unroll
  for (int j = 0; j < 4; ++j) o[j] = ((2 * j + hi) ^ fr) * 16;
  const int KT = K / 64;
  (void)pre; (void)nA; (void)nBt;
#define K_TILE(buf_) do { \
    const int abase = (int)(uintptr_t)lds + (buf_) * BUF + (wr * 32 * TM + r32) * 128; \
    const int bbase = (int)(uintptr_t)lds + (buf_) * BUF + (BM + wc * 32 * TN + r32) * 128; \
    bf16x8 fs[DEP + 1][TM + TN]; \
    _Pragma("unroll") for (int pks = 0; pks < DEP; ++pks) { const int aa_ = abase + o[pks], bb_ = bbase + o[pks]; \
      _Pragma("unroll") for (int m_ = 0; m_ < TM; ++m_) fs[pks][m_] = lds_rd128(aa_, m_ * 4096); \
      _Pragma("unroll") for (int n_ = 0; n_ < TN; ++n_) fs[pks][TM + n_] = lds_rd128(bb_, n_ * 4096); } \
    _Pragma("unroll") for (int ks = 0; ks < 4; ++ks) { \
      if (ks + DEP < 4) { const int aa_ = abase + o[(ks + DEP) & 3], bb_ = bbase + o[(ks + DEP) & 3]; \
        _Pragma("unroll") for (int m_ = 0; m_ < TM; ++m_) fs[(ks + DEP) % (DEP + 1)][m_] = lds_rd128(aa_, m_ * 4096); \
        _Pragma("unroll") for (int n_ = 0; n_ < TN; ++n_) fs[(ks + DEP) % (DEP + 1)][TM + n_] = lds_rd128(bb_, n_ * 4096); } \
      const int ahead = (4 - 1 - ks) < DEP ? (4 - 1 - ks) : DEP; \
      if (ahead == 2) asm volatile("s_waitcnt lgkmcnt(%0)" :: "n"(2 * (TM + TN)) : "memory"); \
      else if (ahead == 1) asm volatile("s_waitcnt lgkmcnt(%0)" :: "n"(TM + TN) : "memory"); \
      else asm volatile("s_waitcnt lgkmcnt(0)" ::: "memory"); \
      __builtin_amdgcn_sched_barrier(0); \
      _Pragma("unroll") for (int m = 0; m < TM; ++m) \
        _Pragma("unroll") for (int n = 0; n < TN; ++n) acc[m][n] = mfma(fs[ks % (DEP + 1)][m], fs[ks % (DEP + 1)][TM + n], acc[m][n]); \
      __builtin_amdgcn_sched_barrier(0); \
    } } while (0)
  G_LOAD(r0, 0); S_WRITE(r0, 0); G_LOAD(r1, 1);
  __syncthreads();
#pragma unroll 1
  for (int kt = 0; kt < KT; kt += 2) {
    if (kt + 2 < KT) G_LOAD(r0, kt + 2);
    K_TILE(0);
    S_WRITE(r1, 1);
    __syncthreads();
    if (kt + 3 < KT) G_LOAD(r1, kt + 3);
    K_TILE(1);
    if (kt + 2 < KT) S_WRITE(r0, 0);
    __syncthreads();
  }
#undef K_TILE
#undef G_LOAD
#undef S_WRITE
}
template <int TM, int TN, int WR, int WC, int DEP = (TM + TN > 4 ? 1 : 2)>
DEVI void gemm_main(f32x16 (&acc)[TM][TN], const u16* __restrict__ A, long lda, const u16* __restrict__ Bt, long ldb, int K, char* lds, const int tid,
                    const bool pre = false, const u16* __restrict__ nA = nullptr, const u16* __restrict__ nBt = nullptr) {
  gemm_main_dma<TM, TN, WR, WC, DEP>(acc, A, lda, Bt, ldb, K, lds, tid, pre, nA, nBt);
}
#define TILE_LOOP(tile, NT) \
  for (int it_ = 0, tile = 0; it_ * 8 * (int)(gridDim.x >> 3) < (NT); ++it_) \
    if ((tile = (it_ * 8 + (int)(blockIdx.x & 7)) * (int)(gridDim.x >> 3) + (int)(blockIdx.x >> 3)) < (NT))
template <int TM, int TN> DEVI void zero_acc(f32x16 (&acc)[TM][TN]) {
#pragma unroll
  for (int m = 0; m < TM; ++m)
#pragma unroll
    for (int n = 0; n < TN; ++n)
#pragma unroll
      for (int r = 0; r < 16; ++r) acc[m][n][r] = 0.f;
}

template <int R, bool BF>
DEVI void rms_rows(const float* const (&src)[R], const bool (&ok)[R], const bool (&zero)[R], const float* __restrict__ g, char* const (&dst)[R], const int lane) {
  float4 v[R][4];
#pragma unroll
  for (int k = 0; k < R; ++k)
#pragma unroll
    for (int i = 0; i < 4; ++i) v[k][i] = (ok[k] && !zero[k]) ? *(const float4*)(src[k] + 4 * lane + 256 * i) : make_float4(0, 0, 0, 0);
  float ss[R];
#pragma unroll
  for (int k = 0; k < R; ++k) {
    ss[k] = 0;
#pragma unroll
    for (int i = 0; i < 4; ++i) ss[k] += v[k][i].x * v[k][i].x + v[k][i].y * v[k][i].y + v[k][i].z * v[k][i].z + v[k][i].w * v[k][i].w;
  }
#pragma unroll
  for (int o = 32; o; o >>= 1)
#pragma unroll
    for (int k = 0; k < R; ++k) ss[k] += __shfl_xor(ss[k], o, 64);
#pragma unroll
  for (int i = 0; i < 4; ++i) {
    const float4 gg = *(const float4*)(g + 4 * lane + 256 * i);
#pragma unroll
    for (int k = 0; k < R; ++k) {
      if (!ok[k]) continue;
      const float rs = rsqrtf(ss[k] * (1.f / 1024.f) + EPS);
      const float4 y = make_float4(v[k][i].x * rs * gg.x, v[k][i].y * rs * gg.y, v[k][i].z * rs * gg.z, v[k][i].w * rs * gg.w);
      if (BF) *(uint2*)((u16*)dst[k] + 4 * lane + 256 * i) = pack4(y.x, y.y, y.z, y.w);
      else *(float4*)((float*)dst[k] + 4 * lane + 256 * i) = y;
    }
  }
}

DEVI void phase0(const Params& p, char* lds, const int wvs) {
  const int tid512 = fresh_tid(wvs);
  char* ws = p.ws;
  const int half = tid512 >> 8, tid = tid512 & 255, lane = tid & 63, w = tid >> 6;
  float* T = (float*)lds + half * (64 * 65);
  constexpr int U_T = 3728, U_C = U_T + 512, U_X = U_C + 548, U_R = U_X + 513, U_K = U_R + 256, U_P = U_K + 32;
  for (int it = blockIdx.x; 2 * it < U_P; it += gridDim.x) {
    const int u = 2 * it + half;
    const float* src = nullptr; u16* dst = nullptr; int N = 0, Kd = 0, k0 = 0, n0 = 0; bool isq = false;
    const bool tr = u < U_T;
    if (tr) {
      int t = u;
      if (t < 816) { src = p.w_in; dst = (u16*)(ws + W_WINT); Kd = 1024; N = DIN; }
      else if (t < 960) { t -= 816; src = p.w_q_up; dst = (u16*)(ws + W_WQT); Kd = 384; N = 1536; isq = true; }
      else if (t < 1024) { t -= 960; src = p.w_uv; dst = (u16*)(ws + W_WUVT); Kd = 256; N = 1024; }
      else if (t < 1280) { t -= 1024; src = p.w_attn_br; dst = (u16*)(ws + W_WABT); Kd = 1024; N = 1024; }
      else if (t < 1296) { t -= 1280; const int g = t >> 2; t &= 3; src = p.w_pool_grp + g * 16384; dst = (u16*)(ws + W_WGT) + g * 16384; Kd = 128; N = 128; }
      else if (t < 1424) { t -= 1296; src = p.w_pool_br; dst = (u16*)(ws + W_WPBT); Kd = 512; N = 1024; }
      else if (t < 1680) { t -= 1424; src = p.w_out; dst = (u16*)(ws + W_WOT); Kd = 1024; N = 1024; }
      else if (t < 2704) { t -= 1680; src = p.w_up; dst = (u16*)(ws + W_WUPT); Kd = 1024; N = 4096; }
      else { t -= 2704; src = p.w_down; dst = (u16*)(ws + W_WDT); Kd = 4096; N = 1024; }
      const int nt = N / 64; const int tk = t / nt, tn = t - tk * nt;
      k0 = tk * 64; n0 = tn * 64;
#pragma unroll
      for (int i = 0; i < 16; ++i) { const int k = w + 4 * i; const float v = src[(long)(k0 + k) * N + n0 + lane]; T[k * 65 + lane] = v;
        if (isq) ((u16*)(ws + W_WQN))[(long)(k0 + k) * 1536 + n0 + lane] = tobf(v); }
    }
    __syncthreads();
    if (tr) {
      const int n = tid >> 2, kc = (tid & 3) * 16;
      unsigned pk[8];
#pragma unroll
      for (int j = 0; j < 8; ++j) pk[j] = cvtpk(T[(kc + 2 * j) * 65 + n], T[(kc + 2 * j + 1) * 65 + n]);
      uint4* d = (uint4*)(dst + (long)(n0 + n) * Kd + k0 + kc);
      d[0] = make_uint4(pk[0], pk[1], pk[2], pk[3]); d[1] = make_uint4(pk[4], pk[5], pk[6], pk[7]);
      if (isq && n0 % 192 == 128) {
        uint4* d2 = (uint4*)((u16*)(ws + W_COMBT) + (long)((n0 / 192) * 320 + 256 + (n < 32 ? 2 * n : 2 * (n - 32) + 1)) * 384 + k0 + kc);
        d2[0] = make_uint4(pk[0], pk[1], pk[2], pk[3]); d2[1] = make_uint4(pk[4], pk[5], pk[6], pk[7]);
      }
    } else if (u < U_C) {
      const int c = u - U_T, bd = c >> 4, ct = c & 15;
      u16* Kd2 = (u16*)(ws + W_KS) + ((long)bd * LKS + ct * 64) * 320;
#pragma unroll 4
      for (int i = 0; i < 16; ++i) {
        const int r = w * 16 + i;
        const float4 v = *(const float4*)(p.cache_kv + ((long)(bd * PAST + ct * 64 + r)) * 256 + 4 * lane);
        uint2 o; o.x = cvtpk(v.x, v.y); o.y = cvtpk(v.z, v.w);
        *(uint2*)(Kd2 + r * 320 + 4 * lane) = o;
        const float kr = p.cache_rope[((long)(bd * PAST + ct * 64 + r)) * 64 + lane];
        Kd2[r * 320 + 256 + (lane < 32 ? 2 * lane : 2 * (lane - 32) + 1)] = tobf(kr);
      }
    } else if (u < U_X) {
      const int ru = u - U_C;
      for (int i = 0; i < 16; i += 4) {
        const float* s[4]; char* d[4]; bool ok[4], z[4];
#pragma unroll
        for (int k = 0; k < 4; ++k) {
          const int R = ru * 64 + w * 16 + i + k;
          s[k] = R < MP ? p.x_prompt + (long)R * 1024 : (R < M ? p.x_sample + (long)(R - MP) * 1024 : p.meta + (long)(R - M) * 1024);
          ok[k] = true; z[k] = R >= M + 16; d[k] = (char*)((u16*)(ws + W_XN) + (long)R * 1024);
        }
        rms_rows<4, true>(s, ok, z, p.g_mix, d, lane);
      }
    } else if (u < U_R) {
      const int base = (u - U_X) * 1024;
      for (int i = 0; i < 4; ++i) {
        const int e = base + i * 256 + tid;
        if (e < 16400 * 32) {
          const int pos = e >> 5, j = e & 31;
          const float inv = exp2f(-(float)j * 0.41524101186092029f);
          const double rev = (double)pos * (double)inv * 0.15915494309189535;
          const float fr = (float)(rev - floor(rev));
          float2 cs; cs.x = __builtin_amdgcn_cosf(fr); cs.y = __builtin_amdgcn_sinf(fr);
          ((float2*)(ws + W_TAB))[e] = cs;
        }
      }
    } else if (u < U_K) {
      const int e = ((u - U_R) * 256 + tid) * 4;
      const float4 v = *(const float4*)(p.w_uk + e);
      uint2 o; o.x = cvtpk(v.x, v.y); o.y = cvtpk(v.z, v.w);
      *(uint2*)((u16*)(ws + W_WUK) + e) = o;
    } else if (u < U_P) {
      const int e = (u - U_K) * 256 + tid;
      ((uint4*)((u16*)(ws + W_WINT) + (long)DIN * 1024))[e] = make_uint4(0, 0, 0, 0);
    }
    __syncthreads();
  }
}

DEVI char* stage_base(char* lds, int wid) { return lds + 65536 + wid * 8192; }
DEVI void stage_put(char* stg, int row, int col, float v) { *(u16*)(stg + row * 128 + col * 2) = tobf(v); }
DEVI void stage_flush(const char* stg, u16* __restrict__ out, long ld, int lane) {
#pragma unroll
  for (int j = 0; j < 8; ++j) {
    const int q = lane + 64 * j, row = q >> 3, c = q & 7;
    const uint4 v = *(const uint4*)(stg + row * 128 + c * 16);
    *(uint4*)(out + (long)row * ld + c * 8) = v;
  }
}


namespace pg8 {
#define PG8_LAS __attribute__((address_space(3)))
typedef unsigned short bf16_t;
typedef float f32x4 __attribute__((ext_vector_type(4)));
constexpr int BM = 256, BK = 64, HALF = 128, HTB = HALF * BK * 2, STAGE_BYTES = 8 * HTB, NXCD = 8, WGM = 8;
__device__ __forceinline__ int lds_byte(int r, int c) { const int st = (r >> 4) * 2 + (c >> 5), rr = r & 15, cc = c & 31, ob = rr * 64 + cc * 2; return st * 1024 + (ob ^ (((ob >> 9) & 1) << 5)); }
__device__ __forceinline__ void stage_rc(int b, int& R, int& C) { const int st = b / 1024, sb = b % 1024, swz = sb ^ (((sb >> 9) & 1) << 5); R = (st >> 1) * 16 + swz / 64; C = (st & 1) * 32 + (swz % 64) / 2; }
__device__ __forceinline__ int perm32(int rho) { const int n = rho >> 4, i = rho & 15; return 8 * (i >> 2) + 4 * n + (i & 3); }
struct Unit { int pm, pn; };
struct Gemm { const bf16_t* A; const bf16_t* Bt; int M, N, K; };
struct StaticOrder {
    int nM, nN, nwg, G, c;
    __device__ void init(int M, int N, int G_, int c_) { nM = M / BM; nN = N / BM; nwg = nM * nN; G = G_; c = c_; }
    __device__ bool next(int i, Unit& u) const {
        const long L = (long)i * G + c; if (L >= nwg) return false;
        int wgid = (int)L; { const int q = nwg / NXCD, r = nwg % NXCD, xcd = wgid % NXCD, off = wgid / NXCD; wgid = (xcd < r ? xcd * (q + 1) : r * (q + 1) + (xcd - r) * q) + off; }
        const int nig = WGM * nN, gid = wgid / nig, fm = gid * WGM, gsz = (nM - fm) < WGM ? (nM - fm) : WGM;
        u.pm = fm + ((wgid % nig) % gsz); u.pn = (wgid % nig) / gsz; return true;
    }
    __device__ __forceinline__ void a_ready(const Unit&) const {}
    __device__ __forceinline__ void done(const Unit&) const {}
};
template <class Epi, class Sched>
__device__ __forceinline__ void gemm_phase(PG8_LAS unsigned char* lds, const Gemm g, const Sched& S, const Epi& E, const int tid) {
    const int wid = __builtin_amdgcn_readfirstlane(tid >> 6), lane = tid & 63, wr = wid >> 2, wc = wid & 3, fr = lane & 15, fq = lane >> 4;
    const int K = g.K, nt = K / BK;
    unsigned voffA[2], voffB[2];
#pragma unroll
    for (int i = 0; i < 2; ++i) { int R, C; stage_rc(tid * 16 + i * 8192, R, C); const int Rb = Epi::PERM ? ((R & ~31) + perm32(R & 31)) : R;
        voffA[i] = (unsigned)(R * K + C) * 2u; voffB[i] = (unsigned)(Rb * K + C) * 2u; }
    const size_t kstep = (size_t)(BK * 2);
    const size_t hstep = (size_t)HALF * K * 2;
    const size_t tstep = 2 * hstep;
    const unsigned ldsw = (unsigned)wid * 1024u;
    const int aoff = lds_byte(wr * 64 + fr, fq * 8), boff = lds_byte(wc * 32 + fr, fq * 8);
#define PG8_SA(b, h) (((b) * 2 + (h)) * HTB)
#define PG8_SB(b, h) ((4 + (b) * 2 + (h)) * HTB)
#define PG8_STAGE(bufoff, gbase, voff) do { _Pragma("unroll") for (int _i = 0; _i < 2; ++_i) \
        __builtin_amdgcn_global_load_lds((const unsigned*)((const char*)(gbase) + (voff)[_i]), (PG8_LAS unsigned*)(lds + (bufoff) + ldsw + _i * 8192), 16, 0, 0); } while (0)
#define PG8_LDA(dst, b, h) do { _Pragma("unroll") for (int m = 0; m < 4; ++m) _Pragma("unroll") for (int k = 0; k < 2; ++k) dst[m][k] = *(const PG8_LAS bf16x8*)(lds + PG8_SA(b, h) + aoff + m * 2048 + k * 1024); } while (0)
#define PG8_LDB(dst, b, h) do { _Pragma("unroll") for (int n = 0; n < 2; ++n) _Pragma("unroll") for (int k = 0; k < 2; ++k) dst[n][k] = *(const PG8_LAS bf16x8*)(lds + PG8_SB(b, h) + boff + n * 2048 + k * 1024); } while (0)
#define PG8_MMA(ai, bj, At, Bt) do { __builtin_amdgcn_s_setprio(1); _Pragma("unroll") for (int m = 0; m < 4; ++m) _Pragma("unroll") for (int n = 0; n < 2; ++n) _Pragma("unroll") for (int k = 0; k < 2; ++k) \
        acc[ai][bj][m][n] = __builtin_amdgcn_mfma_f32_16x16x32_bf16(Bt[n][k], At[m][k], acc[ai][bj][m][n], 0, 0, 0); __builtin_amdgcn_s_setprio(0); } while (0)
#define PG8_WAIT_V(n) asm volatile("s_waitcnt vmcnt(" #n ")" ::: "memory")
#define PG8_WAIT_L(n) asm volatile("s_waitcnt lgkmcnt(" #n ")" ::: "memory")
#define PG8_BAR __builtin_amdgcn_s_barrier()
#define PG8_SCHED __builtin_amdgcn_sched_barrier(0)
    Unit cur, nxt; int ui = 0;
    if (!S.next(0, cur)) return;
    f32x4 acc[2][2][4][2];
#pragma unroll
    for (int a = 0; a < 2; ++a)
#pragma unroll
        for (int b = 0; b < 2; ++b)
#pragma unroll
            for (int m = 0; m < 4; ++m)
#pragma unroll
                for (int n = 0; n < 2; ++n) acc[a][b][m][n] = (f32x4){0.f, 0.f, 0.f, 0.f};
    bf16x8 At[4][2], B0[2][2], B1[2][2];
    const char* cA = (const char*)g.A + (size_t)cur.pm * tstep; const char* cB = (const char*)g.Bt + (size_t)cur.pn * tstep;
    S.a_ready(cur);
    PG8_STAGE(PG8_SB(0, 0), cB, voffB); PG8_STAGE(PG8_SA(0, 0), cA, voffA); PG8_STAGE(PG8_SB(0, 1), cB + hstep, voffB); PG8_STAGE(PG8_SA(0, 1), cA + hstep, voffA);
    if (wr == 1) PG8_BAR;
    PG8_WAIT_V(4); PG8_BAR;
    PG8_STAGE(PG8_SB(1, 0), cB + kstep, voffB); PG8_STAGE(PG8_SA(1, 0), cA + kstep, voffA); PG8_STAGE(PG8_SB(1, 1), cB + hstep + kstep, voffB);
    PG8_WAIT_V(6); PG8_BAR;
    for (;;) {
        const bool has_next = S.next(ui + 1, nxt);
        const char* nA = has_next ? (const char*)g.A + (size_t)nxt.pm * tstep : cA; const char* nB = has_next ? (const char*)g.Bt + (size_t)nxt.pn * tstep : cB;
        for (int t = 0; t < nt; t += 2) {
            const bool last = (t == nt - 2);
            const char* a1 = cA + (size_t)(t + 1) * kstep;
            const char* a2 = last ? nA : cA + (size_t)(t + 2) * kstep; const char* b2 = last ? nB : cB + (size_t)(t + 2) * kstep;
            const char* a3 = a2 + kstep; const char* b3 = b2 + kstep;
            if (last && has_next) S.a_ready(nxt);
            PG8_LDB(B0, 0, 0); PG8_SCHED; PG8_LDA(At, 0, 0); PG8_STAGE(PG8_SA(1, 1), a1 + hstep, voffA);
            PG8_WAIT_L(8); PG8_BAR; PG8_WAIT_L(0); PG8_MMA(0, 0, At, B0); PG8_BAR; PG8_SCHED;
            PG8_LDB(B1, 0, 1); PG8_STAGE(PG8_SB(0, 0), b2, voffB);
            PG8_BAR; PG8_WAIT_L(0); PG8_MMA(0, 1, At, B1); PG8_BAR;
            PG8_LDA(At, 0, 1); PG8_STAGE(PG8_SA(0, 0), a2, voffA);
            PG8_BAR; PG8_WAIT_L(0); PG8_MMA(1, 0, At, B0); PG8_BAR; PG8_SCHED;
            PG8_STAGE(PG8_SB(0, 1), b2 + hstep, voffB);
            PG8_WAIT_V(6); PG8_BAR; PG8_MMA(1, 1, At, B1); PG8_BAR;
            PG8_LDB(B0, 1, 0); PG8_SCHED; PG8_LDA(At, 1, 0); PG8_STAGE(PG8_SA(0, 1), a2 + hstep, voffA);
            PG8_WAIT_L(8); PG8_BAR; PG8_WAIT_L(0); PG8_MMA(0, 0, At, B0); PG8_BAR; PG8_SCHED;
            PG8_LDB(B1, 1, 1); PG8_STAGE(PG8_SB(1, 0), b3, voffB);
            PG8_BAR; PG8_WAIT_L(0); PG8_MMA(0, 1, At, B1); PG8_BAR;
            PG8_LDA(At, 1, 1); PG8_STAGE(PG8_SA(1, 0), a3, voffA);
            PG8_BAR; PG8_WAIT_L(0); PG8_MMA(1, 0, At, B0); PG8_BAR; PG8_SCHED;
            PG8_STAGE(PG8_SB(1, 1), b3 + hstep, voffB);
            PG8_WAIT_V(6); PG8_BAR; PG8_MMA(1, 1, At, B1); PG8_BAR;
        }
            if constexpr (!Epi::AFTER_DRAIN) { E(acc, cur, wr, wc, fr, fq); S.done(cur); }
            if (!has_next) break;
#pragma unroll
        for (int a = 0; a < 2; ++a)
#pragma unroll
            for (int b = 0; b < 2; ++b)
#pragma unroll
                for (int m = 0; m < 4; ++m)
#pragma unroll
                    for (int n = 0; n < 2; ++n) acc[a][b][m][n] = (f32x4){0.f, 0.f, 0.f, 0.f};
        cur = nxt; cA = nA; cB = nB; ++ui;
    }
    PG8_WAIT_V(0);
    if (wr == 0) PG8_BAR;
    PG8_BAR;
    if constexpr (Epi::AFTER_DRAIN) { E.fused(acc, cur, wr, wc, fr, fq, lds, wid, lane); S.done(cur); }
#undef PG8_SA
#undef PG8_SB
#undef PG8_STAGE
#undef PG8_LDA
#undef PG8_LDB
#undef PG8_MMA
#undef PG8_WAIT_V
#undef PG8_WAIT_L
#undef PG8_BAR
#undef PG8_SCHED
}
}

#define PG8_ROW(u, ai, m) ((u).pm * 256 + (ai) * 128 + wr * 64 + (m) * 16 + fr)
#define PG8_COL8(u, bj) ((u).pn * 256 + (bj) * 128 + wc * 32 + 8 * fq)
struct EpiP1 {
  static constexpr bool PERM = true, AFTER_DRAIN = false;
  float* Z; float* UP; u16* G;
  __device__ __forceinline__ void operator()(const pg8::f32x4 (&acc)[2][2][4][2], const pg8::Unit& u, int wr, int wc, int fr, int fq) const {
#pragma unroll
    for (int bj = 0; bj < 2; ++bj) {
      const int c8 = PG8_COL8(u, bj), grp = u.pn * 256 + bj * 128 + wc * 32;
#pragma unroll
      for (int ai = 0; ai < 2; ++ai)
#pragma unroll
        for (int m = 0; m < 4; ++m) {
          const long row = PG8_ROW(u, ai, m);
          if (grp < ZW) { *(pg8::f32x4*)(Z + row * ZW + c8) = acc[ai][bj][m][0]; *(pg8::f32x4*)(Z + row * ZW + c8 + 4) = acc[ai][bj][m][1]; }
          else if (grp < ZW + DPOOL) { *(pg8::f32x4*)(UP + row * 512 + c8 - ZW) = acc[ai][bj][m][0]; *(pg8::f32x4*)(UP + row * 512 + c8 - ZW + 4) = acc[ai][bj][m][1]; }
          else if (grp < DIN && row < M) {
            float s[8];
#pragma unroll
            for (int j = 0; j < 4; ++j) { s[j] = 1.f / (1.f + __expf(-acc[ai][bj][m][0][j])); s[4 + j] = 1.f / (1.f + __expf(-acc[ai][bj][m][1][j])); }
            u32x4 w = {cvtpk(s[0], s[1]), cvtpk(s[2], s[3]), cvtpk(s[4], s[5]), cvtpk(s[6], s[7])};
            *(u32x4*)(G + row * 2048 + c8 - (ZW + DPOOL)) = w;
          }
        }
    }
  }
};
struct EpiP8 {
  static constexpr bool PERM = true, AFTER_DRAIN = false;
  float* Y; const float* xp; const float* xs;
  __device__ __forceinline__ void operator()(const pg8::f32x4 (&acc)[2][2][4][2], const pg8::Unit& u, int wr, int wc, int fr, int fq) const {
#pragma unroll
    for (int ai = 0; ai < 2; ++ai)
#pragma unroll
      for (int m = 0; m < 4; ++m) {
        const long row = PG8_ROW(u, ai, m);
        const float* xr = row < MP ? xp + row * 1024 : xs + (row - MP) * 1024;
#pragma unroll
        for (int bj = 0; bj < 2; ++bj) {
          const int c8 = PG8_COL8(u, bj);
          const pg8::f32x4 x0 = *(const pg8::f32x4*)(xr + c8), x1 = *(const pg8::f32x4*)(xr + c8 + 4);
          *(pg8::f32x4*)(Y + row * 1024 + c8) = x0 + acc[ai][bj][m][0]; *(pg8::f32x4*)(Y + row * 1024 + c8 + 4) = x1 + acc[ai][bj][m][1];
        }
      }
  }
};
struct EpiP10 {
  static constexpr bool PERM = true, AFTER_DRAIN = false;
  u16* U;
  __device__ __forceinline__ void operator()(const pg8::f32x4 (&acc)[2][2][4][2], const pg8::Unit& u, int wr, int wc, int fr, int fq) const {
#pragma unroll
    for (int ai = 0; ai < 2; ++ai)
#pragma unroll
      for (int m = 0; m < 4; ++m) {
        const long row = PG8_ROW(u, ai, m);
#pragma unroll
        for (int bj = 0; bj < 2; ++bj) {
          float v[8];
#pragma unroll
          for (int j = 0; j < 4; ++j) { const float a = fmaxf(acc[ai][bj][m][0][j], 0.f), b = fmaxf(acc[ai][bj][m][1][j], 0.f); v[j] = a * a; v[4 + j] = b * b; }
          u32x4 w = {cvtpk(v[0], v[1]), cvtpk(v[2], v[3]), cvtpk(v[4], v[5]), cvtpk(v[6], v[7])};
          *(u32x4*)(U + row * 4096 + PG8_COL8(u, bj)) = w;
        }
      }
  }
};
struct EpiP11 {
  static constexpr bool PERM = true, AFTER_DRAIN = false;
  float* Y;
  __device__ __forceinline__ void operator()(const pg8::f32x4 (&acc)[2][2][4][2], const pg8::Unit& u, int wr, int wc, int fr, int fq) const {
#pragma unroll
    for (int ai = 0; ai < 2; ++ai)
#pragma unroll
      for (int m = 0; m < 4; ++m) {
        const long row = PG8_ROW(u, ai, m);
#pragma unroll
        for (int bj = 0; bj < 2; ++bj) {
          float* y = Y + row * 1024 + PG8_COL8(u, bj);
          const pg8::f32x4 h0 = *(const pg8::f32x4*)y, h1 = *(const pg8::f32x4*)(y + 4);
          *(pg8::f32x4*)y = h0 + acc[ai][bj][m][0]; *(pg8::f32x4*)(y + 4) = h1 + acc[ai][bj][m][1];
        }
      }
  }
};
template <class Epi>
DEVI void run_pg8(char* lds, const u16* A, const u16* Bt, int Mr, int Nc, int K, const Epi& E, const int tid) {
  pg8::StaticOrder S; S.init(Mr, Nc, (int)gridDim.x, (int)blockIdx.x);
  pg8::Gemm g; g.A = A; g.Bt = Bt; g.M = Mr; g.N = Nc; g.K = K;
  pg8::gemm_phase<Epi, pg8::StaticOrder>((PG8_LAS unsigned char*)lds, g, S, E, tid);
}

DEVI void phase1(const Params& p, char* lds, const int wvs) {
  const int tid = fresh_tid(wvs);
  char* ws = p.ws;
  EpiP1 E; E.Z = (float*)(ws + X_Z); E.UP = (float*)(ws + X_UP); E.G = (u16*)p.out;
  run_pg8(lds, (const u16*)(ws + W_XN), (const u16*)(ws + W_WINT), RALL, DIN_PAD, 1024, E, tid);
}

DEVI void phase2w(const Params& p, char* lds, const int wvs) {
  const int tid = fresh_tid(wvs);
  char* ws = p.ws;
  const int lane = tid & 63;
  for (int ct = blockIdx.x; ct < 24; ct += gridDim.x) {
    const int h = ct / 3, t3 = ct - 3 * h, wid = tid >> 6, wr = wid >> 1, wc = wid & 1, r32 = lane & 31, hi = lane >> 5;
    f32x16 acc[2][2]; zero_acc(acc);
    gemm_main<2, 2, 4, 2>(acc, (const u16*)(ws + W_WUK) + h * 128, 1024, (const u16*)(ws + W_WQN) + (long)(t3 * 128) * 1536 + h * 192, 1536, 128, lds, tid);
    char* stg = stage_base(lds, wid);
#pragma unroll
    for (int m = 0; m < 2; ++m)
#pragma unroll
      for (int n = 0; n < 2; ++n)
#pragma unroll
        for (int r = 0; r < 16; ++r) stage_put(stg, 32 * m + crow(r, hi), 32 * n + r32, acc[m][n][r]);
    stage_flush(stg, (u16*)(ws + W_COMBT) + (long)(h * 320 + wr * 64) * 384 + t3 * 128 + wc * 64, 384, lane);
    __syncthreads();
  }
}
DEVI void phase2(const Params& p, char* lds, const int wvs) {
  const int tid = fresh_tid(wvs);
  char* ws = p.ws;
  const int lane = tid & 63, w = tid >> 6;
  const float* Z = (const float*)(ws + X_Z); const float* UP = (const float*)(ws + X_UP);
  const float2* TAB = (const float2*)(ws + W_TAB);
  for (int u = blockIdx.x; u < 546; u += gridDim.x) {
    int zrow0, pos0, keybase, b = 0; long ldvt; u16 *Kd, *VT; float *okv, *ope, *opool = nullptr; bool meta = false, sample = false;
    if (u < 512) {
      b = u >> 8; const int ft = u & 255;
      zrow0 = b * SEQ + ft * 64; pos0 = 16 + ft * 64; keybase = 64 + ft * 64; ldvt = LKP;
      Kd = (u16*)(ws + W_KP) + ((long)b * LKP + keybase) * 320; VT = (u16*)(ws + W_VTP) + (long)b * 256 * LKP;
      okv = p.out + O_KVP + ((long)b * 16400 + pos0) * 256; ope = p.out + O_PEP + ((long)b * 16400 + pos0) * 64;
      if (ft == 255) opool = p.out + O_POOLP + (long)b * 15 * 512;
    } else if (u < 544) {
      b = u - 512; sample = true;
      zrow0 = MP + b * 64; pos0 = PAST; keybase = PAST; ldvt = LKS;
      Kd = (u16*)(ws + W_KS) + ((long)b * LKS + keybase) * 320; VT = (u16*)(ws + W_VTS) + (long)b * 256 * LKS;
      okv = p.out + O_KVS + (long)b * 64 * 256; ope = p.out + O_PES + (long)b * 64 * 64;
      opool = p.out + O_POOLS + (long)b * 15 * 512;
    } else {
      b = u - 544; meta = true;
      zrow0 = M; pos0 = 0; keybase = 0; ldvt = LKP;
      Kd = (u16*)(ws + W_KP) + (long)b * LKP * 320; VT = (u16*)(ws + W_VTP) + (long)b * 256 * LKP;
      okv = p.out + O_KVP + (long)b * 16400 * 256; ope = p.out + O_PEP + (long)b * 16400 * 64;
    }
    const int w0 = lane < 32 ? 2 : 4, w1 = lane < 32 ? 8 : 16;
    auto urow = [&](int e) -> const float* {
      if (!sample) return e < 16 ? UP + (long)(M + e) * 512 : UP + (long)(b * SEQ + e - 16) * 512;
      return e < 15 ? p.cache_pool + ((long)b * 15 + e) * 512 : UP + (long)(MP + b * 64 + e - 15) * 512;
    };
    float4 S0 = make_float4(0, 0, 0, 0), S1 = S0;
    const int e0 = sample ? 15 + w * 8 : 16 + (zrow0 - b * SEQ) + w * 8;
    if (!meta) {
      for (int k = 1; k <= 16; ++k) {
        const int e = e0 - k;
        if (e >= 0) {
          const float* ur = urow(e);
          if (k <= w0) { const float4 v = *(const float4*)(ur + 4 * lane); S0.x += v.x; S0.y += v.y; S0.z += v.z; S0.w += v.w; }
          if (k <= w1) { const float4 v = *(const float4*)(ur + 256 + 4 * lane); S1.x += v.x; S1.y += v.y; S1.z += v.z; S1.w += v.w; }
        }
      }
    }
    for (int i = 0; i < 8; ++i) {
      const int r = w * 8 + i;
      const bool valid = !meta || r < 16;
      const long zrow = zrow0 + r;
      float4 x = valid ? *(const float4*)(Z + zrow * ZW + QL + 4 * lane) : make_float4(0, 0, 0, 0);
      float ss = wave_sum(x.x * x.x + x.y * x.y + x.z * x.z + x.w * x.w);
      float rs = rsqrtf(ss * (1.f / 256.f) + EPS);
      const float4 gk = *(const float4*)(p.g_kv + 4 * lane);
      float4 c = make_float4(x.x * rs * gk.x, x.y * rs * gk.y, x.z * rs * gk.z, x.w * rs * gk.w);
      uint2 cb; cb.x = cvtpk(c.x, c.y); cb.y = cvtpk(c.z, c.w);
      *(uint2*)(Kd + r * 320 + 4 * lane) = cb;
      if (valid) *(float4*)(okv + (long)r * 256 + 4 * lane) = c;
      if (lane < 32) {
        float o1 = 0.f, o2 = 0.f;
        if (valid) {
          const float x1 = Z[zrow * ZW + 640 + lane], x2 = Z[zrow * ZW + 672 + lane];
          const float2 cs = TAB[(pos0 + r) * 32 + lane];
          o1 = x1 * cs.x - x2 * cs.y; o2 = x1 * cs.y + x2 * cs.x;
          ope[(long)r * 64 + lane] = o1; ope[(long)r * 64 + 32 + lane] = o2;
        }
        *(unsigned*)(Kd + r * 320 + 256 + 2 * lane) = cvtpk(o1, o2);
      }
      if (!meta) {
        float2 q[3];
#pragma unroll
        for (int j = 0; j < 3; ++j) q[j] = *(const float2*)(Z + zrow * ZW + 2 * lane + 128 * j);
        float qs = 0;
#pragma unroll
        for (int j = 0; j < 3; ++j) qs += q[j].x * q[j].x + q[j].y * q[j].y;
        qs = wave_sum(qs);
        const float qr = rsqrtf(qs * (1.f / 384.f) + EPS);
#pragma unroll
        for (int j = 0; j < 3; ++j) {
          const float2 gq = *(const float2*)(p.g_q + 2 * lane + 128 * j);
          *(unsigned*)((u16*)(ws + X_QN_) + zrow * 384 + 2 * lane + 128 * j) = cvtpk(q[j].x * qr * gq.x, q[j].y * qr * gq.y);
        }
        const int e = e0 + i;
        const float* ur = urow(e);
        const float4 u0 = *(const float4*)(ur + 4 * lane), u1 = *(const float4*)(ur + 256 + 4 * lane);
        float4 d0 = make_float4(0, 0, 0, 0), d1 = d0;
        if (e - w0 >= 0) d0 = *(const float4*)(urow(e - w0) + 4 * lane);
        if (e - w1 >= 0) d1 = *(const float4*)(urow(e - w1) + 256 + 4 * lane);
        S0.x += u0.x - d0.x; S0.y += u0.y - d0.y; S0.z += u0.z - d0.z; S0.w += u0.w - d0.w;
        S1.x += u1.x - d1.x; S1.y += u1.y - d1.y; S1.z += u1.z - d1.z; S1.w += u1.w - d1.w;
        const float i0 = 1.f / (float)w0, i1 = 1.f / (float)w1;
        uint2 pa, pb;
        pa.x = cvtpk(S0.x * i0 - u0.x, S0.y * i0 - u0.y); pa.y = cvtpk(S0.z * i0 - u0.z, S0.w * i0 - u0.w);
        pb.x = cvtpk(S1.x * i1 - u1.x, S1.y * i1 - u1.y); pb.y = cvtpk(S1.z * i1 - u1.z, S1.w * i1 - u1.w);
        *(uint2*)((u16*)(ws + X_PIN) + zrow * 512 + 4 * lane) = pa;
        *(uint2*)((u16*)(ws + X_PIN) + zrow * 512 + 256 + 4 * lane) = pb;
        if (opool != nullptr && r >= 49) {
          *(float4*)(opool + (long)(r - 49) * 512 + 4 * lane) = u0;
          *(float4*)(opool + (long)(r - 49) * 512 + 256 + 4 * lane) = u1;
        }
      }
    }
  }
}

DEVI int row_pos(int row) { return row < MP ? 16 + (row & (SEQ - 1)) : PAST + ((row - MP) & 63); }

DEVI void phase3(const Params& p, char* lds, const int wvs) {
  const int tid = fresh_tid(wvs);
  char* ws = p.ws;
  const int lane = tid & 63, wid = tid >> 6, wr = wid >> 1, wc = wid & 1, r32 = lane & 31, hi = lane >> 5;
  TILE_LOOP(t, (M / 256) * 4) {
    const int tm = t >> 2, g = t & 3;
    f32x16 acc[2][2]; zero_acc(acc);
    gemm_main<2, 2, 4, 2>(acc, (const u16*)(ws + X_PIN) + (long)tm * 256 * 512 + g * 128, 512, (const u16*)(ws + W_WGT) + g * 16384, 128, 128, lds, tid);
    char* stg = stage_base(lds, wid);
#pragma unroll
    for (int m = 0; m < 2; ++m)
#pragma unroll
      for (int n = 0; n < 2; ++n) {
        const float sc = p.pool_scale[g * 128 + wc * 64 + n * 32 + r32];
#pragma unroll
        for (int r = 0; r < 16; ++r) stage_put(stg, 32 * m + crow(r, hi), 32 * n + r32, acc[m][n][r] * sc);
      }
    stage_flush(stg, (u16*)(ws + W_XN) + (long)(tm * 256 + wr * 64) * 512 + g * 128 + wc * 64, 512, lane);
  }
}

struct EpiQ {
  static constexpr bool PERM = true, AFTER_DRAIN = false;
  u16* QB; const float2* TAB;
  __device__ __forceinline__ void operator()(const pg8::f32x4 (&acc)[2][2][4][2], const pg8::Unit& u, int wr, int wc, int fr_, int fq_) const {
    const int l_ = fresh_tid(0), fr = l_ & 15, fq = l_ >> 4;
    (void)fr_; (void)fq_;
#pragma unroll
    for (int bj = 0; bj < 2; ++bj) {
      const int c8 = PG8_COL8(u, bj), grp = u.pn * 256 + bj * 128 + wc * 32, head = grp / 320, hcol = grp - head * 320;
#pragma unroll
      for (int ai = 0; ai < 2; ++ai)
#pragma unroll
        for (int m = 0; m < 4; ++m) {
          const int row = PG8_ROW(u, ai, m);
          const pg8::f32x4 v0 = acc[ai][bj][m][0], v1 = acc[ai][bj][m][1];
          u32x4 w;
          if (hcol < 256) {
            w = (u32x4){cvtpk(v0[0] * QS, v0[1] * QS), cvtpk(v0[2] * QS, v0[3] * QS), cvtpk(v1[0] * QS, v1[1] * QS), cvtpk(v1[2] * QS, v1[3] * QS)};
          } else {
            const float2* tp = TAB + row_pos(row) * 32 + ((c8 - head * 320 - 256) >> 1);
#pragma unroll
            for (int i = 0; i < 4; ++i) {
              const float2 cs = tp[i];
              const float x1 = i < 2 ? v0[2 * i] : v1[2 * i - 4], x2 = i < 2 ? v0[2 * i + 1] : v1[2 * i - 3];
              w[i] = cvtpk((x1 * cs.x - x2 * cs.y) * QS, (x1 * cs.y + x2 * cs.x) * QS);
              __builtin_amdgcn_sched_barrier(0);
            }
          }
          *(u32x4*)(QB + (long)row * 2560 + c8) = w;
          __builtin_amdgcn_sched_barrier(0);
        }
    }
  }
};
DEVI void phase3q(const Params& p, char* lds, const int wvs) {
  const int tid = fresh_tid(wvs);
  char* ws = p.ws;
  __syncthreads();
  EpiQ E; E.QB = (u16*)(ws + X_QB); E.TAB = (const float2*)(ws + W_TAB);
  run_pg8(lds, (const u16*)(ws + X_QN_), (const u16*)(ws + W_COMBT), M, 2560, 384, E, tid);
}

using s16x4 = __attribute__((ext_vector_type(4))) short;
template <int OFF> DEVI s16x4 tr_read(int a) { s16x4 r; asm volatile("ds_read_b64_tr_b16 %0, %1 offset:%2" : "=&v"(r) : "v"(a), "i"(OFF) : "memory"); return r; }
struct TrSet { s16x4 lo[2], hi[2]; };
template <int D0> DEVI void tr_load2(TrSet& s, int a0, int a1) {
  constexpr int B = (D0 >> 1) * 8192;
  s.lo[0] = tr_read<B + 0 * 2048>(a0);        s.hi[0] = tr_read<B + 0 * 2048 + 1024>(a1);
  s.lo[1] = tr_read<B + 1 * 2048>(a0);        s.hi[1] = tr_read<B + 1 * 2048 + 1024>(a1);
}
DEVI bf16x8 pk8(s16x4 l, s16x4 h) { return (bf16x8){l[0], l[1], l[2], l[3], h[0], h[1], h[2], h[3]}; }
DEVI void pv2(f32x16& o, const TrSet& s, const bf16x8 (&pf)[2]) {
#pragma unroll
  for (int f = 0; f < 2; ++f) o = mfma(pk8(s.lo[f], s.hi[f]), pf[f], o);
}
#define WAIT_LGKM(n) asm volatile("s_waitcnt lgkmcnt(" #n ")" ::: "memory")
#define SBAR() __builtin_amdgcn_sched_barrier(0)
constexpr int KBUF = 40960;

constexpr int XP_OFF = 3 * KBUF;
constexpr int XM_OFF = XP_OFF + 8 * 2048;
constexpr int XF_OFF = XM_OFF + 8 * 256;
constexpr int ATT_LDS = XF_OFF + 64;
DEVI void raw_barrier() { asm volatile("s_waitcnt lgkmcnt(0)" ::: "memory"); __builtin_amdgcn_s_barrier(); asm volatile("" ::: "memory"); }

DEVI bool attn_job(int& seq, const bool preset, const float mref, const u16* __restrict__ Q0, const u16* __restrict__ Kt, int ntiles, bool maskfirst, u16* __restrict__ O0, char* lds, const int tid_in) {
  int tid = tid_in; asm volatile("" : "+v"(tid));
  const int lane = tid & 63, w = tid >> 6, r32 = lane & 31, hi = lane >> 5;
  const int pr = w >> 1, u = w & 1;
  const int h = 2 * pr + (r32 >> 4), qi = r32 & 15;
  const u16* qp = Q0 + ((long)qi * 8 + h) * 320 + hi * 8;
  bf16x8 qf[20];
#pragma unroll
  for (int ks = 0; ks < 20; ++ks) qf[ks] = *(const bf16x8*)(qp + ks * 16);
  f32x16 O[4];
#pragma unroll
  for (int d = 0; d < 4; ++d)
#pragma unroll
    for (int r = 0; r < 16; ++r) O[d][r] = 0.f;
  float mrun = mref, lrun = 0.f;
  const int fch = (tid & 7) ^ ((((tid >> 4) & 1) << 2) | ((tid >> 5) & 3));
  const u16* ksrc = Kt + (long)(tid >> 3) * 320 + fch * 8;
  char* lw = lds + w * 1024;
#define A_ISSUE(t_, buf_) do { _Pragma("unroll") for (int i_ = 0; i_ < 5; ++i_) glds16(ksrc + (long)(t_) * 64 * 320 + i_ * 64, lw + (buf_) * KBUF + i_ * 8192); } while (0)
  const int fr = ((r32 & 2) << 1) | ((r32 >> 2) & 3);
  const int frh = (fr ^ hi) * 16;
  const int kk = (lane & 15) >> 2, vh = (lane >> 4) & 1, cl = (lane & 3) >> 1;
  int tb[2][2];
#pragma unroll
  for (int dd = 0; dd < 2; ++dd)
#pragma unroll
    for (int hf = 0; hf < 2; ++hf)
      tb[dd][hf] = (int)(uintptr_t)lds + u * 16384 + (kk + 4 * hi) * 128 + ((((dd ^ (kk >> 1)) << 2) | ((2 * vh + cl) ^ (2 * hf + hi))) * 16) + (lane & 1) * 8;
#define xp_own (lds + XP_OFF + w * 2048 + lane * 32)
#define xp_oth (lds + XP_OFF + (w ^ 1) * 2048 + lane * 32)
#define xm_own ((float*)(lds + XM_OFF) + w * 64 + lane)
#define xm_oth ((const float*)(lds + XM_OFF) + (w ^ 1) * 64 + lane)
  A_ISSUE(0, 0);
  if (ntiles > 1) { A_ISSUE(1, 1); asm volatile("s_waitcnt vmcnt(5)" ::: "memory"); } else { WAIT_VM0(); }
  raw_barrier();
  int cbuf = 0;
#pragma unroll 1
  for (int t = 0; t < ntiles; ++t) {
    const bool more = t + 2 < ntiles;
    const int nbuf = cbuf == 0 ? 2 : cbuf - 1;
    if (more) A_ISSUE(t + 2, nbuf);
    const char* kb = lds + cbuf * KBUF;
    const char* ka = kb + (32 * u + r32) * 128;
    f32x16 s;
#pragma unroll
    for (int r = 0; r < 16; ++r) s[r] = 0.f;
    {
      const int kaddr = (int)(uintptr_t)ka;
      int kad[4];
#pragma unroll
      for (int j = 0; j < 4; ++j) kad[j] = kaddr + ((j * 32) ^ frh);
      bf16x8 fk[4];
#pragma unroll
      for (int ks = 0; ks < 3; ++ks) fk[ks] = lds_rd128(kad[ks & 3], (ks >> 2) * 8192);
#pragma unroll
      for (int ks = 0; ks < 20; ++ks) {
        if (ks + 3 < 20) fk[(ks + 3) & 3] = lds_rd128(kad[(ks + 3) & 3], ((ks + 3) >> 2) * 8192);
        const int ahead = (19 - ks) < 3 ? (19 - ks) : 3;
        if (ahead == 3) WAIT_LGKM(3); else if (ahead == 2) WAIT_LGKM(2); else if (ahead == 1) WAIT_LGKM(1); else WAIT_LGKM(0);
        SBAR();
        s = mfma(fk[ks & 3], qf[ks], s);
        SBAR();
      }
    }
    if (maskfirst && t == 0) {
#pragma unroll
      for (int r = 0; r < 16; ++r) { if (32 * u + crow(r, hi) >= 16) s[r] = -1e30f; }
    }
    if (t == 0 && !preset) {
      float mx = s[0];
#pragma unroll
      for (int r = 1; r < 16; ++r) mx = fmaxf(mx, s[r]);
      mx = fmaxf(mx, __shfl_xor(mx, 32, 64));
      *xm_own = mx;
      raw_barrier();
      mrun = fmaxf(mx, *xm_oth);
    }
    float ps = 0.f;
#pragma unroll
    for (int r = 0; r < 16; ++r) { s[r] = __builtin_amdgcn_exp2f(s[r] - mrun); ps += s[r]; }
    lrun += ps;
    u32x4 own0 = {cvtpk(s[0], s[1]), cvtpk(s[2], s[3]), cvtpk(s[4], s[5]), cvtpk(s[6], s[7])};
    u32x4 own1 = {cvtpk(s[8], s[9]), cvtpk(s[10], s[11]), cvtpk(s[12], s[13]), cvtpk(s[14], s[15])};
    *(u32x4*)xp_own = own0; *(u32x4*)(xp_own + 16) = own1;
    ++seq;
    asm volatile("s_waitcnt lgkmcnt(0)" ::: "memory");
    if (lane == 0) *(volatile int*)(lds + XF_OFF + w * 4) = seq;
    bf16x8 pf[2] = {__builtin_bit_cast(bf16x8, own0), __builtin_bit_cast(bf16x8, own1)};
    const int bo = cbuf * KBUF;
    {
      const int e0 = tb[0][0] + bo + u * 4096, e1 = tb[0][1] + bo + u * 4096, o0 = tb[1][0] + bo + u * 4096, o1 = tb[1][1] + bo + u * 4096;
      TrSet A;
      SBAR();
      tr_load2<0>(A, e0, e1); WAIT_LGKM(0); SBAR(); pv2(O[0], A, pf); SBAR();
      tr_load2<1>(A, o0, o1); WAIT_LGKM(0); SBAR(); pv2(O[1], A, pf); SBAR();
      tr_load2<2>(A, e0, e1); WAIT_LGKM(0); SBAR(); pv2(O[2], A, pf); SBAR();
      tr_load2<3>(A, o0, o1); WAIT_LGKM(0); SBAR(); pv2(O[3], A, pf); SBAR();
    }
    {
      const int faddr = (int)(uintptr_t)lds + XF_OFF + (w ^ 1) * 4;
      for (int spin = 0; spin < (1 << 22); ++spin) {
        int v; asm volatile("ds_read_b32 %0, %1\n\ts_waitcnt lgkmcnt(0)" : "=v"(v) : "v"(faddr) : "memory");
        if (__builtin_amdgcn_readfirstlane(v) - seq >= 0) break;
        __builtin_amdgcn_s_sleep(1);
      }
    }
    {
      const u32x4 oth0 = *(const u32x4*)xp_oth, oth1 = *(const u32x4*)(xp_oth + 16);
      bf16x8 pg[2] = {__builtin_bit_cast(bf16x8, oth0), __builtin_bit_cast(bf16x8, oth1)};
      const int uo = (u ^ 1) * 4096;
      const int e0 = tb[0][0] + bo + uo, e1 = tb[0][1] + bo + uo, o0 = tb[1][0] + bo + uo, o1 = tb[1][1] + bo + uo;
      TrSet A;
      asm volatile("s_waitcnt lgkmcnt(0)" ::: "memory");
      SBAR();
      tr_load2<0>(A, e0, e1); WAIT_LGKM(0); SBAR(); pv2(O[0], A, pg); SBAR();
      tr_load2<1>(A, o0, o1); WAIT_LGKM(0); SBAR(); pv2(O[1], A, pg); SBAR();
      tr_load2<2>(A, e0, e1); WAIT_LGKM(0); SBAR(); pv2(O[2], A, pg); SBAR();
      tr_load2<3>(A, o0, o1); WAIT_LGKM(0); SBAR(); pv2(O[3], A, pg); SBAR();
    }
    if (more) asm volatile("s_waitcnt vmcnt(5)" ::: "memory"); else WAIT_VM0();
    raw_barrier();
    cbuf = cbuf == 2 ? 0 : cbuf + 1;
  }
#undef A_ISSUE
  {
    const int badw = __any(!(lrun < 1.1805916e21f)) ? 1 : 0;
    volatile int* bf = (volatile int*)(lds + XF_OFF + 32);
    if (lane == 0) bf[w] = badw;
    __syncthreads();
    const int anyb = bf[0] | bf[1] | bf[2] | bf[3] | bf[4] | bf[5] | bf[6] | bf[7];
    __syncthreads();
    if (anyb) return true;
  }
  float lsum = lrun + __shfl_xor(lrun, 32, 64);
  *xm_own = lsum;
  __syncthreads();
  const float inv = 1.f / (lsum + *xm_oth);
  __syncthreads();
  u16* op = O0 + ((long)qi * 8 + h) * 256 + 128 * u + 4 * hi;
#pragma unroll
  for (int d = 0; d < 4; ++d)
#pragma unroll
    for (int g = 0; g < 4; ++g) {
      uint2 ov; ov.x = cvtpk(O[d][4 * g] * inv, O[d][4 * g + 1] * inv); ov.y = cvtpk(O[d][4 * g + 2] * inv, O[d][4 * g + 3] * inv);
      *(uint2*)(op + d * 32 + g * 8) = ov;
    }
  return false;
#undef xp_own
#undef xp_oth
#undef xm_own
#undef xm_oth
}

DEVI float attn_maxpass(const u16* __restrict__ Q0, const u16* __restrict__ Kt, int ntiles, bool maskfirst, char* lds, const int tid_in) {
  int tid = tid_in; asm volatile("" : "+v"(tid));
  const int lane = tid & 63, w = tid >> 6, r32 = lane & 31, hi = lane >> 5;
  const int h = 2 * (w >> 1) + (r32 >> 4), qi = r32 & 15;
  const u16* qp = Q0 + ((long)qi * 8 + h) * 320 + hi * 8;
  const int fch = (tid & 7) ^ ((((tid >> 4) & 1) << 2) | ((tid >> 5) & 3));
  const u16* ksrc = Kt + (long)(tid >> 3) * 320 + fch * 8;
  char* lw = lds + w * 1024;
  const int fr = ((r32 & 2) << 1) | ((r32 >> 2) & 3);
  float mrun = -1e30f;
#pragma unroll 1
  for (int t = 0; t < ntiles; ++t) {
#pragma unroll
    for (int i = 0; i < 5; ++i) glds16(ksrc + (long)t * 64 * 320 + i * 64, lw + i * 8192);
    WAIT_VM0(); __syncthreads();
    f32x16 s0, s1;
#pragma unroll
    for (int r = 0; r < 16; ++r) { s0[r] = 0.f; s1[r] = 0.f; }
    const char* ka = lds + r32 * 128;
#pragma unroll 2
    for (int ks = 0; ks < 20; ++ks) {
      const bf16x8 q = *(const bf16x8*)(qp + ks * 16);
      const int off = (ks >> 2) * 8192 + ((2 * (ks & 3) + hi) ^ fr) * 16;
      s0 = mfma(*(const bf16x8*)(ka + off), q, s0);
      s1 = mfma(*(const bf16x8*)(ka + 32 * 128 + off), q, s1);
    }
    if (maskfirst && t == 0) {
#pragma unroll
      for (int r = 0; r < 16; ++r) { if (crow(r, hi) >= 16) s0[r] = -1e30f; s1[r] = -1e30f; }
    }
#pragma unroll
    for (int r = 0; r < 16; ++r) mrun = fmaxf(mrun, fmaxf(s0[r], s1[r]));
    __syncthreads();
  }
  return fmaxf(mrun, __shfl_xor(mrun, 32, 64));
}

static_assert(ATT_LDS <= LDS_BYTES && 2 * 512 * 128 <= LDS_BYTES, "LDS");
DEVI void phase5(const Params& p, char* lds, const int wvs) {
  const int tid = fresh_tid(wvs);
  char* ws = p.ws;
  const u16* QB = (const u16*)(ws + X_QB); u16* OL = (u16*)(ws + X_OL);
  if (tid < 8) *(volatile int*)(lds + XF_OFF + tid * 4) = 0;
  __syncthreads();
  int seq = 0;
  const int ngrp = gridDim.x >> 2;
  const int xcd = blockIdx.x & 7, idx = blockIdx.x >> 3;
  const int grp = xcd + 8 * (idx >> 2), j = idx & 3;
  const int nsamp = blockIdx.x < 128 ? (int)((128 - blockIdx.x + gridDim.x - 1) / gridDim.x) : 0;
  for (int jj = -nsamp;; ++jj) {
    long qrow0; const u16* Kt; int nt; bool mask;
    if (jj < 0) {
      const int sit = (int)blockIdx.x + (jj + nsamp) * (int)gridDim.x;
      const int bd = sit >> 2, js = sit & 3;
      qrow0 = MP + bd * 64 + js * 16; Kt = (const u16*)(ws + W_KS) + (long)bd * LKS * 320; nt = 17; mask = false;
    } else {
      const int k = jj * ngrp + ((jj & 1) ? ngrp - 1 - grp : grp);
      if (k >= 512) break;
      const int c = 255 - (k >> 1), b = k & 1;
      qrow0 = (long)b * SEQ + c * 64 + j * 16; Kt = (const u16*)(ws + W_KP) + (long)b * LKP * 320; nt = c + 2; mask = true;
    }
    bool preset = false; float mref = -1e30f;
    while (true) {
      const bool bad = attn_job(seq, preset, mref, QB + qrow0 * 8 * 320, Kt, nt, mask, OL + qrow0 * 2048, lds, tid);
      if (!bad || preset) break;
      mref = attn_maxpass(QB + qrow0 * 8 * 320, Kt, nt, mask, lds, tid);
      preset = true;
    }
  }
}

DEVI void phase6(const Params& p, char* lds, const int wvs) {
  const int tid = fresh_tid(wvs);
  char* ws = p.ws;
  const int lane = tid & 63, wid = tid >> 6, wr = wid >> 1, wc = wid & 1, r32 = lane & 31, hi = lane >> 5;
  u16* OB = (u16*)(ws + X_OB);
  TILE_LOOP(tile, (M / 256) * 8) {
    const int tm = tile >> 3, h = tile & 7;
    f32x16 acc[2][2]; zero_acc(acc);
    gemm_main_reg<2, 2, 4, 2, 2>(acc, (const u16*)(ws + X_OL) + (long)tm * 256 * 2048 + h * 256, 2048, (const u16*)(ws + W_WUVT) + (long)h * 128 * 256, 256, 256, lds, tid);
    char* stg = stage_base(lds, wid);
#pragma unroll
    for (int m = 0; m < 2; ++m)
#pragma unroll
      for (int n = 0; n < 2; ++n)
#pragma unroll
        for (int r = 0; r < 16; ++r) stage_put(stg, 32 * m + crow(r, hi), 32 * n + r32, acc[m][n][r]);
    stage_flush(stg, OB + (long)(tm * 256 + wr * 64) * 1024 + h * 128 + wc * 64, 1024, lane);
  }
}

DEVI void phase7(const Params& p, char* lds, const int wvs) {
  const int tid = fresh_tid(wvs);
  char* ws = p.ws;
  const int lane = tid & 63, wid = tid >> 6, wr = wid >> 1, wc = wid & 1, r32 = lane & 31, hi = lane >> 5;
  const u16* G = (const u16*)p.out; u16* MG = (u16*)(ws + X_MG);
  TILE_LOOP(tile, (M / 256) * 8) {
    const int tm = tile >> 3, tn = tile & 7;
    f32x16 acc[2][2], acp[2][2]; zero_acc(acc); zero_acc(acp);
    gemm_main<2, 2, 4, 2, 1>(acc, (const u16*)(ws + X_OB) + (long)tm * 256 * 1024, 1024, (const u16*)(ws + W_WABT) + (long)tn * 128 * 1024, 1024, 1024, lds, tid);
    gemm_main<2, 2, 4, 2, 1>(acp, (const u16*)(ws + W_XN) + (long)tm * 256 * 512, 512, (const u16*)(ws + W_WPBT) + (long)tn * 128 * 512, 512, 512, lds, tid);
    char* stg = stage_base(lds, wid);
#pragma unroll
    for (int m = 0; m < 2; ++m)
#pragma unroll
      for (int n = 0; n < 2; ++n) {
        const int brow = tm * 256 + wr * 64 + m * 32, col = tn * 128 + wc * 64 + n * 32 + r32;
#pragma unroll
        for (int r = 0; r < 16; ++r) {
          const long row = brow + crow(r, hi);
          const float ga = __uint_as_float((unsigned)G[row * 2048 + col] << 16), gp = __uint_as_float((unsigned)G[row * 2048 + 1024 + col] << 16);
          stage_put(stg, 32 * m + crow(r, hi), 32 * n + r32, ga * acc[m][n][r] + gp * acp[m][n][r]);
        }
        SBAR();
      }
    stage_flush(stg, MG + (long)(tm * 256 + wr * 64) * 1024 + tn * 128 + wc * 64, 1024, lane);
  }
}

DEVI void phase8(const Params& p, char* lds, const int wvs) {
  const int tid = fresh_tid(wvs);
  char* ws = p.ws;
  {
    const int lane = tid & 63, wid = tid >> 6, wr = wid >> 2, wc = wid & 3, r32 = lane & 31, hi = lane >> 5;
    TILE_LOOP(tile, 256) {
      const int tm = tile >> 3, tn = tile & 7;
      f32x16 acc[1][1]; zero_acc(acc);
      gemm_main_reg<1, 1, 2, 4, 2>(acc, (const u16*)(ws + X_MG) + (long)(MP + tm * 64) * 1024, 1024, (const u16*)(ws + W_WOT) + (long)tn * 128 * 1024, 1024, 1024, lds, tid);
      const int col = tn * 128 + wc * 32 + r32;
#pragma unroll
      for (int r = 0; r < 16; ++r) {
        const long srow = tm * 64 + wr * 32 + crow(r, hi);
        p.out[(MP + srow) * 1024 + col] = p.x_sample[srow * 1024 + col] + acc[0][0][r];
      }
    }
  }
  EpiP8 E; E.Y = p.out; E.xp = p.x_prompt; E.xs = p.x_sample;
  run_pg8(lds, (const u16*)(ws + X_MG), (const u16*)(ws + W_WOT), MP, 1024, 1024, E, tid);
}

DEVI void phase9(const Params& p, const int wvs) {
  const int tid = fresh_tid(wvs);
  const int lane = tid & 63, w = tid >> 6;
  for (int r0 = blockIdx.x * 32 + w; r0 < M; r0 += gridDim.x * 32) {
    const float* s[4]; char* d[4]; bool ok[4], z[4];
#pragma unroll
    for (int k = 0; k < 4; ++k) { const int row = r0 + 8 * k; ok[k] = row < M; z[k] = false; s[k] = p.out + (long)row * 1024; d[k] = (char*)((u16*)(p.ws + W_XN) + (long)row * 1024); }
    rms_rows<4, true>(s, ok, z, p.g_ffn, d, lane);
  }
}
DEVI void phase12(const Params& p, const int wvs) {
  const int tid = fresh_tid(wvs);
  const int lane = tid & 63, w = tid >> 6;
  for (int r0 = blockIdx.x * 32 + w; r0 < M; r0 += gridDim.x * 32) {
    const float* s[4]; char* d[4]; bool ok[4], z[4];
#pragma unroll
    for (int k = 0; k < 4; ++k) { const int row = r0 + 8 * k; ok[k] = row < M; z[k] = false; s[k] = p.out + (long)row * 1024; d[k] = (char*)(p.out + (long)row * 1024); }
    rms_rows<4, false>(s, ok, z, p.g_final, d, lane);
  }
}

DEVI void phase10(const Params& p, char* lds, const int wvs) {
  const int tid = fresh_tid(wvs);
  char* ws = p.ws;
  EpiP10 E; E.U = (u16*)(ws + X_U);
  run_pg8(lds, (const u16*)(ws + W_XN), (const u16*)(ws + W_WUPT), M, 4096, 1024, E, tid);
}

DEVI void phase11(const Params& p, char* lds, const int wvs) {
  const int tid = fresh_tid(wvs);
  char* ws = p.ws;
  {
    const int lane = tid & 63, wid = tid >> 6, wr = wid >> 2, wc = wid & 3, r32 = lane & 31, hi = lane >> 5;
    TILE_LOOP(tile, 256) {
      const int tm = tile >> 3, tn = tile & 7;
      f32x16 acc[1][1]; zero_acc(acc);
      gemm_main_reg<1, 1, 2, 4, 2>(acc, (const u16*)(ws + X_U) + (long)(MP + tm * 64) * 4096, 4096, (const u16*)(ws + W_WDT) + (long)tn * 128 * 4096, 4096, 4096, lds, tid);
      const int col = tn * 128 + wc * 32 + r32;
#pragma unroll
      for (int r = 0; r < 16; ++r) { float* y = p.out + (long)(MP + tm * 64 + wr * 32 + crow(r, hi)) * 1024 + col; *y = *y + acc[0][0][r]; }
    }
  }
  EpiP11 E; E.Y = p.out;
  run_pg8(lds, (const u16*)(ws + X_U), (const u16*)(ws + W_WDT), MP, 1024, 4096, E, tid);
}

__global__ void __launch_bounds__(512) fwd_megakernel(Params p) {
  extern __shared__ __attribute__((aligned(16))) char lds[];
  const int wvs = __builtin_amdgcn_readfirstlane(threadIdx.x >> 6);
  phase0(p, lds, wvs);  cg::this_grid().sync();
  phase1(p, lds, wvs);  grid_barrier(p.ws, 1, wvs);
  phase2w(p, lds, wvs); phase2(p, lds, wvs);  grid_barrier(p.ws, 2, wvs);
  phase3(p, lds, wvs);  phase3q(p, lds, wvs);  grid_barrier(p.ws, 3, wvs);
  phase5(p, lds, wvs);  grid_barrier(p.ws, 4, wvs);
  phase6(p, lds, wvs);  grid_barrier(p.ws, 5, wvs);
  phase7(p, lds, wvs);  grid_barrier(p.ws, 6, wvs);
  phase8(p, lds, wvs);  grid_barrier(p.ws, 7, wvs);
  phase9(p, wvs);       grid_barrier(p.ws, 8, wvs);
  phase10(p, lds, wvs); grid_barrier(p.ws, 9, wvs);
  phase11(p, lds, wvs); grid_barrier(p.ws, 10, wvs);
  phase12(p, wvs);
}

extern "C" void kernel_launch(void* const* d_in, const int* in_sizes, int n_in, void* d_out, int out_size, void* d_ws, size_t ws_size, hipStream_t stream) {
  static int grid_blocks = 0;
  if (!grid_blocks) {
    if (ws_size < WS_LIMIT + 4096) { fprintf(stderr, "kernel_launch: ws too small: %zu\n", ws_size); return; }
    if (hipFuncSetAttribute((const void*)fwd_megakernel, hipFuncAttributeMaxDynamicSharedMemorySize, LDS_BYTES) != hipSuccess) {
      fprintf(stderr, "kernel_launch: hipFuncSetAttribute failed\n"); return; }
    int dev = 0, cus = 0, per_cu = 0;
    hipGetDevice(&dev);
    hipDeviceGetAttribute(&cus, hipDeviceAttributeMultiprocessorCount, dev);
    hipOccupancyMaxActiveBlocksPerMultiprocessor(&per_cu, fwd_megakernel, 512, LDS_BYTES);
    if (per_cu < 1) { fprintf(stderr, "kernel_launch: occupancy 0\n"); return; }
    grid_blocks = cus - cus % 32;
    if (grid_blocks < 32) { fprintf(stderr, "kernel_launch: too few CUs\n"); grid_blocks = 0; return; }
  }
  Params p{};
  const float** f = (const float**)&p;
  for (int i = 0; i < 22; ++i) f[i] = (const float*)d_in[i];
  p.out = (float*)d_out; p.ws = (char*)d_ws;
  (void)hipMemsetAsync((char*)d_ws + WS_BAR, 0, 256, stream);
  void* args[] = {&p};
  hipError_t e = hipLaunchCooperativeKernel((void*)fwd_megakernel, dim3(grid_blocks), dim3(512), args, LDS_BYTES, stream);
  if (e != hipSuccess) fprintf(stderr, "cooperative launch failed: %s (grid %d)\n", hipGetErrorString(e), grid_blocks);
}
```

```cpp
#include <hip/hip_runtime.h>
#include <hip/hip_cooperative_groups.h>
#include <cstdio>
#include <cstdint>
namespace cg = cooperative_groups;

#define DEVI __device__ __forceinline__
typedef unsigned short u16;
using bf16x8 = __attribute__((ext_vector_type(8))) short;
using f32x16 = __attribute__((ext_vector_type(16))) float;
using u32x4 = __attribute__((ext_vector_type(4))) unsigned;

constexpr int DM = 1024, SEQ = 16384, PAST = 1024, QL = 384, KVL = 256, ROPE = 64, DPOOL = 512, DFF = 4096;
constexpr int DIN = 3264, DIN_PAD = 3328;
constexpr int MP = 2 * SEQ;
constexpr int MS = 32 * 64;
constexpr int M = MP + MS;
constexpr int RALL = M + 256;
constexpr int LKP = 64 + SEQ;
constexpr int LKS = PAST + 64;
constexpr float EPS = 1e-6f;
constexpr float QS = 0.07216878364870322f * 1.4426950408889634f;
constexpr int ZW = 704;

constexpr size_t al256(size_t x) { return (x + 255) / 256 * 256; }
constexpr size_t W_WINT = 0;
constexpr size_t W_WQT  = W_WINT + (size_t)DIN_PAD * 1024 * 2;
constexpr size_t W_WUK  = W_WQT + (size_t)1536 * 384 * 2;
constexpr size_t W_WUVT = W_WUK + (size_t)256 * 1024 * 2;
constexpr size_t W_WABT = W_WUVT + (size_t)1024 * 256 * 2;
constexpr size_t W_WGT  = W_WABT + (size_t)1024 * 1024 * 2;
constexpr size_t W_WPBT = W_WGT + (size_t)4 * 128 * 128 * 2;
constexpr size_t W_WOT  = W_WPBT + (size_t)1024 * 512 * 2;
constexpr size_t W_WUPT = W_WOT + (size_t)1024 * 1024 * 2;
constexpr size_t W_WDT  = W_WUPT + (size_t)4096 * 1024 * 2;
constexpr size_t W_TAB  = W_WDT + (size_t)1024 * 4096 * 2;
constexpr size_t W_XN   = al256(W_TAB + (size_t)16400 * 32 * 8);
constexpr size_t W_KP   = al256(W_XN + (size_t)RALL * 1024 * 2);
constexpr size_t W_VTP  = W_KP + (size_t)2 * LKP * 320 * 2;
constexpr size_t W_COMBT = W_VTP;
constexpr size_t W_WQN  = W_VTP + (size_t)4 * 1024 * 1024;
constexpr size_t W_WUVN = W_VTP + (size_t)6 * 1024 * 1024;
constexpr size_t W_WPT  = W_VTP + (size_t)8 * 1024 * 1024;
constexpr size_t W_KS   = W_VTP + (size_t)2 * 256 * LKP * 2;
constexpr size_t W_VTS  = W_KS + (size_t)32 * LKS * 320 * 2;
constexpr size_t W_X    = al256(W_VTS + (size_t)32 * 256 * LKS * 2);
constexpr size_t X_Z    = W_X;
constexpr size_t X_UP   = X_Z + (size_t)RALL * ZW * 4;
constexpr size_t X_QB   = W_X;
constexpr size_t X_QN_  = W_X + (size_t)190 * 1024 * 1024;
constexpr size_t X_PIN  = X_QN_ + (size_t)M * 384 * 2;
constexpr size_t X_QNOPE= X_PIN + (size_t)M * 512 * 2;
constexpr size_t X_OL   = W_X + (size_t)M * 8 * 320 * 2;
constexpr size_t X_OB   = W_X;
constexpr size_t X_MG   = W_X;
constexpr size_t X_U    = W_X;
constexpr size_t WS_END1 = X_OL + (size_t)M * 2048 * 2;
constexpr size_t WS_END2 = X_QNOPE + (size_t)M * 1024 * 2;
constexpr size_t WS_END3 = X_U + (size_t)M * 4096 * 2;
constexpr size_t WS_LIMIT = (size_t)512 * 1024 * 1024 - 4096;
constexpr size_t WS_BAR = WS_LIMIT;
static_assert(X_UP + (size_t)RALL * 512 * 4 <= X_QN_, "Z/Upool overlap qn");
static_assert(X_QB + (size_t)M * 8 * 320 * 2 <= X_QN_, "Qb overlaps qn");
static_assert(WS_END1 <= WS_LIMIT && WS_END2 <= WS_LIMIT && WS_END3 <= WS_LIMIT, "ws too small");

constexpr size_t O_Y = 0;
constexpr size_t O_KVP = (size_t)M * 1024;
constexpr size_t O_PEP = O_KVP + (size_t)2 * 16400 * 256;
constexpr size_t O_POOLP = O_PEP + (size_t)2 * 16400 * 64;
constexpr size_t O_KVS = O_POOLP + (size_t)2 * 15 * 512;
constexpr size_t O_PES = O_KVS + (size_t)32 * 64 * 256;
constexpr size_t O_POOLS = O_PES + (size_t)32 * 64 * 64;

constexpr int ABUF = 64 * 640 + 256 * 128;
constexpr int LDS_BYTES = 141568;

struct Params {
  const float *x_prompt, *x_sample, *cache_kv, *cache_rope, *cache_pool, *meta, *w_in, *g_mix, *g_q, *g_kv, *w_q_up, *w_uk, *w_uv,
      *w_attn_br, *w_pool_grp, *pool_scale, *w_pool_br, *w_out, *g_ffn, *w_up, *w_down, *g_final;
  float* out; char* ws;
};

DEVI unsigned cvtpk(float lo, float hi) { unsigned r; asm("v_cvt_pk_bf16_f32 %0, %1, %2" : "=v"(r) : "v"(lo), "v"(hi)); return r; }
DEVI u16 tobf(float x) { return (u16)(cvtpk(x, 0.f) & 0xffffu); }
DEVI uint2 pack4(float a, float b, float c, float d) { uint2 o; o.x = cvtpk(a, b); o.y = cvtpk(c, d); return o; }
DEVI int crow(int r, int hi) { return (r & 3) + 8 * (r >> 2) + 4 * hi; }
DEVI float wave_sum(float v) {
#pragma unroll
  for (int o = 32; o; o >>= 1) v += __shfl_xor(v, o, 64);
  return v;
}
DEVI f32x16 mfma(bf16x8 a, bf16x8 b, f32x16 c) { return __builtin_amdgcn_mfma_f32_32x32x16_bf16(a, b, c, 0, 0, 0); }
DEVI int fresh_tid(int ws) { int l; asm volatile("v_mbcnt_lo_u32_b32 %0, -1, 0\n\tv_mbcnt_hi_u32_b32 %0, -1, %0" : "=v"(l)); return ws * 64 + l; }
DEVI void grid_barrier(char* wsbase, unsigned k, int wvs) {
  unsigned* ctr = (unsigned*)(wsbase + ((size_t)512 * 1024 * 1024 - 4096));
  const unsigned target = k * gridDim.x;
  __threadfence();
  __syncthreads();
  if (fresh_tid(wvs) == 0) {
    __hip_atomic_fetch_add(ctr, 1u, __ATOMIC_RELAXED, __HIP_MEMORY_SCOPE_AGENT);
    while (__hip_atomic_load(ctr, __ATOMIC_RELAXED, __HIP_MEMORY_SCOPE_AGENT) < target) __builtin_amdgcn_s_sleep(2);
  }
  __syncthreads();
  __threadfence();
}


DEVI bf16x8 lds_rd128(int a, const int off) { bf16x8 r; asm volatile("ds_read_b128 %0, %1 offset:%2" : "=&v"(r) : "v"(a), "i"(off) : "memory"); return r; }
DEVI void glds16(const void* g, void* l) { __builtin_amdgcn_global_load_lds((const unsigned*)g, (unsigned*)l, 16, 0, 0); }
#define WAIT_VM0() asm volatile("s_waitcnt vmcnt(0)" ::: "memory")

template <int TM, int TN, int WR, int WC, int DEP = (TM + TN > 4 ? 1 : 2)>
DEVI void gemm_main_dma(f32x16 (&acc)[TM][TN], const u16* __restrict__ A, long lda, const u16* __restrict__ Bt, long ldb, int K, char* lds, const int tid,
                    const bool pre = false, const u16* __restrict__ nA = nullptr, const u16* __restrict__ nBt = nullptr) {
  static_assert(WR * WC == 8, "8 waves");
  constexpr int BM = 32 * TM * WR, BN = 32 * TN * WC, NA = BM / 64, NB = BN / 64, BUF = (BM + BN) * 128;
  const int lane = tid & 63, wid = tid >> 6, wr = wid / WC, wc = wid % WC, r32 = lane & 31, hi = lane >> 5;
  const int lrow = tid >> 3, lch = (tid & 7) ^ ((((tid >> 4) & 1) << 2) | ((tid >> 5) & 3));
  const u16* ag = A + (long)lrow * lda + lch * 8;
  const u16* bg = Bt + (long)lrow * ldb + lch * 8;
  char* lw = lds + wid * 1024;
#define G_ISSUE(kt_, buf_) do { \
    _Pragma("unroll") for (int i_ = 0; i_ < NA; ++i_) glds16(ag + (long)(64 * i_) * lda + (kt_) * 64, lw + (buf_) * BUF + i_ * 8192); \
    _Pragma("unroll") for (int i_ = 0; i_ < NB; ++i_) glds16(bg + (long)(64 * i_) * ldb + (kt_) * 64, lw + (buf_) * BUF + (NA + i_) * 8192); } while (0)
  const int fr = ((r32 & 2) << 1) | ((r32 >> 2) & 3);
  int o[4];
#pragma unroll
  for (int j = 0; j < 4; ++j) o[j] = ((2 * j + hi) ^ fr) * 16;
  const int KT = K / 64;
  if (!pre) G_ISSUE(0, 0);
  WAIT_VM0(); __syncthreads();
#pragma unroll 1
  for (int kt = 0; kt < KT; ++kt) {
    if (kt + 1 < KT) G_ISSUE(kt + 1, (kt + 1) & 1);
    const int abase = (int)(uintptr_t)lds + (kt & 1) * BUF + (wr * 32 * TM + r32) * 128;
    const int bbase = (int)(uintptr_t)lds + (kt & 1) * BUF + (BM + wc * 32 * TN + r32) * 128;
    bf16x8 fs[DEP + 1][TM + TN];
#define F_LOAD(set_, ks_) do { const int aa_ = abase + o[ks_], bb_ = bbase + o[ks_]; \
      _Pragma("unroll") for (int m_ = 0; m_ < TM; ++m_) fs[set_][m_] = lds_rd128(aa_, m_ * 4096); \
      _Pragma("unroll") for (int n_ = 0; n_ < TN; ++n_) fs[set_][TM + n_] = lds_rd128(bb_, n_ * 4096); } while (0)
#pragma unroll
    for (int pks = 0; pks < DEP; ++pks) F_LOAD(pks, pks);
#pragma unroll
    for (int ks = 0; ks < 4; ++ks) {
      if (ks + DEP < 4) F_LOAD((ks + DEP) % (DEP + 1), ks + DEP);
      constexpr int NF = TM + TN;
      const int ahead = (4 - 1 - ks) < DEP ? (4 - 1 - ks) : DEP;
      if (ahead == 2) asm volatile("s_waitcnt lgkmcnt(%0)" :: "n"(2 * NF) : "memory");
      else if (ahead == 1) asm volatile("s_waitcnt lgkmcnt(%0)" :: "n"(NF) : "memory");
      else asm volatile("s_waitcnt lgkmcnt(0)" ::: "memory");
      __builtin_amdgcn_sched_barrier(0);
#pragma unroll
      for (int m = 0; m < TM; ++m)
#pragma unroll
        for (int n = 0; n < TN; ++n) acc[m][n] = mfma(fs[ks % (DEP + 1)][m], fs[ks % (DEP + 1)][TM + n], acc[m][n]);
      __builtin_amdgcn_sched_barrier(0);
    }
#undef F_LOAD
    WAIT_VM0(); __syncthreads();
  }
  if (nA != nullptr) {
    const u16* ag2 = nA + (long)lrow * lda + lch * 8;
    const u16* bg2 = nBt + (long)lrow * ldb + lch * 8;
#pragma unroll
    for (int i = 0; i < NA; ++i) glds16(ag2 + (long)(64 * i) * lda, lw + i * 8192);
#pragma unroll
    for (int i = 0; i < NB; ++i) glds16(bg2 + (long)(64 * i) * ldb, lw + (NA + i) * 8192);
  }
#undef G_ISSUE
}
template <int TM, int TN, int WR, int WC, int DEP = (TM + TN > 4 ? 1 : 2)>
DEVI void gemm_main_reg(f32x16 (&acc)[TM][TN], const u16* __restrict__ A, long lda, const u16* __restrict__ Bt, long ldb, int K, char* lds, const int tid,
                    const bool pre = false, const u16* __restrict__ nA = nullptr, const u16* __restrict__ nBt = nullptr) {
  static_assert(WR * WC == 8, "8 waves");
  constexpr int BM = 32 * TM * WR, BN = 32 * TN * WC, NA = BM / 64, NB = BN / 64, BUF = (BM + BN) * 128;
  const int lane = tid & 63, wid = tid >> 6, wr = wid / WC, wc = wid % WC, r32 = lane & 31, hi = lane >> 5;
  const int lrow = tid >> 3, lpos = (tid & 7) ^ ((((tid >> 4) & 1) << 2) | ((tid >> 5) & 3));
  const u16* ag = A + (long)lrow * lda + (tid & 7) * 8;
  const u16* bg = Bt + (long)lrow * ldb + (tid & 7) * 8;
  char* lwr = lds + lrow * 128 + lpos * 16;
  u32x4 r0[NA + NB], r1[NA + NB];
#define G_LOAD(R_, kt_) do { \
    _Pragma("unroll") for (int i_ = 0; i_ < NA; ++i_) R_[i_] = *(const u32x4*)(ag + (long)(64 * i_) * lda + (kt_) * 64); \
    _Pragma("unroll") for (int i_ = 0; i_ < NB; ++i_) R_[NA + i_] = *(const u32x4*)(bg + (long)(64 * i_) * ldb + (kt_) * 64); } while (0)
#define S_WRITE(R_, buf_) do { _Pragma("unroll") for (int i_ = 0; i_ < NA + NB; ++i_) *(u32x4*)(lwr + (buf_) * BUF + i_ * 8192) = R_[i_]; } while (0)
  const int fr = ((r32 & 2) << 1) | ((r32 >> 2) & 3);
  int o[4];
#pragma unroll
  for (int j = 0; j < 4; ++j) o[j] = ((2 * j + hi) ^ fr) * 16;
  const int KT = K / 64;
  (void)pre; (void)nA; (void)nBt;
#define K_TILE(buf_) do { \
    const int abase = (int)(uintptr_t)lds + (buf_) * BUF + (wr * 32 * TM + r32) * 128; \
    const int bbase = (int)(uintptr_t)lds + (buf_) * BUF + (BM + wc * 32 * TN + r32) * 128; \
    bf16x8 fs[DEP + 1][TM + TN]; \
    _Pragma("unroll") for (int pks = 0; pks < DEP; ++pks) { const int aa_ = abase + o[pks], bb_ = bbase + o[pks]; \
      _Pragma("unroll") for (int m_ = 0; m_ < TM; ++m_) fs[pks][m_] = lds_rd128(aa_, m_ * 4096); \
      _Pragma("unroll") for (int n_ = 0; n_ < TN; ++n_) fs[pks][TM + n_] = lds_rd128(bb_, n_ * 4096); } \
    _Pragma("unroll") for (int ks = 0; ks < 4; ++ks) { \
      if (ks + DEP < 4) { const int aa_ = abase + o[(ks + DEP) & 3], bb_ = bbase + o[(ks + DEP) & 3]; \
        _Pragma("unroll") for (int m_ = 0; m_ < TM; ++m_) fs[(ks + DEP) % (DEP + 1)][m_] = lds_rd128(aa_, m_ * 4096); \
        _Pragma("unroll") for (int n_ = 0; n_ < TN; ++n_) fs[(ks + DEP) % (DEP + 1)][TM + n_] = lds_rd128(bb_, n_ * 4096); } \
      const int ahead = (4 - 1 - ks) < DEP ? (4 - 1 - ks) : DEP; \
      if (ahead == 2) asm volatile("s_waitcnt lgkmcnt(%0)" :: "n"(2 * (TM + TN)) : "memory"); \
      else if (ahead == 1) asm volatile("s_waitcnt lgkmcnt(%0)" :: "n"(TM + TN) : "memory"); \
      else asm volatile("s_waitcnt lgkmcnt(0)" ::: "memory"); \
      __builtin_amdgcn_sched_barrier(0); \
      _Pragma("unroll") for (int m = 0; m < TM; ++m) \
        _Pragma("unroll") for (int n = 0; n < TN; ++n) acc[m][n] = mfma(fs[ks % (DEP + 1)][m], fs[ks % (DEP + 1)][TM + n], acc[m][n]); \
      __builtin_amdgcn_sched_barrier(0); \
    } } while (0)
  G_LOAD(r0, 0); S_WRITE(r0, 0); G_LOAD(r1, 1);
  __syncthreads();
#pragma unroll 1
  for (int kt = 0; kt < KT; kt += 2) {
    if (kt + 2 < KT) G_LOAD(r0, kt + 2);
    K_TILE(0);
    S_WRITE(r1, 1);
    __syncthreads();
    if (kt + 3 < KT) G_LOAD(r1, kt + 3);
    K_TILE(1);
    if (kt + 2 < KT) S_WRITE(r0, 0);
    __syncthreads();
  }
#undef K_TILE
#undef G_LOAD
#undef S_WRITE
}
template <int TM, int TN, int WR, int WC, int DEP = (TM + TN > 4 ? 1 : 2)>
DEVI void gemm_main(f32x16 (&acc)[TM][TN], const u16* __restrict__ A, long lda, const u16* __restrict__ Bt, long ldb, int K, char* lds, const int tid,
                    const bool pre = false, const u16* __restrict__ nA = nullptr, const u16* __restrict__ nBt = nullptr) {
  gemm_main_dma<TM, TN, WR, WC, DEP>(acc, A, lda, Bt, ldb, K, lds, tid, pre, nA, nBt);
}
#define TILE_LOOP(tile, NT) \
  for (int it_ = 0, tile = 0; it_ * 8 * (int)(gridDim.x >> 3) < (NT); ++it_) \
    if ((tile = (it_ * 8 + (int)(blockIdx.x & 7)) * (int)(gridDim.x >> 3) + (int)(blockIdx.x >> 3)) < (NT))
template <int TM, int TN> DEVI void zero_acc(f32x16 (&acc)[TM][TN]) {
#pragma unroll
  for (int m = 0; m < TM; ++m)
#pragma unroll
    for (int n = 0; n < TN; ++n)
#pragma unroll
      for (int r = 0; r < 16; ++r) acc[m][n][r] = 0.f;
}

template <int R, bool BF>
DEVI void rms_rows(const float* const (&src)[R], const bool (&ok)[R], const bool (&zero)[R], const float* __restrict__ g, char* const (&dst)[R], const int lane) {
  float4 v[R][4];
#pragma unroll
  for (int k = 0; k < R; ++k)
#pragma unroll
    for (int i = 0; i < 4; ++i) v[k][i] = (ok[k] && !zero[k]) ? *(const float4*)(src[k] + 4 * lane + 256 * i) : make_float4(0, 0, 0, 0);
  float ss[R];
#pragma unroll
  for (int k = 0; k < R; ++k) {
    ss[k] = 0;
#pragma unroll
    for (int i = 0; i < 4; ++i) ss[k] += v[k][i].x * v[k][i].x + v[k][i].y * v[k][i].y + v[k][i].z * v[k][i].z + v[k][i].w * v[k][i].w;
  }
#pragma unroll
  for (int o = 32; o; o >>= 1)
#pragma unroll
    for (int k = 0; k < R; ++k) ss[k] += __shfl_xor(ss[k], o, 64);
#pragma unroll
  for (int i = 0; i < 4; ++i) {
    const float4 gg = *(const float4*)(g + 4 * lane + 256 * i);
#pragma unroll
    for (int k = 0; k < R; ++k) {
      if (!ok[k]) continue;
      const float rs = rsqrtf(ss[k] * (1.f / 1024.f) + EPS);
      const float4 y = make_float4(v[k][i].x * rs * gg.x, v[k][i].y * rs * gg.y, v[k][i].z * rs * gg.z, v[k][i].w * rs * gg.w);
      if (BF) *(uint2*)((u16*)dst[k] + 4 * lane + 256 * i) = pack4(y.x, y.y, y.z, y.w);
      else *(float4*)((float*)dst[k] + 4 * lane + 256 * i) = y;
    }
  }
}

DEVI void phase0(const Params& p, char* lds, const int wvs) {
  const int tid512 = fresh_tid(wvs);
  char* ws = p.ws;
  const int half = tid512 >> 8, tid = tid512 & 255, lane = tid & 63, w = tid >> 6;
  float* T = (float*)lds + half * (64 * 65);
  constexpr int U_T = 3728, U_C = U_T + 512, U_X = U_C + 548, U_R = U_X + 513, U_K = U_R + 256, U_P = U_K + 32;
  for (int it = blockIdx.x; 2 * it < U_P; it += gridDim.x) {
    const int u = 2 * it + half;
    const float* src = nullptr; u16* dst = nullptr; int N = 0, Kd = 0, k0 = 0, n0 = 0; bool isq = false;
    const bool tr = u < U_T;
    if (tr) {
      int t = u;
      if (t < 816) { src = p.w_in; dst = (u16*)(ws + W_WINT); Kd = 1024; N = DIN; }
      else if (t < 960) { t -= 816; src = p.w_q_up; dst = (u16*)(ws + W_WQT); Kd = 384; N = 1536; isq = true; }
      else if (t < 1024) { t -= 960; src = p.w_uv; dst = (u16*)(ws + W_WUVT); Kd = 256; N = 1024; }
      else if (t < 1280) { t -= 1024; src = p.w_attn_br; dst = (u16*)(ws + W_WABT); Kd = 1024; N = 1024; }
      else if (t < 1296) { t -= 1280; const int g = t >> 2; t &= 3; src = p.w_pool_grp + g * 16384; dst = (u16*)(ws + W_WGT) + g * 16384; Kd = 128; N = 128; }
      else if (t < 1424) { t -= 1296; src = p.w_pool_br; dst = (u16*)(ws + W_WPBT); Kd = 512; N = 1024; }
      else if (t < 1680) { t -= 1424; src = p.w_out; dst = (u16*)(ws + W_WOT); Kd = 1024; N = 1024; }
      else if (t < 2704) { t -= 1680; src = p.w_up; dst = (u16*)(ws + W_WUPT); Kd = 1024; N = 4096; }
      else { t -= 2704; src = p.w_down; dst = (u16*)(ws + W_WDT); Kd = 4096; N = 1024; }
      const int nt = N / 64; const int tk = t / nt, tn = t - tk * nt;
      k0 = tk * 64; n0 = tn * 64;
#pragma unroll
      for (int i = 0; i < 16; ++i) { const int k = w + 4 * i; const float v = src[(long)(k0 + k) * N + n0 + lane]; T[k * 65 + lane] = v;
        if (isq) ((u16*)(ws + W_WQN))[(long)(k0 + k) * 1536 + n0 + lane] = tobf(v); }
    }
    __syncthreads();
    if (tr) {
      const int n = tid >> 2, kc = (tid & 3) * 16;
      unsigned pk[8];
#pragma unroll
      for (int j = 0; j < 8; ++j) pk[j] = cvtpk(T[(kc + 2 * j) * 65 + n], T[(kc + 2 * j + 1) * 65 + n]);
      uint4* d = (uint4*)(dst + (long)(n0 + n) * Kd + k0 + kc);
      d[0] = make_uint4(pk[0], pk[1], pk[2], pk[3]); d[1] = make_uint4(pk[4], pk[5], pk[6], pk[7]);
      if (isq && n0 % 192 == 128) {
        uint4* d2 = (uint4*)((u16*)(ws + W_COMBT) + (long)((n0 / 192) * 320 + 256 + (n < 32 ? 2 * n : 2 * (n - 32) + 1)) * 384 + k0 + kc);
        d2[0] = make_uint4(pk[0], pk[1], pk[2], pk[3]); d2[1] = make_uint4(pk[4], pk[5], pk[6], pk[7]);
      }
    } else if (u < U_C) {
      const int c = u - U_T, bd = c >> 4, ct = c & 15;
      u16* Kd2 = (u16*)(ws + W_KS) + ((long)bd * LKS + ct * 64) * 320;
#pragma unroll 4
      for (int i = 0; i < 16; ++i) {
        const int r = w * 16 + i;
        const float4 v = *(const float4*)(p.cache_kv + ((long)(bd * PAST + ct * 64 + r)) * 256 + 4 * lane);
        uint2 o; o.x = cvtpk(v.x, v.y); o.y = cvtpk(v.z, v.w);
        *(uint2*)(Kd2 + r * 320 + 4 * lane) = o;
        const float kr = p.cache_rope[((long)(bd * PAST + ct * 64 + r)) * 64 + lane];
        Kd2[r * 320 + 256 + (lane < 32 ? 2 * lane : 2 * (lane - 32) + 1)] = tobf(kr);
      }
    } else if (u < U_X) {
      const int ru = u - U_C;
      for (int i = 0; i < 16; i += 4) {
        const float* s[4]; char* d[4]; bool ok[4], z[4];
#pragma unroll
        for (int k = 0; k < 4; ++k) {
          const int R = ru * 64 + w * 16 + i + k;
          s[k] = R < MP ? p.x_prompt + (long)R * 1024 : (R < M ? p.x_sample + (long)(R - MP) * 1024 : p.meta + (long)(R - M) * 1024);
          ok[k] = true; z[k] = R >= M + 16; d[k] = (char*)((u16*)(ws + W_XN) + (long)R * 1024);
        }
        rms_rows<4, true>(s, ok, z, p.g_mix, d, lane);
      }
    } else if (u < U_R) {
      const int base = (u - U_X) * 1024;
      for (int i = 0; i < 4; ++i) {
        const int e = base + i * 256 + tid;
        if (e < 16400 * 32) {
          const int pos = e >> 5, j = e & 31;
          const float inv = exp2f(-(float)j * 0.41524101186092029f);
          const double rev = (double)pos * (double)inv * 0.15915494309189535;
          const float fr = (float)(rev - floor(rev));
          float2 cs; cs.x = __builtin_amdgcn_cosf(fr); cs.y = __builtin_amdgcn_sinf(fr);
          ((float2*)(ws + W_TAB))[e] = cs;
        }
      }
    } else if (u < U_K) {
      const int e = ((u - U_R) * 256 + tid) * 4;
      const float4 v = *(const float4*)(p.w_uk + e);
      uint2 o; o.x = cvtpk(v.x, v.y); o.y = cvtpk(v.z, v.w);
      *(uint2*)((u16*)(ws + W_WUK) + e) = o;
      const float4 v2 = *(const float4*)(p.w_uv + e);
      uint2 o2; o2.x = cvtpk(v2.x, v2.y); o2.y = cvtpk(v2.z, v2.w);
      *(uint2*)((u16*)(ws + W_WUVN) + e) = o2;
    } else if (u < U_P) {
      const int e = (u - U_K) * 256 + tid;
      ((uint4*)((u16*)(ws + W_WINT) + (long)DIN * 1024))[e] = make_uint4(0, 0, 0, 0);
    }
    __syncthreads();
  }
}

DEVI char* stage_base(char* lds, int wid) { return lds + 65536 + wid * 8192; }
DEVI void stage_put(char* stg, int row, int col, float v) { *(u16*)(stg + row * 128 + col * 2) = tobf(v); }
DEVI void stage_flush(const char* stg, u16* __restrict__ out, long ld, int lane) {
#pragma unroll
  for (int j = 0; j < 8; ++j) {
    const int q = lane + 64 * j, row = q >> 3, c = q & 7;
    const uint4 v = *(const uint4*)(stg + row * 128 + c * 16);
    *(uint4*)(out + (long)row * ld + c * 8) = v;
  }
}


namespace pg8 {
#define PG8_LAS __attribute__((address_space(3)))
typedef unsigned short bf16_t;
typedef float f32x4 __attribute__((ext_vector_type(4)));
constexpr int BM = 256, BK = 64, HALF = 128, HTB = HALF * BK * 2, STAGE_BYTES = 8 * HTB, NXCD = 8, WGM = 8;
__device__ __forceinline__ int lds_byte(int r, int c) { const int st = (r >> 4) * 2 + (c >> 5), rr = r & 15, cc = c & 31, ob = rr * 64 + cc * 2; return st * 1024 + (ob ^ (((ob >> 9) & 1) << 5)); }
__device__ __forceinline__ void stage_rc(int b, int& R, int& C) { const int st = b / 1024, sb = b % 1024, swz = sb ^ (((sb >> 9) & 1) << 5); R = (st >> 1) * 16 + swz / 64; C = (st & 1) * 32 + (swz % 64) / 2; }
__device__ __forceinline__ int perm32(int rho) { const int n = rho >> 4, i = rho & 15; return 8 * (i >> 2) + 4 * n + (i & 3); }
struct Unit { int pm, pn; };
struct Gemm { const bf16_t* A; const bf16_t* Bt; int M, N, K; };
struct StaticOrder {
    int nM, nN, nwg, G, c;
    __device__ void init(int M, int N, int G_, int c_) { nM = M / BM; nN = N / BM; nwg = nM * nN; G = G_; c = c_; }
    __device__ bool next(int i, Unit& u) const {
        const long L = (long)i * G + c; if (L >= nwg) return false;
        int wgid = (int)L; { const int q = nwg / NXCD, r = nwg % NXCD, xcd = wgid % NXCD, off = wgid / NXCD; wgid = (xcd < r ? xcd * (q + 1) : r * (q + 1) + (xcd - r) * q) + off; }
        const int nig = WGM * nN, gid = wgid / nig, fm = gid * WGM, gsz = (nM - fm) < WGM ? (nM - fm) : WGM;
        u.pm = fm + ((wgid % nig) % gsz); u.pn = (wgid % nig) / gsz; return true;
    }
    __device__ __forceinline__ void a_ready(const Unit&) const {}
    __device__ __forceinline__ void done(const Unit&) const {}
};
template <class Epi, class Sched>
__device__ __forceinline__ void gemm_phase(PG8_LAS unsigned char* lds, const Gemm g, const Sched& S, const Epi& E, const int tid) {
    const int wid = __builtin_amdgcn_readfirstlane(tid >> 6), lane = tid & 63, wr = wid >> 2, wc = wid & 3, fr = lane & 15, fq = lane >> 4;
    const int K = g.K, nt = K / BK;
    unsigned voffA[2], voffB[2];
#pragma unroll
    for (int i = 0; i < 2; ++i) { int R, C; stage_rc(tid * 16 + i * 8192, R, C); const int Rb = Epi::PERM ? ((R & ~31) + perm32(R & 31)) : R;
        voffA[i] = (unsigned)(R * K + C) * 2u; voffB[i] = (unsigned)(Rb * K + C) * 2u; }
    const size_t kstep = (size_t)(BK * 2);
    const size_t hstep = (size_t)HALF * K * 2;
    const size_t tstep = 2 * hstep;
    const unsigned ldsw = (unsigned)wid * 1024u;
    const int aoff = lds_byte(wr * 64 + fr, fq * 8), boff = lds_byte(wc * 32 + fr, fq * 8);
#define PG8_SA(b, h) (((b) * 2 + (h)) * HTB)
#define PG8_SB(b, h) ((4 + (b) * 2 + (h)) * HTB)
#define PG8_STAGE(bufoff, gbase, voff) do { _Pragma("unroll") for (int _i = 0; _i < 2; ++_i) \
        __builtin_amdgcn_global_load_lds((const unsigned*)((const char*)(gbase) + (voff)[_i]), (PG8_LAS unsigned*)(lds + (bufoff) + ldsw + _i * 8192), 16, 0, 0); } while (0)
#define PG8_LDA(dst, b, h) do { _Pragma("unroll") for (int m = 0; m < 4; ++m) _Pragma("unroll") for (int k = 0; k < 2; ++k) dst[m][k] = *(const PG8_LAS bf16x8*)(lds + PG8_SA(b, h) + aoff + m * 2048 + k * 1024); } while (0)
#define PG8_LDB(dst, b, h) do { _Pragma("unroll") for (int n = 0; n < 2; ++n) _Pragma("unroll") for (int k = 0; k < 2; ++k) dst[n][k] = *(const PG8_LAS bf16x8*)(lds + PG8_SB(b, h) + boff + n * 2048 + k * 1024); } while (0)
#define PG8_MMA(ai, bj, At, Bt) do { __builtin_amdgcn_s_setprio(1); _Pragma("unroll") for (int m = 0; m < 4; ++m) _Pragma("unroll") for (int n = 0; n < 2; ++n) _Pragma("unroll") for (int k = 0; k < 2; ++k) \
        acc[ai][bj][m][n] = __builtin_amdgcn_mfma_f32_16x16x32_bf16(Bt[n][k], At[m][k], acc[ai][bj][m][n], 0, 0, 0); __builtin_amdgcn_s_setprio(0); } while (0)
#define PG8_WAIT_V(n) asm volatile("s_waitcnt vmcnt(" #n ")" ::: "memory")
#define PG8_WAIT_L(n) asm volatile("s_waitcnt lgkmcnt(" #n ")" ::: "memory")
#define PG8_BAR __builtin_amdgcn_s_barrier()
#define PG8_SCHED __builtin_amdgcn_sched_barrier(0)
    Unit cur, nxt; int ui = 0;
    if (!S.next(0, cur)) return;
    f32x4 acc[2][2][4][2];
#pragma unroll
    for (int a = 0; a < 2; ++a)
#pragma unroll
        for (int b = 0; b < 2; ++b)
#pragma unroll
            for (int m = 0; m < 4; ++m)
#pragma unroll
                for (int n = 0; n < 2; ++n) acc[a][b][m][n] = (f32x4){0.f, 0.f, 0.f, 0.f};
    bf16x8 At[4][2], B0[2][2], B1[2][2];
    const char* cA = (const char*)g.A + (size_t)cur.pm * tstep; const char* cB = (const char*)g.Bt + (size_t)cur.pn * tstep;
    S.a_ready(cur);
    PG8_STAGE(PG8_SB(0, 0), cB, voffB); PG8_STAGE(PG8_SA(0, 0), cA, voffA); PG8_STAGE(PG8_SB(0, 1), cB + hstep, voffB); PG8_STAGE(PG8_SA(0, 1), cA + hstep, voffA);
    if (wr == 1) PG8_BAR;
    PG8_WAIT_V(4); PG8_BAR;
    PG8_STAGE(PG8_SB(1, 0), cB + kstep, voffB); PG8_STAGE(PG8_SA(1, 0), cA + kstep, voffA); PG8_STAGE(PG8_SB(1, 1), cB + hstep + kstep, voffB);
    PG8_WAIT_V(6); PG8_BAR;
    for (;;) {
        const bool has_next = S.next(ui + 1, nxt);
        const char* nA = has_next ? (const char*)g.A + (size_t)nxt.pm * tstep : cA; const char* nB = has_next ? (const char*)g.Bt + (size_t)nxt.pn * tstep : cB;
        for (int t = 0; t < nt; t += 2) {
            const bool last = (t == nt - 2);
            const char* a1 = cA + (size_t)(t + 1) * kstep;
            const char* a2 = last ? nA : cA + (size_t)(t + 2) * kstep; const char* b2 = last ? nB : cB + (size_t)(t + 2) * kstep;
            const char* a3 = a2 + kstep; const char* b3 = b2 + kstep;
            if (last && has_next) S.a_ready(nxt);
            PG8_LDB(B0, 0, 0); PG8_SCHED; PG8_LDA(At, 0, 0); PG8_STAGE(PG8_SA(1, 1), a1 + hstep, voffA);
            PG8_WAIT_L(8); PG8_BAR; PG8_WAIT_L(0); PG8_MMA(0, 0, At, B0); PG8_BAR; PG8_SCHED;
            PG8_LDB(B1, 0, 1); PG8_STAGE(PG8_SB(0, 0), b2, voffB);
            PG8_BAR; PG8_WAIT_L(0); PG8_MMA(0, 1, At, B1); PG8_BAR;
            PG8_LDA(At, 0, 1); PG8_STAGE(PG8_SA(0, 0), a2, voffA);
            PG8_BAR; PG8_WAIT_L(0); PG8_MMA(1, 0, At, B0); PG8_BAR; PG8_SCHED;
            PG8_STAGE(PG8_SB(0, 1), b2 + hstep, voffB);
            PG8_WAIT_V(6); PG8_BAR; PG8_MMA(1, 1, At, B1); PG8_BAR;
            PG8_LDB(B0, 1, 0); PG8_SCHED; PG8_LDA(At, 1, 0); PG8_STAGE(PG8_SA(0, 1), a2 + hstep, voffA);
            PG8_WAIT_L(8); PG8_BAR; PG8_WAIT_L(0); PG8_MMA(0, 0, At, B0); PG8_BAR; PG8_SCHED;
            PG8_LDB(B1, 1, 1); PG8_STAGE(PG8_SB(1, 0), b3, voffB);
            PG8_BAR; PG8_WAIT_L(0); PG8_MMA(0, 1, At, B1); PG8_BAR;
            PG8_LDA(At, 1, 1); PG8_STAGE(PG8_SA(1, 0), a3, voffA);
            PG8_BAR; PG8_WAIT_L(0); PG8_MMA(1, 0, At, B0); PG8_BAR; PG8_SCHED;
            PG8_STAGE(PG8_SB(1, 1), b3 + hstep, voffB);
            PG8_WAIT_V(6); PG8_BAR; PG8_MMA(1, 1, At, B1); PG8_BAR;
        }
            if constexpr (!Epi::AFTER_DRAIN) { E(acc, cur, wr, wc, fr, fq); S.done(cur); }
            if (!has_next) break;
#pragma unroll
        for (int a = 0; a < 2; ++a)
#pragma unroll
            for (int b = 0; b < 2; ++b)
#pragma unroll
                for (int m = 0; m < 4; ++m)
#pragma unroll
                    for (int n = 0; n < 2; ++n) acc[a][b][m][n] = (f32x4){0.f, 0.f, 0.f, 0.f};
        cur = nxt; cA = nA; cB = nB; ++ui;
    }
    PG8_WAIT_V(0);
    if (wr == 0) PG8_BAR;
    PG8_BAR;
    if constexpr (Epi::AFTER_DRAIN) { E.fused(acc, cur, wr, wc, fr, fq, lds, wid, lane); S.done(cur); }
#undef PG8_SA
#undef PG8_SB
#undef PG8_STAGE
#undef PG8_LDA
#undef PG8_LDB
#undef PG8_MMA
#undef PG8_WAIT_V
#undef PG8_WAIT_L
#undef PG8_BAR
#undef PG8_SCHED
}
}

#define PG8_ROW(u, ai, m) ((u).pm * 256 + (ai) * 128 + wr * 64 + (m) * 16 + fr)
#define PG8_COL8(u, bj) ((u).pn * 256 + (bj) * 128 + wc * 32 + 8 * fq)
struct EpiP1 {
  static constexpr bool PERM = true, AFTER_DRAIN = false;
  float* Z; float* UP; u16* G;
  __device__ __forceinline__ void operator()(const pg8::f32x4 (&acc)[2][2][4][2], const pg8::Unit& u, int wr, int wc, int fr, int fq) const {
#pragma unroll
    for (int bj = 0; bj < 2; ++bj) {
      const int c8 = PG8_COL8(u, bj), grp = u.pn * 256 + bj * 128 + wc * 32;
#pragma unroll
      for (int ai = 0; ai < 2; ++ai)
#pragma unroll
        for (int m = 0; m < 4; ++m) {
          const long row = PG8_ROW(u, ai, m);
          if (grp < ZW) { *(pg8::f32x4*)(Z + row * ZW + c8) = acc[ai][bj][m][0]; *(pg8::f32x4*)(Z + row * ZW + c8 + 4) = acc[ai][bj][m][1]; }
          else if (grp < ZW + DPOOL) { *(pg8::f32x4*)(UP + row * 512 + c8 - ZW) = acc[ai][bj][m][0]; *(pg8::f32x4*)(UP + row * 512 + c8 - ZW + 4) = acc[ai][bj][m][1]; }
          else if (grp < DIN && row < M) {
            float s[8];
#pragma unroll
            for (int j = 0; j < 4; ++j) { s[j] = 1.f / (1.f + __expf(-acc[ai][bj][m][0][j])); s[4 + j] = 1.f / (1.f + __expf(-acc[ai][bj][m][1][j])); }
            u32x4 w = {cvtpk(s[0], s[1]), cvtpk(s[2], s[3]), cvtpk(s[4], s[5]), cvtpk(s[6], s[7])};
            *(u32x4*)(G + row * 2048 + c8 - (ZW + DPOOL)) = w;
          }
        }
    }
  }
};
struct EpiP8 {
  static constexpr bool PERM = true, AFTER_DRAIN = false;
  float* Y; const float* xp; const float* xs;
  __device__ __forceinline__ void operator()(const pg8::f32x4 (&acc)[2][2][4][2], const pg8::Unit& u, int wr, int wc, int fr, int fq) const {
#pragma unroll
    for (int ai = 0; ai < 2; ++ai)
#pragma unroll
      for (int m = 0; m < 4; ++m) {
        const long row = PG8_ROW(u, ai, m);
        const float* xr = row < MP ? xp + row * 1024 : xs + (row - MP) * 1024;
#pragma unroll
        for (int bj = 0; bj < 2; ++bj) {
          const int c8 = PG8_COL8(u, bj);
          const pg8::f32x4 x0 = *(const pg8::f32x4*)(xr + c8), x1 = *(const pg8::f32x4*)(xr + c8 + 4);
          *(pg8::f32x4*)(Y + row * 1024 + c8) = x0 + acc[ai][bj][m][0]; *(pg8::f32x4*)(Y + row * 1024 + c8 + 4) = x1 + acc[ai][bj][m][1];
        }
      }
  }
};
struct EpiP10 {
  static constexpr bool PERM = true, AFTER_DRAIN = false;
  u16* U;
  __device__ __forceinline__ void operator()(const pg8::f32x4 (&acc)[2][2][4][2], const pg8::Unit& u, int wr, int wc, int fr, int fq) const {
#pragma unroll
    for (int ai = 0; ai < 2; ++ai)
#pragma unroll
      for (int m = 0; m < 4; ++m) {
        const long row = PG8_ROW(u, ai, m);
#pragma unroll
        for (int bj = 0; bj < 2; ++bj) {
          float v[8];
#pragma unroll
          for (int j = 0; j < 4; ++j) { const float a = fmaxf(acc[ai][bj][m][0][j], 0.f), b = fmaxf(acc[ai][bj][m][1][j], 0.f); v[j] = a * a; v[4 + j] = b * b; }
          u32x4 w = {cvtpk(v[0], v[1]), cvtpk(v[2], v[3]), cvtpk(v[4], v[5]), cvtpk(v[6], v[7])};
          *(u32x4*)(U + row * 4096 + PG8_COL8(u, bj)) = w;
        }
      }
  }
};
struct EpiP11 {
  static constexpr bool PERM = true, AFTER_DRAIN = false;
  float* Y;
  __device__ __forceinline__ void operator()(const pg8::f32x4 (&acc)[2][2][4][2], const pg8::Unit& u, int wr, int wc, int fr, int fq) const {
#pragma unroll
    for (int ai = 0; ai < 2; ++ai)
#pragma unroll
      for (int m = 0; m < 4; ++m) {
        const long row = PG8_ROW(u, ai, m);
#pragma unroll
        for (int bj = 0; bj < 2; ++bj) {
          float* y = Y + row * 1024 + PG8_COL8(u, bj);
          const pg8::f32x4 h0 = *(const pg8::f32x4*)y, h1 = *(const pg8::f32x4*)(y + 4);
          *(pg8::f32x4*)y = h0 + acc[ai][bj][m][0]; *(pg8::f32x4*)(y + 4) = h1 + acc[ai][bj][m][1];
        }
      }
  }
};
template <class Epi>
DEVI void run_pg8(char* lds, const u16* A, const u16* Bt, int Mr, int Nc, int K, const Epi& E, const int tid) {
  pg8::StaticOrder S; S.init(Mr, Nc, (int)gridDim.x, (int)blockIdx.x);
  pg8::Gemm g; g.A = A; g.Bt = Bt; g.M = Mr; g.N = Nc; g.K = K;
  pg8::gemm_phase<Epi, pg8::StaticOrder>((PG8_LAS unsigned char*)lds, g, S, E, tid);
}

DEVI void phase1(const Params& p, char* lds, const int wvs) {
  const int tid = fresh_tid(wvs);
  char* ws = p.ws;
  EpiP1 E; E.Z = (float*)(ws + X_Z); E.UP = (float*)(ws + X_UP); E.G = (u16*)p.out;
  run_pg8(lds, (const u16*)(ws + W_XN), (const u16*)(ws + W_WINT), RALL, DIN_PAD, 1024, E, tid);
}

DEVI void phase2w(const Params& p, char* lds, const int wvs) {
  const int tid = fresh_tid(wvs);
  char* ws = p.ws;
  const int lane = tid & 63;
  for (int ct = blockIdx.x; ct < 24; ct += gridDim.x) {
    const int h = ct / 3, t3 = ct - 3 * h, wid = tid >> 6, wr = wid >> 1, wc = wid & 1, r32 = lane & 31, hi = lane >> 5;
    f32x16 acc[2][2]; zero_acc(acc);
    gemm_main<2, 2, 4, 2>(acc, (const u16*)(ws + W_WUK) + h * 128, 1024, (const u16*)(ws + W_WQN) + (long)(t3 * 128) * 1536 + h * 192, 1536, 128, lds, tid);
    char* stg = stage_base(lds, wid);
#pragma unroll
    for (int m = 0; m < 2; ++m)
#pragma unroll
      for (int n = 0; n < 2; ++n)
#pragma unroll
        for (int r = 0; r < 16; ++r) stage_put(stg, 32 * m + crow(r, hi), 32 * n + r32, acc[m][n][r]);
    stage_flush(stg, (u16*)(ws + W_COMBT) + (long)(h * 320 + wr * 64) * 384 + t3 * 128 + wc * 64, 384, lane);
    __syncthreads();
  }
  for (int ct = (int)blockIdx.x - 24; ct < 64; ct += gridDim.x) {
    if (ct < 0) continue;
    const int h = ct >> 3, jt = (ct >> 1) & 3, cn = ct & 1, wid = tid >> 6, wr = wid >> 1, wc = wid & 1, r32 = lane & 31, hi = lane >> 5;
    f32x16 acc[2][2]; zero_acc(acc);
    gemm_main<2, 2, 4, 2>(acc, (const u16*)(ws + W_WABT) + (long)(jt * 256) * 1024 + h * 128, 1024, (const u16*)(ws + W_WUVN) + (long)(cn * 128) * 1024 + h * 128, 1024, 128, lds, tid);
    char* stg = stage_base(lds, wid);
#pragma unroll
    for (int m = 0; m < 2; ++m)
#pragma unroll
      for (int n = 0; n < 2; ++n)
#pragma unroll
        for (int r = 0; r < 16; ++r) stage_put(stg, 32 * m + crow(r, hi), 32 * n + r32, acc[m][n][r]);
    stage_flush(stg, (u16*)(ws + W_WPT) + (long)(jt * 256 + wr * 64) * 2048 + h * 256 + cn * 128 + wc * 64, 2048, lane);
    __syncthreads();
  }
}
DEVI void phase2(const Params& p, char* lds, const int wvs) {
  const int tid = fresh_tid(wvs);
  char* ws = p.ws;
  const int lane = tid & 63, w = tid >> 6;
  const float* Z = (const float*)(ws + X_Z); const float* UP = (const float*)(ws + X_UP);
  const float2* TAB = (const float2*)(ws + W_TAB);
  for (int u = blockIdx.x; u < 546; u += gridDim.x) {
    int zrow0, pos0, keybase, b = 0; long ldvt; u16 *Kd, *VT; float *okv, *ope, *opool = nullptr; bool meta = false, sample = false;
    if (u < 512) {
      b = u >> 8; const int ft = u & 255;
      zrow0 = b * SEQ + ft * 64; pos0 = 16 + ft * 64; keybase = 64 + ft * 64; ldvt = LKP;
      Kd = (u16*)(ws + W_KP) + ((long)b * LKP + keybase) * 320; VT = (u16*)(ws + W_VTP) + (long)b * 256 * LKP;
      okv = p.out + O_KVP + ((long)b * 16400 + pos0) * 256; ope = p.out + O_PEP + ((long)b * 16400 + pos0) * 64;
      if (ft == 255) opool = p.out + O_POOLP + (long)b * 15 * 512;
    } else if (u < 544) {
      b = u - 512; sample = true;
      zrow0 = MP + b * 64; pos0 = PAST; keybase = PAST; ldvt = LKS;
      Kd = (u16*)(ws + W_KS) + ((long)b * LKS + keybase) * 320; VT = (u16*)(ws + W_VTS) + (long)b * 256 * LKS;
      okv = p.out + O_KVS + (long)b * 64 * 256; ope = p.out + O_PES + (long)b * 64 * 64;
      opool = p.out + O_POOLS + (long)b * 15 * 512;
    } else {
      b = u - 544; meta = true;
      zrow0 = M; pos0 = 0; keybase = 0; ldvt = LKP;
      Kd = (u16*)(ws + W_KP) + (long)b * LKP * 320; VT = (u16*)(ws + W_VTP) + (long)b * 256 * LKP;
      okv = p.out + O_KVP + (long)b * 16400 * 256; ope = p.out + O_PEP + (long)b * 16400 * 64;
    }
    const int w0 = lane < 32 ? 2 : 4, w1 = lane < 32 ? 8 : 16;
    auto urow = [&](int e) -> const float* {
      if (!sample) return e < 16 ? UP + (long)(M + e) * 512 : UP + (long)(b * SEQ + e - 16) * 512;
      return e < 15 ? p.cache_pool + ((long)b * 15 + e) * 512 : UP + (long)(MP + b * 64 + e - 15) * 512;
    };
    float4 S0 = make_float4(0, 0, 0, 0), S1 = S0;
    const int e0 = sample ? 15 + w * 8 : 16 + (zrow0 - b * SEQ) + w * 8;
    if (!meta) {
      for (int k = 1; k <= 16; ++k) {
        const int e = e0 - k;
        if (e >= 0) {
          const float* ur = urow(e);
          if (k <= w0) { const float4 v = *(const float4*)(ur + 4 * lane); S0.x += v.x; S0.y += v.y; S0.z += v.z; S0.w += v.w; }
          if (k <= w1) { const float4 v = *(const float4*)(ur + 256 + 4 * lane); S1.x += v.x; S1.y += v.y; S1.z += v.z; S1.w += v.w; }
        }
      }
    }
    for (int i = 0; i < 8; ++i) {
      const int r = w * 8 + i;
      const bool valid = !meta || r < 16;
      const long zrow = zrow0 + r;
      float4 x = valid ? *(const float4*)(Z + zrow * ZW + QL + 4 * lane) : make_float4(0, 0, 0, 0);
      float ss = wave_sum(x.x * x.x + x.y * x.y + x.z * x.z + x.w * x.w);
      float rs = rsqrtf(ss * (1.f / 256.f) + EPS);
      const float4 gk = *(const float4*)(p.g_kv + 4 * lane);
      float4 c = make_float4(x.x * rs * gk.x, x.y * rs * gk.y, x.z * rs * gk.z, x.w * rs * gk.w);
      uint2 cb; cb.x = cvtpk(c.x, c.y); cb.y = cvtpk(c.z, c.w);
      *(uint2*)(Kd + r * 320 + 4 * lane) = cb;
      if (valid) *(float4*)(okv + (long)r * 256 + 4 * lane) = c;
      if (lane < 32) {
        float o1 = 0.f, o2 = 0.f;
        if (valid) {
          const float x1 = Z[zrow * ZW + 640 + lane], x2 = Z[zrow * ZW + 672 + lane];
          const float2 cs = TAB[(pos0 + r) * 32 + lane];
          o1 = x1 * cs.x - x2 * cs.y; o2 = x1 * cs.y + x2 * cs.x;
          ope[(long)r * 64 + lane] = o1; ope[(long)r * 64 + 32 + lane] = o2;
        }
        *(unsigned*)(Kd + r * 320 + 256 + 2 * lane) = cvtpk(o1, o2);
      }
      if (!meta) {
        float2 q[3];
#pragma unroll
        for (int j = 0; j < 3; ++j) q[j] = *(const float2*)(Z + zrow * ZW + 2 * lane + 128 * j);
        float qs = 0;
#pragma unroll
        for (int j = 0; j < 3; ++j) qs += q[j].x * q[j].x + q[j].y * q[j].y;
        qs = wave_sum(qs);
        const float qr = rsqrtf(qs * (1.f / 384.f) + EPS);
#pragma unroll
        for (int j = 0; j < 3; ++j) {
          const float2 gq = *(const float2*)(p.g_q + 2 * lane + 128 * j);
          *(unsigned*)((u16*)(ws + X_QN_) + zrow * 384 + 2 * lane + 128 * j) = cvtpk(q[j].x * qr * gq.x, q[j].y * qr * gq.y);
        }
        const int e = e0 + i;
        const float* ur = urow(e);
        const float4 u0 = *(const float4*)(ur + 4 * lane), u1 = *(const float4*)(ur + 256 + 4 * lane);
        float4 d0 = make_float4(0, 0, 0, 0), d1 = d0;
        if (e - w0 >= 0) d0 = *(const float4*)(urow(e - w0) + 4 * lane);
        if (e - w1 >= 0) d1 = *(const float4*)(urow(e - w1) + 256 + 4 * lane);
        S0.x += u0.x - d0.x; S0.y += u0.y - d0.y; S0.z += u0.z - d0.z; S0.w += u0.w - d0.w;
        S1.x += u1.x - d1.x; S1.y += u1.y - d1.y; S1.z += u1.z - d1.z; S1.w += u1.w - d1.w;
        const float i0 = 1.f / (float)w0, i1 = 1.f / (float)w1;
        uint2 pa, pb;
        pa.x = cvtpk(S0.x * i0 - u0.x, S0.y * i0 - u0.y); pa.y = cvtpk(S0.z * i0 - u0.z, S0.w * i0 - u0.w);
        pb.x = cvtpk(S1.x * i1 - u1.x, S1.y * i1 - u1.y); pb.y = cvtpk(S1.z * i1 - u1.z, S1.w * i1 - u1.w);
        *(uint2*)((u16*)(ws + X_PIN) + zrow * 512 + 4 * lane) = pa;
        *(uint2*)((u16*)(ws + X_PIN) + zrow * 512 + 256 + 4 * lane) = pb;
        if (opool != nullptr && r >= 49) {
          *(float4*)(opool + (long)(r - 49) * 512 + 4 * lane) = u0;
          *(float4*)(opool + (long)(r - 49) * 512 + 256 + 4 * lane) = u1;
        }
      }
    }
  }
}

DEVI int row_pos(int row) { return row < MP ? 16 + (row & (SEQ - 1)) : PAST + ((row - MP) & 63); }

DEVI void phase3(const Params& p, char* lds, const int wvs) {
  const int tid = fresh_tid(wvs);
  char* ws = p.ws;
  const int lane = tid & 63, wid = tid >> 6, wr = wid >> 1, wc = wid & 1, r32 = lane & 31, hi = lane >> 5;
  TILE_LOOP(t, (M / 256) * 4) {
    const int tm = t >> 2, g = t & 3;
    f32x16 acc[2][2]; zero_acc(acc);
    gemm_main<2, 2, 4, 2>(acc, (const u16*)(ws + X_PIN) + (long)tm * 256 * 512 + g * 128, 512, (const u16*)(ws + W_WGT) + g * 16384, 128, 128, lds, tid);
    char* stg = stage_base(lds, wid);
#pragma unroll
    for (int m = 0; m < 2; ++m)
#pragma unroll
      for (int n = 0; n < 2; ++n) {
        const float sc = p.pool_scale[g * 128 + wc * 64 + n * 32 + r32];
#pragma unroll
        for (int r = 0; r < 16; ++r) stage_put(stg, 32 * m + crow(r, hi), 32 * n + r32, acc[m][n][r] * sc);
      }
    stage_flush(stg, (u16*)(ws + W_XN) + (long)(tm * 256 + wr * 64) * 512 + g * 128 + wc * 64, 512, lane);
  }
}

struct EpiQ {
  static constexpr bool PERM = true, AFTER_DRAIN = false;
  u16* QB; const float2* TAB;
  __device__ __forceinline__ void operator()(const pg8::f32x4 (&acc)[2][2][4][2], const pg8::Unit& u, int wr, int wc, int fr_, int fq_) const {
    const int l_ = fresh_tid(0), fr = l_ & 15, fq = l_ >> 4;
    (void)fr_; (void)fq_;
#pragma unroll
    for (int bj = 0; bj < 2; ++bj) {
      const int c8 = PG8_COL8(u, bj), grp = u.pn * 256 + bj * 128 + wc * 32, head = grp / 320, hcol = grp - head * 320;
#pragma unroll
      for (int ai = 0; ai < 2; ++ai)
#pragma unroll
        for (int m = 0; m < 4; ++m) {
          const int row = PG8_ROW(u, ai, m);
          const pg8::f32x4 v0 = acc[ai][bj][m][0], v1 = acc[ai][bj][m][1];
          u32x4 w;
          if (hcol < 256) {
            w = (u32x4){cvtpk(v0[0] * QS, v0[1] * QS), cvtpk(v0[2] * QS, v0[3] * QS), cvtpk(v1[0] * QS, v1[1] * QS), cvtpk(v1[2] * QS, v1[3] * QS)};
          } else {
            const float2* tp = TAB + row_pos(row) * 32 + ((c8 - head * 320 - 256) >> 1);
#pragma unroll
            for (int i = 0; i < 4; ++i) {
              const float2 cs = tp[i];
              const float x1 = i < 2 ? v0[2 * i] : v1[2 * i - 4], x2 = i < 2 ? v0[2 * i + 1] : v1[2 * i - 3];
              w[i] = cvtpk((x1 * cs.x - x2 * cs.y) * QS, (x1 * cs.y + x2 * cs.x) * QS);
              __builtin_amdgcn_sched_barrier(0);
            }
          }
          *(u32x4*)(QB + (long)row * 2560 + c8) = w;
          __builtin_amdgcn_sched_barrier(0);
        }
    }
  }
};
DEVI void phase3q(const Params& p, char* lds, const int wvs) {
  const int tid = fresh_tid(wvs);
  char* ws = p.ws;
  __syncthreads();
  EpiQ E; E.QB = (u16*)(ws + X_QB); E.TAB = (const float2*)(ws + W_TAB);
  run_pg8(lds, (const u16*)(ws + X_QN_), (const u16*)(ws + W_COMBT), M, 2560, 384, E, tid);
}

using s16x4 = __attribute__((ext_vector_type(4))) short;
template <int OFF> DEVI s16x4 tr_read(int a) { s16x4 r; asm volatile("ds_read_b64_tr_b16 %0, %1 offset:%2" : "=&v"(r) : "v"(a), "i"(OFF) : "memory"); return r; }
struct TrSet { s16x4 lo[2], hi[2]; };
template <int D0> DEVI void tr_load2(TrSet& s, int a0, int a1) {
  constexpr int B = (D0 >> 1) * 8192;
  s.lo[0] = tr_read<B + 0 * 2048>(a0);        s.hi[0] = tr_read<B + 0 * 2048 + 1024>(a1);
  s.lo[1] = tr_read<B + 1 * 2048>(a0);        s.hi[1] = tr_read<B + 1 * 2048 + 1024>(a1);
}
DEVI bf16x8 pk8(s16x4 l, s16x4 h) { return (bf16x8){l[0], l[1], l[2], l[3], h[0], h[1], h[2], h[3]}; }
DEVI void pv2(f32x16& o, const TrSet& s, const bf16x8 (&pf)[2]) {
#pragma unroll
  for (int f = 0; f < 2; ++f) o = mfma(pk8(s.lo[f], s.hi[f]), pf[f], o);
}
#define WAIT_LGKM(n) asm volatile("s_waitcnt lgkmcnt(" #n ")" ::: "memory")
#define SBAR() __builtin_amdgcn_sched_barrier(0)
constexpr int KBUF = 40960;

constexpr int XP_OFF = 3 * KBUF;
constexpr int XM_OFF = XP_OFF + 8 * 2048;
constexpr int XF_OFF = XM_OFF + 8 * 256;
constexpr int ATT_LDS = XF_OFF + 64;
DEVI void raw_barrier() { asm volatile("s_waitcnt lgkmcnt(0)" ::: "memory"); __builtin_amdgcn_s_barrier(); asm volatile("" ::: "memory"); }

DEVI bool attn_job(int& seq, const bool preset, const float mref, const u16* __restrict__ Q0, const u16* __restrict__ Kt, int ntiles, bool maskfirst, u16* __restrict__ O0, char* lds, const int tid_in) {
  int tid = tid_in; asm volatile("" : "+v"(tid));
  const int lane = tid & 63, w = tid >> 6, r32 = lane & 31, hi = lane >> 5;
  const int pr = w >> 1, u = w & 1;
  const int h = 2 * pr + (r32 >> 4), qi = r32 & 15;
  const u16* qp = Q0 + ((long)qi * 8 + h) * 320 + hi * 8;
  bf16x8 qf[20];
#pragma unroll
  for (int ks = 0; ks < 20; ++ks) qf[ks] = *(const bf16x8*)(qp + ks * 16);
  f32x16 O[4];
#pragma unroll
  for (int d = 0; d < 4; ++d)
#pragma unroll
    for (int r = 0; r < 16; ++r) O[d][r] = 0.f;
  float mrun = mref, lrun = 0.f;
  const int fch = (tid & 7) ^ ((((tid >> 4) & 1) << 2) | ((tid >> 5) & 3));
  const u16* ksrc = Kt + (long)(tid >> 3) * 320 + fch * 8;
  char* lw = lds + w * 1024;
#define A_ISSUE(t_, buf_) do { _Pragma("unroll") for (int i_ = 0; i_ < 5; ++i_) glds16(ksrc + (long)(t_) * 64 * 320 + i_ * 64, lw + (buf_) * KBUF + i_ * 8192); } while (0)
  const int fr = ((r32 & 2) << 1) | ((r32 >> 2) & 3);
  const int frh = (fr ^ hi) * 16;
  const int kk = (lane & 15) >> 2, vh = (lane >> 4) & 1, cl = (lane & 3) >> 1;
  int tb[2][2];
#pragma unroll
  for (int dd = 0; dd < 2; ++dd)
#pragma unroll
    for (int hf = 0; hf < 2; ++hf)
      tb[dd][hf] = (int)(uintptr_t)lds + u * 16384 + (kk + 4 * hi) * 128 + ((((dd ^ (kk >> 1)) << 2) | ((2 * vh + cl) ^ (2 * hf + hi))) * 16) + (lane & 1) * 8;
#define xp_own (lds + XP_OFF + w * 2048 + lane * 32)
#define xp_oth (lds + XP_OFF + (w ^ 1) * 2048 + lane * 32)
#define xm_own ((float*)(lds + XM_OFF) + w * 64 + lane)
#define xm_oth ((const float*)(lds + XM_OFF) + (w ^ 1) * 64 + lane)
  A_ISSUE(0, 0);
  if (ntiles > 1) { A_ISSUE(1, 1); asm volatile("s_waitcnt vmcnt(5)" ::: "memory"); } else { WAIT_VM0(); }
  raw_barrier();
  int cbuf = 0;
#pragma unroll 1
  for (int t = 0; t < ntiles; ++t) {
    const bool more = t + 2 < ntiles;
    const int nbuf = cbuf == 0 ? 2 : cbuf - 1;
    if (more) A_ISSUE(t + 2, nbuf);
    const char* kb = lds + cbuf * KBUF;
    const char* ka = kb + (32 * u + r32) * 128;
    f32x16 s;
#pragma unroll
    for (int r = 0; r < 16; ++r) s[r] = 0.f;
    {
      const int kaddr = (int)(uintptr_t)ka;
      int kad[4];
#pragma unroll
      for (int j = 0; j < 4; ++j) kad[j] = kaddr + ((j * 32) ^ frh);
      bf16x8 fk[4];
#pragma unroll
      for (int ks = 0; ks < 3; ++ks) fk[ks] = lds_rd128(kad[ks & 3], (ks >> 2) * 8192);
#pragma unroll
      for (int ks = 0; ks < 20; ++ks) {
        if (ks + 3 < 20) fk[(ks + 3) & 3] = lds_rd128(kad[(ks + 3) & 3], ((ks + 3) >> 2) * 8192);
        const int ahead = (19 - ks) < 3 ? (19 - ks) : 3;
        if (ahead == 3) WAIT_LGKM(3); else if (ahead == 2) WAIT_LGKM(2); else if (ahead == 1) WAIT_LGKM(1); else WAIT_LGKM(0);
        SBAR();
        s = mfma(fk[ks & 3], qf[ks], s);
        SBAR();
      }
    }
    if (maskfirst && t == 0) {
#pragma unroll
      for (int r = 0; r < 16; ++r) { if (32 * u + crow(r, hi) >= 16) s[r] = -1e30f; }
    }
    if (t == 0 && !preset) {
      float mx = s[0];
#pragma unroll
      for (int r = 1; r < 16; ++r) mx = fmaxf(mx, s[r]);
      mx = fmaxf(mx, __shfl_xor(mx, 32, 64));
      *xm_own = mx;
      raw_barrier();
      mrun = fmaxf(mx, *xm_oth);
    }
    float ps = 0.f;
#pragma unroll
    for (int r = 0; r < 16; ++r) { s[r] = __builtin_amdgcn_exp2f(s[r] - mrun); ps += s[r]; }
    lrun += ps;
    u32x4 own0 = {cvtpk(s[0], s[1]), cvtpk(s[2], s[3]), cvtpk(s[4], s[5]), cvtpk(s[6], s[7])};
    u32x4 own1 = {cvtpk(s[8], s[9]), cvtpk(s[10], s[11]), cvtpk(s[12], s[13]), cvtpk(s[14], s[15])};
    *(u32x4*)xp_own = own0; *(u32x4*)(xp_own + 16) = own1;
    ++seq;
    asm volatile("s_waitcnt lgkmcnt(0)" ::: "memory");
    if (lane == 0) *(volatile int*)(lds + XF_OFF + w * 4) = seq;
    bf16x8 pf[2] = {__builtin_bit_cast(bf16x8, own0), __builtin_bit_cast(bf16x8, own1)};
    const int bo = cbuf * KBUF;
    {
      const int e0 = tb[0][0] + bo + u * 4096, e1 = tb[0][1] + bo + u * 4096, o0 = tb[1][0] + bo + u * 4096, o1 = tb[1][1] + bo + u * 4096;
      TrSet A;
      SBAR();
      tr_load2<0>(A, e0, e1); WAIT_LGKM(0); SBAR(); pv2(O[0], A, pf); SBAR();
      tr_load2<1>(A, o0, o1); WAIT_LGKM(0); SBAR(); pv2(O[1], A, pf); SBAR();
      tr_load2<2>(A, e0, e1); WAIT_LGKM(0); SBAR(); pv2(O[2], A, pf); SBAR();
      tr_load2<3>(A, o0, o1); WAIT_LGKM(0); SBAR(); pv2(O[3], A, pf); SBAR();
    }
    {
      const int faddr = (int)(uintptr_t)lds + XF_OFF + (w ^ 1) * 4;
      for (int spin = 0; spin < (1 << 22); ++spin) {
        int v; asm volatile("ds_read_b32 %0, %1\n\ts_waitcnt lgkmcnt(0)" : "=v"(v) : "v"(faddr) : "memory");
        if (__builtin_amdgcn_readfirstlane(v) - seq >= 0) break;
        __builtin_amdgcn_s_sleep(1);
      }
    }
    {
      const u32x4 oth0 = *(const u32x4*)xp_oth, oth1 = *(const u32x4*)(xp_oth + 16);
      bf16x8 pg[2] = {__builtin_bit_cast(bf16x8, oth0), __builtin_bit_cast(bf16x8, oth1)};
      const int uo = (u ^ 1) * 4096;
      const int e0 = tb[0][0] + bo + uo, e1 = tb[0][1] + bo + uo, o0 = tb[1][0] + bo + uo, o1 = tb[1][1] + bo + uo;
      TrSet A;
      asm volatile("s_waitcnt lgkmcnt(0)" ::: "memory");
      SBAR();
      tr_load2<0>(A, e0, e1); WAIT_LGKM(0); SBAR(); pv2(O[0], A, pg); SBAR();
      tr_load2<1>(A, o0, o1); WAIT_LGKM(0); SBAR(); pv2(O[1], A, pg); SBAR();
      tr_load2<2>(A, e0, e1); WAIT_LGKM(0); SBAR(); pv2(O[2], A, pg); SBAR();
      tr_load2<3>(A, o0, o1); WAIT_LGKM(0); SBAR(); pv2(O[3], A, pg); SBAR();
    }
    if (more) asm volatile("s_waitcnt vmcnt(5)" ::: "memory"); else WAIT_VM0();
    raw_barrier();
    cbuf = cbuf == 2 ? 0 : cbuf + 1;
  }
#undef A_ISSUE
  {
    const int badw = __any(!(lrun < 1.1805916e21f)) ? 1 : 0;
    volatile int* bf = (volatile int*)(lds + XF_OFF + 32);
    if (lane == 0) bf[w] = badw;
    __syncthreads();
    const int anyb = bf[0] | bf[1] | bf[2] | bf[3] | bf[4] | bf[5] | bf[6] | bf[7];
    __syncthreads();
    if (anyb) return true;
  }
  float lsum = lrun + __shfl_xor(lrun, 32, 64);
  *xm_own = lsum;
  __syncthreads();
  const float inv = 1.f / (lsum + *xm_oth);
  __syncthreads();
  u16* op = O0 + ((long)qi * 8 + h) * 256 + 128 * u + 4 * hi;
#pragma unroll
  for (int d = 0; d < 4; ++d)
#pragma unroll
    for (int g = 0; g < 4; ++g) {
      uint2 ov; ov.x = cvtpk(O[d][4 * g] * inv, O[d][4 * g + 1] * inv); ov.y = cvtpk(O[d][4 * g + 2] * inv, O[d][4 * g + 3] * inv);
      *(uint2*)(op + d * 32 + g * 8) = ov;
    }
  return false;
#undef xp_own
#undef xp_oth
#undef xm_own
#undef xm_oth
}

DEVI float attn_maxpass(const u16* __restrict__ Q0, const u16* __restrict__ Kt, int ntiles, bool maskfirst, char* lds, const int tid_in) {
  int tid = tid_in; asm volatile("" : "+v"(tid));
  const int lane = tid & 63, w = tid >> 6, r32 = lane & 31, hi = lane >> 5;
  const int h = 2 * (w >> 1) + (r32 >> 4), qi = r32 & 15;
  const u16* qp = Q0 + ((long)qi * 8 + h) * 320 + hi * 8;
  const int fch = (tid & 7) ^ ((((tid >> 4) & 1) << 2) | ((tid >> 5) & 3));
  const u16* ksrc = Kt + (long)(tid >> 3) * 320 + fch * 8;
  char* lw = lds + w * 1024;
  const int fr = ((r32 & 2) << 1) | ((r32 >> 2) & 3);
  float mrun = -1e30f;
#pragma unroll 1
  for (int t = 0; t < ntiles; ++t) {
#pragma unroll
    for (int i = 0; i < 5; ++i) glds16(ksrc + (long)t * 64 * 320 + i * 64, lw + i * 8192);
    WAIT_VM0(); __syncthreads();
    f32x16 s0, s1;
#pragma unroll
    for (int r = 0; r < 16; ++r) { s0[r] = 0.f; s1[r] = 0.f; }
    const char* ka = lds + r32 * 128;
#pragma unroll 2
    for (int ks = 0; ks < 20; ++ks) {
      const bf16x8 q = *(const bf16x8*)(qp + ks * 16);
      const int off = (ks >> 2) * 8192 + ((2 * (ks & 3) + hi) ^ fr) * 16;
      s0 = mfma(*(const bf16x8*)(ka + off), q, s0);
      s1 = mfma(*(const bf16x8*)(ka + 32 * 128 + off), q, s1);
    }
    if (maskfirst && t == 0) {
#pragma unroll
      for (int r = 0; r < 16; ++r) { if (crow(r, hi) >= 16) s0[r] = -1e30f; s1[r] = -1e30f; }
    }
#pragma unroll
    for (int r = 0; r < 16; ++r) mrun = fmaxf(mrun, fmaxf(s0[r], s1[r]));
    __syncthreads();
  }
  return fmaxf(mrun, __shfl_xor(mrun, 32, 64));
}

static_assert(ATT_LDS <= LDS_BYTES && 2 * 512 * 128 <= LDS_BYTES, "LDS");
DEVI void phase5(const Params& p, char* lds, const int wvs) {
  const int tid = fresh_tid(wvs);
  char* ws = p.ws;
  const u16* QB = (const u16*)(ws + X_QB); u16* OL = (u16*)(ws + X_OL);
  if (tid < 8) *(volatile int*)(lds + XF_OFF + tid * 4) = 0;
  __syncthreads();
  int seq = 0;
  const int ngrp = gridDim.x >> 2;
  const int xcd = blockIdx.x & 7, idx = blockIdx.x >> 3;
  const int grp = xcd + 8 * (idx >> 2), j = idx & 3;
  const int nsamp = blockIdx.x < 128 ? (int)((128 - blockIdx.x + gridDim.x - 1) / gridDim.x) : 0;
  for (int jj = -nsamp;; ++jj) {
    long qrow0; const u16* Kt; int nt; bool mask;
    if (jj < 0) {
      const int sit = (int)blockIdx.x + (jj + nsamp) * (int)gridDim.x;
      const int bd = sit >> 2, js = sit & 3;
      qrow0 = MP + bd * 64 + js * 16; Kt = (const u16*)(ws + W_KS) + (long)bd * LKS * 320; nt = 17; mask = false;
    } else {
      const int k = jj * ngrp + ((jj & 1) ? ngrp - 1 - grp : grp);
      if (k >= 512) break;
      const int c = 255 - (k >> 1), b = k & 1;
      qrow0 = (long)b * SEQ + c * 64 + j * 16; Kt = (const u16*)(ws + W_KP) + (long)b * LKP * 320; nt = c + 2; mask = true;
    }
    bool preset = false; float mref = -1e30f;
    while (true) {
      const bool bad = attn_job(seq, preset, mref, QB + qrow0 * 8 * 320, Kt, nt, mask, OL + qrow0 * 2048, lds, tid);
      if (!bad || preset) break;
      mref = attn_maxpass(QB + qrow0 * 8 * 320, Kt, nt, mask, lds, tid);
      preset = true;
    }
  }
}

DEVI void phase6(const Params& p, char* lds, const int wvs) {
  const int tid = fresh_tid(wvs);
  char* ws = p.ws;
  const int lane = tid & 63, wid = tid >> 6, wr = wid >> 1, wc = wid & 1, r32 = lane & 31, hi = lane >> 5;
  u16* OB = (u16*)(ws + X_OB);
  TILE_LOOP(tile, (M / 256) * 8) {
    const int tm = tile >> 3, h = tile & 7;
    f32x16 acc[2][2]; zero_acc(acc);
    gemm_main_reg<2, 2, 4, 2, 2>(acc, (const u16*)(ws + X_OL) + (long)tm * 256 * 2048 + h * 256, 2048, (const u16*)(ws + W_WUVT) + (long)h * 128 * 256, 256, 256, lds, tid);
    char* stg = stage_base(lds, wid);
#pragma unroll
    for (int m = 0; m < 2; ++m)
#pragma unroll
      for (int n = 0; n < 2; ++n)
#pragma unroll
        for (int r = 0; r < 16; ++r) stage_put(stg, 32 * m + crow(r, hi), 32 * n + r32, acc[m][n][r]);
    stage_flush(stg, OB + (long)(tm * 256 + wr * 64) * 1024 + h * 128 + wc * 64, 1024, lane);
  }
}

DEVI void phase7(const Params& p, char* lds, const int wvs) {
  const int tid = fresh_tid(wvs);
  char* ws = p.ws;
  const int lane = tid & 63, wid = tid >> 6, wr = wid >> 1, wc = wid & 1, r32 = lane & 31, hi = lane >> 5;
  const u16* G = (const u16*)p.out; u16* MG = (u16*)(ws + X_MG);
  TILE_LOOP(tile, (M / 256) * 8) {
    const int tm = tile >> 3, tn = tile & 7;
    f32x16 acc[2][2], acp[2][2]; zero_acc(acc); zero_acc(acp);
    gemm_main<2, 2, 4, 2, 1>(acc, (const u16*)(ws + X_OL) + (long)tm * 256 * 2048, 2048, (const u16*)(ws + W_WPT) + (long)tn * 128 * 2048, 2048, 2048, lds, tid);
    gemm_main<2, 2, 4, 2, 1>(acp, (const u16*)(ws + W_XN) + (long)tm * 256 * 512, 512, (const u16*)(ws + W_WPBT) + (long)tn * 128 * 512, 512, 512, lds, tid);
    char* stg = stage_base(lds, wid);
#pragma unroll
    for (int m = 0; m < 2; ++m)
#pragma unroll
      for (int n = 0; n < 2; ++n) {
        const int brow = tm * 256 + wr * 64 + m * 32, col = tn * 128 + wc * 64 + n * 32 + r32;
#pragma unroll
        for (int r = 0; r < 16; ++r) {
          const long row = brow + crow(r, hi);
          const float ga = __uint_as_float((unsigned)G[row * 2048 + col] << 16), gp = __uint_as_float((unsigned)G[row * 2048 + 1024 + col] << 16);
          stage_put(stg, 32 * m + crow(r, hi), 32 * n + r32, ga * acc[m][n][r] + gp * acp[m][n][r]);
        }
        SBAR();
      }
    stage_flush(stg, MG + (long)(tm * 256 + wr * 64) * 1024 + tn * 128 + wc * 64, 1024, lane);
  }
}

DEVI void phase8(const Params& p, char* lds, const int wvs) {
  const int tid = fresh_tid(wvs);
  char* ws = p.ws;
  {
    const int lane = tid & 63, wid = tid >> 6, wr = wid >> 2, wc = wid & 3, r32 = lane & 31, hi = lane >> 5;
    TILE_LOOP(tile, 256) {
      const int tm = tile >> 3, tn = tile & 7;
      f32x16 acc[1][1]; zero_acc(acc);
      gemm_main_reg<1, 1, 2, 4, 2>(acc, (const u16*)(ws + X_MG) + (long)(MP + tm * 64) * 1024, 1024, (const u16*)(ws + W_WOT) + (long)tn * 128 * 1024, 1024, 1024, lds, tid);
      const int col = tn * 128 + wc * 32 + r32;
#pragma unroll
      for (int r = 0; r < 16; ++r) {
        const long srow = tm * 64 + wr * 32 + crow(r, hi);
        p.out[(MP + srow) * 1024 + col] = p.x_sample[srow * 1024 + col] + acc[0][0][r];
      }
    }
  }
  EpiP8 E; E.Y = p.out; E.xp = p.x_prompt; E.xs = p.x_sample;
  run_pg8(lds, (const u16*)(ws + X_MG), (const u16*)(ws + W_WOT), MP, 1024, 1024, E, tid);
}

DEVI void phase9(const Params& p, const int wvs) {
  const int tid = fresh_tid(wvs);
  const int lane = tid & 63, w = tid >> 6;
  for (int r0 = blockIdx.x * 32 + w; r0 < M; r0 += gridDim.x * 32) {
    const float* s[4]; char* d[4]; bool ok[4], z[4];
#pragma unroll
    for (int k = 0; k < 4; ++k) { const int row = r0 + 8 * k; ok[k] = row < M; z[k] = false; s[k] = p.out + (long)row * 1024; d[k] = (char*)((u16*)(p.ws + W_XN) + (long)row * 1024); }
    rms_rows<4, true>(s, ok, z, p.g_ffn, d, lane);
  }
}
DEVI void phase12(const Params& p, const int wvs) {
  const int tid = fresh_tid(wvs);
  const int lane = tid & 63, w = tid >> 6;
  for (int r0 = blockIdx.x * 32 + w; r0 < M; r0 += gridDim.x * 32) {
    const float* s[4]; char* d[4]; bool ok[4], z[4];
#pragma unroll
    for (int k = 0; k < 4; ++k) { const int row = r0 + 8 * k; ok[k] = row < M; z[k] = false; s[k] = p.out + (long)row * 1024; d[k] = (char*)(p.out + (long)row * 1024); }
    rms_rows<4, false>(s, ok, z, p.g_final, d, lane);
  }
}

DEVI void phase10(const Params& p, char* lds, const int wvs) {
  const int tid = fresh_tid(wvs);
  char* ws = p.ws;
  EpiP10 E; E.U = (u16*)(ws + X_U);
  run_pg8(lds, (const u16*)(ws + W_XN), (const u16*)(ws + W_WUPT), M, 4096, 1024, E, tid);
}

DEVI void phase11(const Params& p, char* lds, const int wvs) {
  const int tid = fresh_tid(wvs);
  char* ws = p.ws;
  {
    const int lane = tid & 63, wid = tid >> 6, wr = wid >> 2, wc = wid & 3, r32 = lane & 31, hi = lane >> 5;
    TILE_LOOP(tile, 256) {
      const int tm = tile >> 3, tn = tile & 7;
      f32x16 acc[1][1]; zero_acc(acc);
      gemm_main_reg<1, 1, 2, 4, 2>(acc, (const u16*)(ws + X_U) + (long)(MP + tm * 64) * 4096, 4096, (const u16*)(ws + W_WDT) + (long)tn * 128 * 4096, 4096, 4096, lds, tid);
      const int col = tn * 128 + wc * 32 + r32;
#pragma unroll
      for (int r = 0; r < 16; ++r) { float* y = p.out + (long)(MP + tm * 64 + wr * 32 + crow(r, hi)) * 1024 + col; *y = *y + acc[0][0][r]; }
    }
  }
  EpiP11 E; E.Y = p.out;
  run_pg8(lds, (const u16*)(ws + X_U), (const u16*)(ws + W_WDT), MP, 1024, 4096, E, tid);
}

__global__ void __launch_bounds__(512) fwd_megakernel(Params p) {
  extern __shared__ __attribute__((aligned(16))) char lds[];
  const int wvs = __builtin_amdgcn_readfirstlane(threadIdx.x >> 6);
  phase0(p, lds, wvs);  cg::this_grid().sync();
  phase1(p, lds, wvs);  grid_barrier(p.ws, 1, wvs);
  phase2w(p, lds, wvs); phase2(p, lds, wvs);  grid_barrier(p.ws, 2, wvs);
  phase3(p, lds, wvs);  phase3q(p, lds, wvs);  grid_barrier(p.ws, 3, wvs);
  phase5(p, lds, wvs);  grid_barrier(p.ws, 4, wvs);
  phase7(p, lds, wvs);  grid_barrier(p.ws, 5, wvs);
  phase8(p, lds, wvs);  grid_barrier(p.ws, 6, wvs);
  phase9(p, wvs);       grid_barrier(p.ws, 7, wvs);
  phase10(p, lds, wvs); grid_barrier(p.ws, 8, wvs);
  phase11(p, lds, wvs); grid_barrier(p.ws, 9, wvs);
  phase12(p, wvs);
}

extern "C" void kernel_launch(void* const* d_in, const int* in_sizes, int n_in, void* d_out, int out_size, void* d_ws, size_t ws_size, hipStream_t stream) {
  static int grid_blocks = 0;
  if (!grid_blocks) {
    if (ws_size < WS_LIMIT + 4096) { fprintf(stderr, "kernel_launch: ws too small: %zu\n", ws_size); return; }
    if (hipFuncSetAttribute((const void*)fwd_megakernel, hipFuncAttributeMaxDynamicSharedMemorySize, LDS_BYTES) != hipSuccess) {
      fprintf(stderr, "kernel_launch: hipFuncSetAttribute failed\n"); return; }
    int dev = 0, cus = 0, per_cu = 0;
    hipGetDevice(&dev);
    hipDeviceGetAttribute(&cus, hipDeviceAttributeMultiprocessorCount, dev);
    hipOccupancyMaxActiveBlocksPerMultiprocessor(&per_cu, fwd_megakernel, 512, LDS_BYTES);
    if (per_cu < 1) { fprintf(stderr, "kernel_launch: occupancy 0\n"); return; }
    grid_blocks = cus - cus % 32;
    if (grid_blocks < 32) { fprintf(stderr, "kernel_launch: too few CUs\n"); grid_blocks = 0; return; }
  }
  Params p{};
  const float** f = (const float**)&p;
  for (int i = 0; i < 22; ++i) f[i] = (const float*)d_in[i];
  p.out = (float*)d_out; p.ws = (char*)d_ws;
  (void)hipMemsetAsync((char*)d_ws + WS_BAR, 0, 256, stream);
  void* args[] = {&p};
  hipError_t e = hipLaunchCooperativeKernel((void*)fwd_megakernel, dim3(grid_blocks), dim3(512), args, LDS_BYTES, stream);
  if (e != hipSuccess) fprintf(stderr, "cooperative launch failed: %s (grid %d)\n", hipGetErrorString(e), grid_blocks);
}
```

```cpp
#include <hip/hip_runtime.h>
#include <hip/hip_cooperative_groups.h>
#include <cstdio>
#include <cstdint>
namespace cg = cooperative_groups;

#define DEVI __device__ __forceinline__
typedef unsigned short u16;
using bf16x8 = __attribute__((ext_vector_type(8))) short;
using f32x16 = __attribute__((ext_vector_type(16))) float;
using u32x4 = __attribute__((ext_vector_type(4))) unsigned;

constexpr int DM = 1024, SEQ = 16384, PAST = 1024, QL = 384, KVL = 256, ROPE = 64, DPOOL = 512, DFF = 4096;
constexpr int DIN = 3264, DIN_PAD = 3328;
constexpr int MP = 2 * SEQ;
constexpr int MS = 32 * 64;
constexpr int M = MP + MS;
constexpr int RALL = M + 256;
constexpr int LKP = 64 + SEQ;
constexpr int LKS = PAST + 64;
constexpr float EPS = 1e-6f;
constexpr float QS = 0.07216878364870322f * 1.4426950408889634f;
constexpr int ZW = 704;

constexpr size_t al256(size_t x) { return (x + 255) / 256 * 256; }
constexpr size_t W_WINT = 0;
constexpr size_t W_WQT  = W_WINT + (size_t)DIN_PAD * 1024 * 2;
constexpr size_t W_WUK  = W_WQT + (size_t)1536 * 384 * 2;
constexpr size_t W_WUVT = W_WUK + (size_t)256 * 1024 * 2;
constexpr size_t W_WABT = W_WUVT + (size_t)1024 * 256 * 2;
constexpr size_t W_WGT  = W_WABT + (size_t)1024 * 1024 * 2;
constexpr size_t W_WPBT = W_WGT + (size_t)4 * 128 * 128 * 2;
constexpr size_t W_WOT  = W_WPBT + (size_t)1024 * 512 * 2;
constexpr size_t W_WUPT = W_WOT + (size_t)1024 * 1024 * 2;
constexpr size_t W_WDT  = W_WUPT + (size_t)4096 * 1024 * 2;
constexpr size_t W_TAB  = W_WDT + (size_t)1024 * 4096 * 2;
constexpr size_t W_XN   = al256(W_TAB + (size_t)16400 * 32 * 8);
constexpr size_t W_KP   = al256(W_XN + (size_t)RALL * 1024 * 2);
constexpr size_t W_VTP  = W_KP + (size_t)2 * LKP * 320 * 2;
constexpr size_t W_COMBT = W_VTP;
constexpr size_t W_WQN  = W_VTP + (size_t)4 * 1024 * 1024;
constexpr size_t W_WUVN = W_VTP + (size_t)6 * 1024 * 1024;
constexpr size_t W_WPT  = W_VTP + (size_t)8 * 1024 * 1024;
constexpr size_t W_KS   = W_VTP + (size_t)2 * 256 * LKP * 2;
constexpr size_t W_VTS  = W_KS + (size_t)32 * LKS * 320 * 2;
constexpr size_t W_X    = al256(W_VTS + (size_t)32 * 256 * LKS * 2);
constexpr size_t X_Z    = W_X;
constexpr size_t X_UP   = X_Z + (size_t)RALL * ZW * 4;
constexpr size_t X_QB   = W_X;
constexpr size_t X_QN_  = W_X + (size_t)190 * 1024 * 1024;
constexpr size_t X_PIN  = X_QN_ + (size_t)M * 384 * 2;
constexpr size_t X_QNOPE= X_PIN + (size_t)M * 512 * 2;
constexpr size_t X_OL   = W_X + (size_t)M * 8 * 320 * 2;
constexpr size_t X_OB   = W_X;
constexpr size_t X_MG   = W_X;
constexpr size_t X_U    = W_X;
constexpr size_t WS_END1 = X_OL + (size_t)M * 2048 * 2;
constexpr size_t WS_END2 = X_QNOPE + (size_t)M * 1024 * 2;
constexpr size_t WS_END3 = X_U + (size_t)M * 4096 * 2;
constexpr size_t WS_LIMIT = (size_t)512 * 1024 * 1024 - 4096;
constexpr size_t WS_BAR = WS_LIMIT;
static_assert(X_UP + (size_t)RALL * 512 * 4 <= X_QN_, "Z/Upool overlap qn");
static_assert(X_QB + (size_t)M * 8 * 320 * 2 <= X_QN_, "Qb overlaps qn");
static_assert(WS_END1 <= WS_LIMIT && WS_END2 <= WS_LIMIT && WS_END3 <= WS_LIMIT, "ws too small");

constexpr size_t O_Y = 0;
constexpr size_t O_KVP = (size_t)M * 1024;
constexpr size_t O_PEP = O_KVP + (size_t)2 * 16400 * 256;
constexpr size_t O_POOLP = O_PEP + (size_t)2 * 16400 * 64;
constexpr size_t O_KVS = O_POOLP + (size_t)2 * 15 * 512;
constexpr size_t O_PES = O_KVS + (size_t)32 * 64 * 256;
constexpr size_t O_POOLS = O_PES + (size_t)32 * 64 * 64;

constexpr int ABUF = 64 * 640 + 256 * 128;
constexpr int LDS_BYTES = 141568;

struct Params {
  const float *x_prompt, *x_sample, *cache_kv, *cache_rope, *cache_pool, *meta, *w_in, *g_mix, *g_q, *g_kv, *w_q_up, *w_uk, *w_uv,
      *w_attn_br, *w_pool_grp, *pool_scale, *w_pool_br, *w_out, *g_ffn, *w_up, *w_down, *g_final;
  float* out; char* ws;
};

DEVI unsigned cvtpk(float lo, float hi) { unsigned r; asm("v_cvt_pk_bf16_f32 %0, %1, %2" : "=v"(r) : "v"(lo), "v"(hi)); return r; }
DEVI u16 tobf(float x) { return (u16)(cvtpk(x, 0.f) & 0xffffu); }
DEVI uint2 pack4(float a, float b, float c, float d) { uint2 o; o.x = cvtpk(a, b); o.y = cvtpk(c, d); return o; }
DEVI int crow(int r, int hi) { return (r & 3) + 8 * (r >> 2) + 4 * hi; }
DEVI float wave_sum(float v) {
#pragma unroll
  for (int o = 32; o; o >>= 1) v += __shfl_xor(v, o, 64);
  return v;
}
DEVI f32x16 mfma(bf16x8 a, bf16x8 b, f32x16 c) { return __builtin_amdgcn_mfma_f32_32x32x16_bf16(a, b, c, 0, 0, 0); }
DEVI int fresh_tid(int ws) { int l; asm volatile("v_mbcnt_lo_u32_b32 %0, -1, 0\n\tv_mbcnt_hi_u32_b32 %0, -1, %0" : "=v"(l)); return ws * 64 + l; }
DEVI void grid_barrier(char* wsbase, unsigned k, int wvs) {
  unsigned* ctr = (unsigned*)(wsbase + ((size_t)512 * 1024 * 1024 - 4096));
  const unsigned target = k * gridDim.x;
  __threadfence();
  __syncthreads();
  if (fresh_tid(wvs) == 0) {
    __hip_atomic_fetch_add(ctr, 1u, __ATOMIC_RELAXED, __HIP_MEMORY_SCOPE_AGENT);
    while (__hip_atomic_load(ctr, __ATOMIC_RELAXED, __HIP_MEMORY_SCOPE_AGENT) < target) __builtin_amdgcn_s_sleep(2);
  }
  __syncthreads();
  __threadfence();
}


DEVI bf16x8 lds_rd128(int a, const int off) { bf16x8 r; asm volatile("ds_read_b128 %0, %1 offset:%2" : "=&v"(r) : "v"(a), "i"(off) : "memory"); return r; }
DEVI void glds16(const void* g, void* l) { __builtin_amdgcn_global_load_lds((const unsigned*)g, (unsigned*)l, 16, 0, 0); }
#define WAIT_VM0() asm volatile("s_waitcnt vmcnt(0)" ::: "memory")

template <int TM, int TN, int WR, int WC, int DEP = (TM + TN > 4 ? 1 : 2)>
DEVI void gemm_main_dma(f32x16 (&acc)[TM][TN], const u16* __restrict__ A, long lda, const u16* __restrict__ Bt, long ldb, int K, char* lds, const int tid,
                    const bool pre = false, const u16* __restrict__ nA = nullptr, const u16* __restrict__ nBt = nullptr) {
  static_assert(WR * WC == 8, "8 waves");
  constexpr int BM = 32 * TM * WR, BN = 32 * TN * WC, NA = BM / 64, NB = BN / 64, BUF = (BM + BN) * 128;
  const int lane = tid & 63, wid = tid >> 6, wr = wid / WC, wc = wid % WC, r32 = lane & 31, hi = lane >> 5;
  const int lrow = tid >> 3, lch = (tid & 7) ^ ((((tid >> 4) & 1) << 2) | ((tid >> 5) & 3));
  const u16* ag = A + (long)lrow * lda + lch * 8;
  const u16* bg = Bt + (long)lrow * ldb + lch * 8;
  char* lw = lds + wid * 1024;
#define G_ISSUE(kt_, buf_) do { \
    _Pragma("unroll") for (int i_ = 0; i_ < NA; ++i_) glds16(ag + (long)(64 * i_) * lda + (kt_) * 64, lw + (buf_) * BUF + i_ * 8192); \
    _Pragma("unroll") for (int i_ = 0; i_ < NB; ++i_) glds16(bg + (long)(64 * i_) * ldb + (kt_) * 64, lw + (buf_) * BUF + (NA + i_) * 8192); } while (0)
  const int fr = ((r32 & 2) << 1) | ((r32 >> 2) & 3);
  int o[4];
#pragma unroll
  for (int j = 0; j < 4; ++j) o[j] = ((2 * j + hi) ^ fr) * 16;
  const int KT = K / 64;
  if (!pre) G_ISSUE(0, 0);
  WAIT_VM0(); __syncthreads();
#pragma unroll 1
  for (int kt = 0; kt < KT; ++kt) {
    if (kt + 1 < KT) G_ISSUE(kt + 1, (kt + 1) & 1);
    const int abase = (int)(uintptr_t)lds + (kt & 1) * BUF + (wr * 32 * TM + r32) * 128;
    const int bbase = (int)(uintptr_t)lds + (kt & 1) * BUF + (BM + wc * 32 * TN + r32) * 128;
    bf16x8 fs[DEP + 1][TM + TN];
#define F_LOAD(set_, ks_) do { const int aa_ = abase + o[ks_], bb_ = bbase + o[ks_]; \
      _Pragma("unroll") for (int m_ = 0; m_ < TM; ++m_) fs[set_][m_] = lds_rd128(aa_, m_ * 4096); \
      _Pragma("unroll") for (int n_ = 0; n_ < TN; ++n_) fs[set_][TM + n_] = lds_rd128(bb_, n_ * 4096); } while (0)
#pragma unroll
    for (int pks = 0; pks < DEP; ++pks) F_LOAD(pks, pks);
#pragma unroll
    for (int ks = 0; ks < 4; ++ks) {
      if (ks + DEP < 4) F_LOAD((ks + DEP) % (DEP + 1), ks + DEP);
      constexpr int NF = TM + TN;
      const int ahead = (4 - 1 - ks) < DEP ? (4 - 1 - ks) : DEP;
      if (ahead == 2) asm volatile("s_waitcnt lgkmcnt(%0)" :: "n"(2 * NF) : "memory");
      else if (ahead == 1) asm volatile("s_waitcnt lgkmcnt(%0)" :: "n"(NF) : "memory");
      else asm volatile("s_waitcnt lgkmcnt(0)" ::: "memory");
      __builtin_amdgcn_sched_barrier(0);
#pragma unroll
      for (int m = 0; m < TM; ++m)
#pragma unroll
        for (int n = 0; n < TN; ++n) acc[m][n] = mfma(fs[ks % (DEP + 1)][m], fs[ks % (DEP + 1)][TM + n], acc[m][n]);
      __builtin_amdgcn_sched_barrier(0);
    }
#undef F_LOAD
    WAIT_VM0(); __syncthreads();
  }
  if (nA != nullptr) {
    const u16* ag2 = nA + (long)lrow * lda + lch * 8;
    const u16* bg2 = nBt + (long)lrow * ldb + lch * 8;
#pragma unroll
    for (int i = 0; i < NA; ++i) glds16(ag2 + (long)(64 * i) * lda, lw + i * 8192);
#pragma unroll
    for (int i = 0; i < NB; ++i) glds16(bg2 + (long)(64 * i) * ldb, lw + (NA + i) * 8192);
  }
#undef G_ISSUE
}
template <int TM, int TN, int WR, int WC, int DEP = (TM + TN > 4 ? 1 : 2)>
DEVI void gemm_main_reg(f32x16 (&acc)[TM][TN], const u16* __restrict__ A, long lda, const u16* __restrict__ Bt, long ldb, int K, char* lds, const int tid,
                    const bool pre = false, const u16* __restrict__ nA = nullptr, const u16* __restrict__ nBt = nullptr) {
  static_assert(WR * WC == 8, "8 waves");
  constexpr int BM = 32 * TM * WR, BN = 32 * TN * WC, NA = BM / 64, NB = BN / 64, BUF = (BM + BN) * 128;
  const int lane = tid & 63, wid = tid >> 6, wr = wid / WC, wc = wid % WC, r32 = lane & 31, hi = lane >> 5;
  const int lrow = tid >> 3, lpos = (tid & 7) ^ ((((tid >> 4) & 1) << 2) | ((tid >> 5) & 3));
  const u16* ag = A + (long)lrow * lda + (tid & 7) * 8;
  const u16* bg = Bt + (long)lrow * ldb + (tid & 7) * 8;
  char* lwr = lds + lrow * 128 + lpos * 16;
  u32x4 r0[NA + NB], r1[NA + NB];
#define G_LOAD(R_, kt_) do { \
    _Pragma("unroll") for (int i_ = 0; i_ < NA; ++i_) R_[i_] = *(const u32x4*)(ag + (long)(64 * i_) * lda + (kt_) * 64); \
    _Pragma("unroll") for (int i_ = 0; i_ < NB; ++i_) R_[NA + i_] = *(const u32x4*)(bg + (long)(64 * i_) * ldb + (kt_) * 64); } while (0)
#define S_WRITE(R_, buf_) do { _Pragma("unroll") for (int i_ = 0; i_ < NA + NB; ++i_) *(u32x4*)(lwr + (buf_) * BUF + i_ * 8192) = R_[i_]; } while (0)
  const int fr = ((r32 & 2) << 1) | ((r32 >> 2) & 3);
  int o[4];
#pragma unroll
  for (int j = 0; j < 4; ++j) o[j] = ((2 * j + hi) ^ fr) * 16;
  const int KT = K / 64;
  (void)pre; (void)nA; (void)nBt;
#define K_TILE(buf_) do { \
    const int abase = (int)(uintptr_t)lds + (buf_) * BUF + (wr * 32 * TM + r32) * 128; \
    const int bbase = (int)(uintptr_t)lds + (buf_) * BUF + (BM + wc * 32 * TN + r32) * 128; \
    bf16x8 fs[DEP + 1][TM + TN]; \
    _Pragma("unroll") for (int pks = 0; pks < DEP; ++pks) { const int aa_ = abase + o[pks], bb_ = bbase + o[pks]; \
      _Pragma("unroll") for (int m_ = 0; m_ < TM; ++m_) fs[pks][m_] = lds_rd128(aa_, m_ * 4096); \
      _Pragma("unroll") for (int n_ = 0; n_ < TN; ++n_) fs[pks][TM + n_] = lds_rd128(bb_, n_ * 4096); } \
    _Pragma("unroll") for (int ks = 0; ks < 4; ++ks) { \
      if (ks + DEP < 4) { const int aa_ = abase + o[(ks + DEP) & 3], bb_ = bbase + o[(ks + DEP) & 3]; \
        _Pragma("unroll") for (int m_ = 0; m_ < TM; ++m_) fs[(ks + DEP) % (DEP + 1)][m_] = lds_rd128(aa_, m_ * 4096); \
        _Pragma("unroll") for (int n_ = 0; n_ < TN; ++n_) fs[(ks + DEP) % (DEP + 1)][TM + n_] = lds_rd128(bb_, n_ * 4096); } \
      const int ahead = (4 - 1 - ks) < DEP ? (4 - 1 - ks) : DEP; \
      if (ahead == 2) asm volatile("s_waitcnt lgkmcnt(%0)" :: "n"(2 * (TM + TN)) : "memory"); \
      else if (ahead == 1) asm volatile("s_waitcnt lgkmcnt(%0)" :: "n"(TM + TN) : "memory"); \
      else asm volatile("s_waitcnt lgkmcnt(0)" ::: "memory"); \
      __builtin_amdgcn_sched_barrier(0); \
      _Pragma("unroll") for (int m = 0; m < TM; ++m) \
        _Pragma("unroll") for (int n = 0; n < TN; ++n) acc[m][n] = mfma(fs[ks % (DEP + 1)][m], fs[ks % (DEP + 1)][TM + n], acc[m][n]); \
      __builtin_amdgcn_sched_barrier(0); \
    } } while (0)
  G_LOAD(r0, 0); S_WRITE(r0, 0); G_LOAD(r1, 1);
  __syncthreads();
#pragma unroll 1
  for (int kt = 0; kt < KT; kt += 2) {
    if (kt + 2 < KT) G_LOAD(r0, kt + 2);
    K_TILE(0);
    S_WRITE(r1, 1);
    __syncthreads();
    if (kt + 3 < KT) G_LOAD(r1, kt + 3);
    K_TILE(1);
    if (kt + 2 < KT) S_WRITE(r0, 0);
    __syncthreads();
  }
#undef K_TILE
#undef G_LOAD
#undef S_WRITE
}
template <int TM, int TN, int WR, int WC, int DEP = (TM + TN > 4 ? 1 : 2)>
DEVI void gemm_main(f32x16 (&acc)[TM][TN], const u16* __restrict__ A, long lda, const u16* __restrict__ Bt, long ldb, int K, char* lds, const int tid,
                    const bool pre = false, const u16* __restrict__ nA = nullptr, const u16* __restrict__ nBt = nullptr) {
  gemm_main_dma<TM, TN, WR, WC, DEP>(acc, A, lda, Bt, ldb, K, lds, tid, pre, nA, nBt);
}
#define TILE_LOOP(tile, NT) \
  for (int it_ = 0, tile = 0; it_ * 8 * (int)(gridDim.x >> 3) < (NT); ++it_) \
    if ((tile = (it_ * 8 + (int)(blockIdx.x & 7)) * (int)(gridDim.x >> 3) + (int)(blockIdx.x >> 3)) < (NT))
template <int TM, int TN> DEVI void zero_acc(f32x16 (&acc)[TM][TN]) {
#pragma unroll
  for (int m = 0; m < TM; ++m)
#pragma unroll
    for (int n = 0; n < TN; ++n)
#pragma unroll
      for (int r = 0; r < 16; ++r) acc[m][n][r] = 0.f;
}

template <int R, bool BF>
DEVI void rms_rows(const float* const (&src)[R], const bool (&ok)[R], const bool (&zero)[R], const float* __restrict__ g, char* const (&dst)[R], const int lane) {
  float4 v[R][4];
#pragma unroll
  for (int k = 0; k < R; ++k)
#pragma unroll
    for (int i = 0; i < 4; ++i) v[k][i] = (ok[k] && !zero[k]) ? *(const float4*)(src[k] + 4 * lane + 256 * i) : make_float4(0, 0, 0, 0);
  float ss[R];
#pragma unroll
  for (int k = 0; k < R; ++k) {
    ss[k] = 0;
#pragma unroll
    for (int i = 0; i < 4; ++i) ss[k] += v[k][i].x * v[k][i].x + v[k][i].y * v[k][i].y + v[k][i].z * v[k][i].z + v[k][i].w * v[k][i].w;
  }
#pragma unroll
  for (int o = 32; o; o >>= 1)
#pragma unroll
    for (int k = 0; k < R; ++k) ss[k] += __shfl_xor(ss[k], o, 64);
#pragma unroll
  for (int i = 0; i < 4; ++i) {
    const float4 gg = *(const float4*)(g + 4 * lane + 256 * i);
#pragma unroll
    for (int k = 0; k < R; ++k) {
      if (!ok[k]) continue;
      const float rs = rsqrtf(ss[k] * (1.f / 1024.f) + EPS);
      const float4 y = make_float4(v[k][i].x * rs * gg.x, v[k][i].y * rs * gg.y, v[k][i].z * rs * gg.z, v[k][i].w * rs * gg.w);
      if (BF) *(uint2*)((u16*)dst[k] + 4 * lane + 256 * i) = pack4(y.x, y.y, y.z, y.w);
      else *(float4*)((float*)dst[k] + 4 * lane + 256 * i) = y;
    }
  }
}

DEVI void phase0(const Params& p, char* lds, const int wvs) {
  const int tid512 = fresh_tid(wvs);
  char* ws = p.ws;
  const int half = tid512 >> 8, tid = tid512 & 255, lane = tid & 63, w = tid >> 6;
  float* T = (float*)lds + half * (64 * 65);
  constexpr int U_T = 3728, U_C = U_T + 512, U_X = U_C + 548, U_R = U_X + 513, U_K = U_R + 256, U_P = U_K + 32;
  for (int it = blockIdx.x; 2 * it < U_P; it += gridDim.x) {
    const int u = 2 * it + half;
    const float* src = nullptr; u16* dst = nullptr; int N = 0, Kd = 0, k0 = 0, n0 = 0; bool isq = false;
    const bool tr = u < U_T;
    if (tr) {
      int t = u;
      if (t < 816) { src = p.w_in; dst = (u16*)(ws + W_WINT); Kd = 1024; N = DIN; }
      else if (t < 960) { t -= 816; src = p.w_q_up; dst = (u16*)(ws + W_WQT); Kd = 384; N = 1536; isq = true; }
      else if (t < 1024) { t -= 960; src = p.w_uv; dst = (u16*)(ws + W_WUVT); Kd = 256; N = 1024; }
      else if (t < 1280) { t -= 1024; src = p.w_attn_br; dst = (u16*)(ws + W_WABT); Kd = 1024; N = 1024; }
      else if (t < 1296) { t -= 1280; const int g = t >> 2; t &= 3; src = p.w_pool_grp + g * 16384; dst = (u16*)(ws + W_WGT) + g * 16384; Kd = 128; N = 128; }
      else if (t < 1424) { t -= 1296; src = p.w_pool_br; dst = (u16*)(ws + W_WPBT); Kd = 512; N = 1024; }
      else if (t < 1680) { t -= 1424; src = p.w_out; dst = (u16*)(ws + W_WOT); Kd = 1024; N = 1024; }
      else if (t < 2704) { t -= 1680; src = p.w_up; dst = (u16*)(ws + W_WUPT); Kd = 1024; N = 4096; }
      else { t -= 2704; src = p.w_down; dst = (u16*)(ws + W_WDT); Kd = 4096; N = 1024; }
      const int nt = N / 64; const int tk = t / nt, tn = t - tk * nt;
      k0 = tk * 64; n0 = tn * 64;
#pragma unroll
      for (int i = 0; i < 16; ++i) { const int k = w + 4 * i; const float v = src[(long)(k0 + k) * N + n0 + lane]; T[k * 65 + lane] = v;
        if (isq) ((u16*)(ws + W_WQN))[(long)(k0 + k) * 1536 + n0 + lane] = tobf(v); }
    }
    __syncthreads();
    if (tr) {
      const int n = tid >> 2, kc = (tid & 3) * 16;
      unsigned pk[8];
#pragma unroll
      for (int j = 0; j < 8; ++j) pk[j] = cvtpk(T[(kc + 2 * j) * 65 + n], T[(kc + 2 * j + 1) * 65 + n]);
      uint4* d = (uint4*)(dst + (long)(n0 + n) * Kd + k0 + kc);
      d[0] = make_uint4(pk[0], pk[1], pk[2], pk[3]); d[1] = make_uint4(pk[4], pk[5], pk[6], pk[7]);
      if (isq && n0 % 192 == 128) {
        uint4* d2 = (uint4*)((u16*)(ws + W_COMBT) + (long)((n0 / 192) * 320 + 256 + (n < 32 ? 2 * n : 2 * (n - 32) + 1)) * 384 + k0 + kc);
        d2[0] = make_uint4(pk[0], pk[1], pk[2], pk[3]); d2[1] = make_uint4(pk[4], pk[5], pk[6], pk[7]);
      }
    } else if (u < U_C) {
      const int c = u - U_T, bd = c >> 4, ct = c & 15;
      u16* Kd2 = (u16*)(ws + W_KS) + ((long)bd * LKS + ct * 64) * 320;
#pragma unroll 4
      for (int i = 0; i < 16; ++i) {
        const int r = w * 16 + i;
        const float4 v = *(const float4*)(p.cache_kv + ((long)(bd * PAST + ct * 64 + r)) * 256 + 4 * lane);
        uint2 o; o.x = cvtpk(v.x, v.y); o.y = cvtpk(v.z, v.w);
        *(uint2*)(Kd2 + r * 320 + 4 * lane) = o;
        const float kr = p.cache_rope[((long)(bd * PAST + ct * 64 + r)) * 64 + lane];
        Kd2[r * 320 + 256 + (lane < 32 ? 2 * lane : 2 * (lane - 32) + 1)] = tobf(kr);
      }
    } else if (u < U_X) {
      const int ru = u - U_C;
      for (int i = 0; i < 16; i += 4) {
        const float* s[4]; char* d[4]; bool ok[4], z[4];
#pragma unroll
        for (int k = 0; k < 4; ++k) {
          const int R = ru * 64 + w * 16 + i + k;
          s[k] = R < MP ? p.x_prompt + (long)R * 1024 : (R < M ? p.x_sample + (long)(R - MP) * 1024 : p.meta + (long)(R - M) * 1024);
          ok[k] = true; z[k] = R >= M + 16; d[k] = (char*)((u16*)(ws + W_XN) + (long)R * 1024);
        }
        rms_rows<4, true>(s, ok, z, p.g_mix, d, lane);
      }
    } else if (u < U_R) {
      const int base = (u - U_X) * 1024;
      for (int i = 0; i < 4; ++i) {
        const int e = base + i * 256 + tid;
        if (e < 16400 * 32) {
          const int pos = e >> 5, j = e & 31;
          const float inv = exp2f(-(float)j * 0.41524101186092029f);
          const double rev = (double)pos * (double)inv * 0.15915494309189535;
          const float fr = (float)(rev - floor(rev));
          float2 cs; cs.x = __builtin_amdgcn_cosf(fr); cs.y = __builtin_amdgcn_sinf(fr);
          ((float2*)(ws + W_TAB))[e] = cs;
        }
      }
    } else if (u < U_K) {
      const int e = ((u - U_R) * 256 + tid) * 4;
      const float4 v = *(const float4*)(p.w_uk + e);
      uint2 o; o.x = cvtpk(v.x, v.y); o.y = cvtpk(v.z, v.w);
      *(uint2*)((u16*)(ws + W_WUK) + e) = o;
      const float4 v2 = *(const float4*)(p.w_uv + e);
      uint2 o2; o2.x = cvtpk(v2.x, v2.y); o2.y = cvtpk(v2.z, v2.w);
      *(uint2*)((u16*)(ws + W_WUVN) + e) = o2;
    } else if (u < U_P) {
      const int e = (u - U_K) * 256 + tid;
      ((uint4*)((u16*)(ws + W_WINT) + (long)DIN * 1024))[e] = make_uint4(0, 0, 0, 0);
    }
    __syncthreads();
  }
}

DEVI char* stage_base(char* lds, int wid) { return lds + 65536 + wid * 8192; }
DEVI void stage_put(char* stg, int row, int col, float v) { *(u16*)(stg + row * 128 + col * 2) = tobf(v); }
DEVI void stage_flush(const char* stg, u16* __restrict__ out, long ld, int lane) {
#pragma unroll
  for (int j = 0; j < 8; ++j) {
    const int q = lane + 64 * j, row = q >> 3, c = q & 7;
    const uint4 v = *(const uint4*)(stg + row * 128 + c * 16);
    *(uint4*)(out + (long)row * ld + c * 8) = v;
  }
}


namespace pg8 {
#define PG8_LAS __attribute__((address_space(3)))
typedef unsigned short bf16_t;
typedef float f32x4 __attribute__((ext_vector_type(4)));
constexpr int BM = 256, BK = 64, HALF = 128, HTB = HALF * BK * 2, STAGE_BYTES = 8 * HTB, NXCD = 8, WGM = 8;
__device__ __forceinline__ int lds_byte(int r, int c) { const int st = (r >> 4) * 2 + (c >> 5), rr = r & 15, cc = c & 31, ob = rr * 64 + cc * 2; return st * 1024 + (ob ^ (((ob >> 9) & 1) << 5)); }
__device__ __forceinline__ void stage_rc(int b, int& R, int& C) { const int st = b / 1024, sb = b % 1024, swz = sb ^ (((sb >> 9) & 1) << 5); R = (st >> 1) * 16 + swz / 64; C = (st & 1) * 32 + (swz % 64) / 2; }
__device__ __forceinline__ int perm32(int rho) { const int n = rho >> 4, i = rho & 15; return 8 * (i >> 2) + 4 * n + (i & 3); }
struct Unit { int pm, pn; };
struct Gemm { const bf16_t* A; const bf16_t* Bt; int M, N, K; };
struct StaticOrder {
    int nM, nN, nwg, G, c;
    __device__ void init(int M, int N, int G_, int c_) { nM = M / BM; nN = N / BM; nwg = nM * nN; G = G_; c = c_; }
    __device__ bool next(int i, Unit& u) const {
        const long L = (long)i * G + c; if (L >= nwg) return false;
        int wgid = (int)L; { const int q = nwg / NXCD, r = nwg % NXCD, xcd = wgid % NXCD, off = wgid / NXCD; wgid = (xcd < r ? xcd * (q + 1) : r * (q + 1) + (xcd - r) * q) + off; }
        const int nig = WGM * nN, gid = wgid / nig, fm = gid * WGM, gsz = (nM - fm) < WGM ? (nM - fm) : WGM;
        u.pm = fm + ((wgid % nig) % gsz); u.pn = (wgid % nig) / gsz; return true;
    }
    __device__ __forceinline__ void a_ready(const Unit&) const {}
    __device__ __forceinline__ void done(const Unit&) const {}
};
template <class Epi, class Sched>
__device__ __forceinline__ void gemm_phase(PG8_LAS unsigned char* lds, const Gemm g, const Sched& S, const Epi& E, const int tid) {
    const int wid = __builtin_amdgcn_readfirstlane(tid >> 6), lane = tid & 63, wr = wid >> 2, wc = wid & 3, fr = lane & 15, fq = lane >> 4;
    const int K = g.K, nt = K / BK;
    unsigned voffA[2], voffB[2];
#pragma unroll
    for (int i = 0; i < 2; ++i) { int R, C; stage_rc(tid * 16 + i * 8192, R, C); const int Rb = Epi::PERM ? ((R & ~31) + perm32(R & 31)) : R;
        voffA[i] = (unsigned)(R * K + C) * 2u; voffB[i] = (unsigned)(Rb * K + C) * 2u; }
    const size_t kstep = (size_t)(BK * 2);
    const size_t hstep = (size_t)HALF * K * 2;
    const size_t tstep = 2 * hstep;
    const unsigned ldsw = (unsigned)wid * 1024u;
    const int aoff = lds_byte(wr * 64 + fr, fq * 8), boff = lds_byte(wc * 32 + fr, fq * 8);
#define PG8_SA(b, h) (((b) * 2 + (h)) * HTB)
#define PG8_SB(b, h) ((4 + (b) * 2 + (h)) * HTB)
#define PG8_STAGE(bufoff, gbase, voff) do { _Pragma("unroll") for (int _i = 0; _i < 2; ++_i) \
        __builtin_amdgcn_global_load_lds((const unsigned*)((const char*)(gbase) + (voff)[_i]), (PG8_LAS unsigned*)(lds + (bufoff) + ldsw + _i * 8192), 16, 0, 0); } while (0)
#define PG8_LDA(dst, b, h) do { _Pragma("unroll") for (int m = 0; m < 4; ++m) _Pragma("unroll") for (int k = 0; k < 2; ++k) dst[m][k] = *(const PG8_LAS bf16x8*)(lds + PG8_SA(b, h) + aoff + m * 2048 + k * 1024); } while (0)
#define PG8_LDB(dst, b, h) do { _Pragma("unroll") for (int n = 0; n < 2; ++n) _Pragma("unroll") for (int k = 0; k < 2; ++k) dst[n][k] = *(const PG8_LAS bf16x8*)(lds + PG8_SB(b, h) + boff + n * 2048 + k * 1024); } while (0)
#define PG8_MMA(ai, bj, At, Bt) do { __builtin_amdgcn_s_setprio(1); _Pragma("unroll") for (int m = 0; m < 4; ++m) _Pragma("unroll") for (int n = 0; n < 2; ++n) _Pragma("unroll") for (int k = 0; k < 2; ++k) \
        acc[ai][bj][m][n] = __builtin_amdgcn_mfma_f32_16x16x32_bf16(Bt[n][k], At[m][k], acc[ai][bj][m][n], 0, 0, 0); __builtin_amdgcn_s_setprio(0); } while (0)
#define PG8_WAIT_V(n) asm volatile("s_waitcnt vmcnt(" #n ")" ::: "memory")
#define PG8_WAIT_L(n) asm volatile("s_waitcnt lgkmcnt(" #n ")" ::: "memory")
#define PG8_BAR __builtin_amdgcn_s_barrier()
#define PG8_SCHED __builtin_amdgcn_sched_barrier(0)
    Unit cur, nxt; int ui = 0;
    if (!S.next(0, cur)) return;
    f32x4 acc[2][2][4][2];
#pragma unroll
    for (int a = 0; a < 2; ++a)
#pragma unroll
        for (int b = 0; b < 2; ++b)
#pragma unroll
            for (int m = 0; m < 4; ++m)
#pragma unroll
                for (int n = 0; n < 2; ++n) acc[a][b][m][n] = (f32x4){0.f, 0.f, 0.f, 0.f};
    bf16x8 At[4][2], B0[2][2], B1[2][2];
    const char* cA = (const char*)g.A + (size_t)cur.pm * tstep; const char* cB = (const char*)g.Bt + (size_t)cur.pn * tstep;
    S.a_ready(cur);
    PG8_STAGE(PG8_SB(0, 0), cB, voffB); PG8_STAGE(PG8_SA(0, 0), cA, voffA); PG8_STAGE(PG8_SB(0, 1), cB + hstep, voffB); PG8_STAGE(PG8_SA(0, 1), cA + hstep, voffA);
    if (wr == 1) PG8_BAR;
    PG8_WAIT_V(4); PG8_BAR;
    PG8_STAGE(PG8_SB(1, 0), cB + kstep, voffB); PG8_STAGE(PG8_SA(1, 0), cA + kstep, voffA); PG8_STAGE(PG8_SB(1, 1), cB + hstep + kstep, voffB);
    PG8_WAIT_V(6); PG8_BAR;
    for (;;) {
        const bool has_next = S.next(ui + 1, nxt);
        const char* nA = has_next ? (const char*)g.A + (size_t)nxt.pm * tstep : cA; const char* nB = has_next ? (const char*)g.Bt + (size_t)nxt.pn * tstep : cB;
        for (int t = 0; t < nt; t += 2) {
            const bool last = (t == nt - 2);
            const char* a1 = cA + (size_t)(t + 1) * kstep;
            const char* a2 = last ? nA : cA + (size_t)(t + 2) * kstep; const char* b2 = last ? nB : cB + (size_t)(t + 2) * kstep;
            const char* a3 = a2 + kstep; const char* b3 = b2 + kstep;
            if (last && has_next) S.a_ready(nxt);
            PG8_LDB(B0, 0, 0); PG8_SCHED; PG8_LDA(At, 0, 0); PG8_STAGE(PG8_SA(1, 1), a1 + hstep, voffA);
            PG8_WAIT_L(8); PG8_BAR; PG8_WAIT_L(0); PG8_MMA(0, 0, At, B0); PG8_BAR; PG8_SCHED;
            PG8_LDB(B1, 0, 1); PG8_STAGE(PG8_SB(0, 0), b2, voffB);
            PG8_BAR; PG8_WAIT_L(0); PG8_MMA(0, 1, At, B1); PG8_BAR;
            PG8_LDA(At, 0, 1); PG8_STAGE(PG8_SA(0, 0), a2, voffA);
            PG8_BAR; PG8_WAIT_L(0); PG8_MMA(1, 0, At, B0); PG8_BAR; PG8_SCHED;
            PG8_STAGE(PG8_SB(0, 1), b2 + hstep, voffB);
            PG8_WAIT_V(6); PG8_BAR; PG8_MMA(1, 1, At, B1); PG8_BAR;
            PG8_LDB(B0, 1, 0); PG8_SCHED; PG8_LDA(At, 1, 0); PG8_STAGE(PG8_SA(0, 1), a2 + hstep, voffA);
            PG8_WAIT_L(8); PG8_BAR; PG8_WAIT_L(0); PG8_MMA(0, 0, At, B0); PG8_BAR; PG8_SCHED;
            PG8_LDB(B1, 1, 1); PG8_STAGE(PG8_SB(1, 0), b3, voffB);
            PG8_BAR; PG8_WAIT_L(0); PG8_MMA(0, 1, At, B1); PG8_BAR;
            PG8_LDA(At, 1, 1); PG8_STAGE(PG8_SA(1, 0), a3, voffA);
            PG8_BAR; PG8_WAIT_L(0); PG8_MMA(1, 0, At, B0); PG8_BAR; PG8_SCHED;
            PG8_STAGE(PG8_SB(1, 1), b3 + hstep, voffB);
            PG8_WAIT_V(6); PG8_BAR; PG8_MMA(1, 1, At, B1); PG8_BAR;
        }
            if constexpr (!Epi::AFTER_DRAIN) { E(acc, cur, wr, wc, fr, fq); S.done(cur); }
            if (!has_next) break;
#pragma unroll
        for (int a = 0; a < 2; ++a)
#pragma unroll
            for (int b = 0; b < 2; ++b)
#pragma unroll
                for (int m = 0; m < 4; ++m)
#pragma unroll
                    for (int n = 0; n < 2; ++n) acc[a][b][m][n] = (f32x4){0.f, 0.f, 0.f, 0.f};
        cur = nxt; cA = nA; cB = nB; ++ui;
    }
    PG8_WAIT_V(0);
    if (wr == 0) PG8_BAR;
    PG8_BAR;
    if constexpr (Epi::AFTER_DRAIN) { E.fused(acc, cur, wr, wc, fr, fq, lds, wid, lane); S.done(cur); }
#undef PG8_SA
#undef PG8_SB
#undef PG8_STAGE
#undef PG8_LDA
#undef PG8_LDB
#undef PG8_MMA
#undef PG8_WAIT_V
#undef PG8_WAIT_L
#undef PG8_BAR
#undef PG8_SCHED
}
}

#define PG8_ROW(u, ai, m) ((u).pm * 256 + (ai) * 128 + wr * 64 + (m) * 16 + fr)
#define PG8_COL8(u, bj) ((u).pn * 256 + (bj) * 128 + wc * 32 + 8 * fq)
struct EpiP1 {
  static constexpr bool PERM = true, AFTER_DRAIN = false;
  float* Z; float* UP; u16* G;
  __device__ __forceinline__ void operator()(const pg8::f32x4 (&acc)[2][2][4][2], const pg8::Unit& u, int wr, int wc, int fr, int fq) const {
#pragma unroll
    for (int bj = 0; bj < 2; ++bj) {
      const int c8 = PG8_COL8(u, bj), grp = u.pn * 256 + bj * 128 + wc * 32;
#pragma unroll
      for (int ai = 0; ai < 2; ++ai)
#pragma unroll
        for (int m = 0; m < 4; ++m) {
          const long row = PG8_ROW(u, ai, m);
          if (grp < ZW) { *(pg8::f32x4*)(Z + row * ZW + c8) = acc[ai][bj][m][0]; *(pg8::f32x4*)(Z + row * ZW + c8 + 4) = acc[ai][bj][m][1]; }
          else if (grp < ZW + DPOOL) { *(pg8::f32x4*)(UP + row * 512 + c8 - ZW) = acc[ai][bj][m][0]; *(pg8::f32x4*)(UP + row * 512 + c8 - ZW + 4) = acc[ai][bj][m][1]; }
          else if (grp < DIN && row < M) {
            float s[8];
#pragma unroll
            for (int j = 0; j < 4; ++j) { s[j] = 1.f / (1.f + __expf(-acc[ai][bj][m][0][j])); s[4 + j] = 1.f / (1.f + __expf(-acc[ai][bj][m][1][j])); }
            u32x4 w = {cvtpk(s[0], s[1]), cvtpk(s[2], s[3]), cvtpk(s[4], s[5]), cvtpk(s[6], s[7])};
            *(u32x4*)(G + row * 2048 + c8 - (ZW + DPOOL)) = w;
          }
        }
    }
  }
};
struct EpiP8 {
  static constexpr bool PERM = true, AFTER_DRAIN = false;
  float* Y; const float* xp; const float* xs;
  __device__ __forceinline__ void operator()(const pg8::f32x4 (&acc)[2][2][4][2], const pg8::Unit& u, int wr, int wc, int fr, int fq) const {
#pragma unroll
    for (int ai = 0; ai < 2; ++ai)
#pragma unroll
      for (int m = 0; m < 4; ++m) {
        const long row = PG8_ROW(u, ai, m);
        const float* xr = row < MP ? xp + row * 1024 : xs + (row - MP) * 1024;
#pragma unroll
        for (int bj = 0; bj < 2; ++bj) {
          const int c8 = PG8_COL8(u, bj);
          const pg8::f32x4 x0 = *(const pg8::f32x4*)(xr + c8), x1 = *(const pg8::f32x4*)(xr + c8 + 4);
          *(pg8::f32x4*)(Y + row * 1024 + c8) = x0 + acc[ai][bj][m][0]; *(pg8::f32x4*)(Y + row * 1024 + c8 + 4) = x1 + acc[ai][bj][m][1];
        }
      }
  }
};
struct EpiP10 {
  static constexpr bool PERM = true, AFTER_DRAIN = false;
  u16* U;
  __device__ __forceinline__ void operator()(const pg8::f32x4 (&acc)[2][2][4][2], const pg8::Unit& u, int wr, int wc, int fr, int fq) const {
#pragma unroll
    for (int ai = 0; ai < 2; ++ai)
#pragma unroll
      for (int m = 0; m < 4; ++m) {
        const long row = PG8_ROW(u, ai, m);
#pragma unroll
        for (int bj = 0; bj < 2; ++bj) {
          float v[8];
#pragma unroll
          for (int j = 0; j < 4; ++j) { const float a = fmaxf(acc[ai][bj][m][0][j], 0.f), b = fmaxf(acc[ai][bj][m][1][j], 0.f); v[j] = a * a; v[4 + j] = b * b; }
          u32x4 w = {cvtpk(v[0], v[1]), cvtpk(v[2], v[3]), cvtpk(v[4], v[5]), cvtpk(v[6], v[7])};
          *(u32x4*)(U + row * 4096 + PG8_COL8(u, bj)) = w;
        }
      }
  }
};
struct EpiP11 {
  static constexpr bool PERM = true, AFTER_DRAIN = false;
  float* Y;
  __device__ __forceinline__ void operator()(const pg8::f32x4 (&acc)[2][2][4][2], const pg8::Unit& u, int wr, int wc, int fr, int fq) const {
#pragma unroll
    for (int ai = 0; ai < 2; ++ai)
#pragma unroll
      for (int m = 0; m < 4; ++m) {
        const long row = PG8_ROW(u, ai, m);
#pragma unroll
        for (int bj = 0; bj < 2; ++bj) {
          float* y = Y + row * 1024 + PG8_COL8(u, bj);
          const pg8::f32x4 h0 = *(const pg8::f32x4*)y, h1 = *(const pg8::f32x4*)(y + 4);
          *(pg8::f32x4*)y = h0 + acc[ai][bj][m][0]; *(pg8::f32x4*)(y + 4) = h1 + acc[ai][bj][m][1];
        }
      }
  }
};
template <class Epi>
DEVI void run_pg8(char* lds, const u16* A, const u16* Bt, int Mr, int Nc, int K, const Epi& E, const int tid) {
  pg8::StaticOrder S; S.init(Mr, Nc, (int)gridDim.x, (int)blockIdx.x);
  pg8::Gemm g; g.A = A; g.Bt = Bt; g.M = Mr; g.N = Nc; g.K = K;
  pg8::gemm_phase<Epi, pg8::StaticOrder>((PG8_LAS unsigned char*)lds, g, S, E, tid);
}

DEVI void phase1(const Params& p, char* lds, const int wvs) {
  const int tid = fresh_tid(wvs);
  char* ws = p.ws;
  EpiP1 E; E.Z = (float*)(ws + X_Z); E.UP = (float*)(ws + X_UP); E.G = (u16*)p.out;
  run_pg8(lds, (const u16*)(ws + W_XN), (const u16*)(ws + W_WINT), RALL, DIN_PAD, 1024, E, tid);
}

DEVI void phase2w(const Params& p, char* lds, const int wvs) {
  const int tid = fresh_tid(wvs);
  char* ws = p.ws;
  const int lane = tid & 63;
  for (int ct = blockIdx.x; ct < 24; ct += gridDim.x) {
    const int h = ct / 3, t3 = ct - 3 * h, wid = tid >> 6, wr = wid >> 1, wc = wid & 1, r32 = lane & 31, hi = lane >> 5;
    f32x16 acc[2][2]; zero_acc(acc);
    gemm_main<2, 2, 4, 2>(acc, (const u16*)(ws + W_WUK) + h * 128, 1024, (const u16*)(ws + W_WQN) + (long)(t3 * 128) * 1536 + h * 192, 1536, 128, lds, tid);
    char* stg = stage_base(lds, wid);
#pragma unroll
    for (int m = 0; m < 2; ++m)
#pragma unroll
      for (int n = 0; n < 2; ++n)
#pragma unroll
        for (int r = 0; r < 16; ++r) stage_put(stg, 32 * m + crow(r, hi), 32 * n + r32, acc[m][n][r]);
    stage_flush(stg, (u16*)(ws + W_COMBT) + (long)(h * 320 + wr * 64) * 384 + t3 * 128 + wc * 64, 384, lane);
    __syncthreads();
  }
  for (int ct = (int)blockIdx.x - 24; ct < 64; ct += gridDim.x) {
    if (ct < 0) continue;
    const int h = ct >> 3, jt = (ct >> 1) & 3, cn = ct & 1, wid = tid >> 6, wr = wid >> 1, wc = wid & 1, r32 = lane & 31, hi = lane >> 5;
    f32x16 acc[2][2]; zero_acc(acc);
    gemm_main<2, 2, 4, 2>(acc, (const u16*)(ws + W_WABT) + (long)(jt * 256) * 1024 + h * 128, 1024, (const u16*)(ws + W_WUVN) + (long)(cn * 128) * 1024 + h * 128, 1024, 128, lds, tid);
    char* stg = stage_base(lds, wid);
#pragma unroll
    for (int m = 0; m < 2; ++m)
#pragma unroll
      for (int n = 0; n < 2; ++n)
#pragma unroll
        for (int r = 0; r < 16; ++r) stage_put(stg, 32 * m + crow(r, hi), 32 * n + r32, acc[m][n][r]);
    stage_flush(stg, (u16*)(ws + W_WPT) + (long)(jt * 256 + wr * 64) * 2048 + h * 256 + cn * 128 + wc * 64, 2048, lane);
    __syncthreads();
  }
}
DEVI void phase2(const Params& p, char* lds, const int wvs) {
  const int tid = fresh_tid(wvs);
  char* ws = p.ws;
  const int lane = tid & 63, w = tid >> 6;
  const float* Z = (const float*)(ws + X_Z); const float* UP = (const float*)(ws + X_UP);
  const float2* TAB = (const float2*)(ws + W_TAB);
  for (int u = blockIdx.x; u < 546; u += gridDim.x) {
    int zrow0, pos0, keybase, b = 0; long ldvt; u16 *Kd, *VT; float *okv, *ope, *opool = nullptr; bool meta = false, sample = false;
    if (u < 512) {
      b = u >> 8; const int ft = u & 255;
      zrow0 = b * SEQ + ft * 64; pos0 = 16 + ft * 64; keybase = 64 + ft * 64; ldvt = LKP;
      Kd = (u16*)(ws + W_KP) + ((long)b * LKP + keybase) * 320; VT = (u16*)(ws + W_VTP) + (long)b * 256 * LKP;
      okv = p.out + O_KVP + ((long)b * 16400 + pos0) * 256; ope = p.out + O_PEP + ((long)b * 16400 + pos0) * 64;
      if (ft == 255) opool = p.out + O_POOLP + (long)b * 15 * 512;
    } else if (u < 544) {
      b = u - 512; sample = true;
      zrow0 = MP + b * 64; pos0 = PAST; keybase = PAST; ldvt = LKS;
      Kd = (u16*)(ws + W_KS) + ((long)b * LKS + keybase) * 320; VT = (u16*)(ws + W_VTS) + (long)b * 256 * LKS;
      okv = p.out + O_KVS + (long)b * 64 * 256; ope = p.out + O_PES + (long)b * 64 * 64;
      opool = p.out + O_POOLS + (long)b * 15 * 512;
    } else {
      b = u - 544; meta = true;
      zrow0 = M; pos0 = 0; keybase = 0; ldvt = LKP;
      Kd = (u16*)(ws + W_KP) + (long)b * LKP * 320; VT = (u16*)(ws + W_VTP) + (long)b * 256 * LKP;
      okv = p.out + O_KVP + (long)b * 16400 * 256; ope = p.out + O_PEP + (long)b * 16400 * 64;
    }
    const int w0 = lane < 32 ? 2 : 4, w1 = lane < 32 ? 8 : 16;
    auto urow = [&](int e) -> const float* {
      if (!sample) return e < 16 ? UP + (long)(M + e) * 512 : UP + (long)(b * SEQ + e - 16) * 512;
      return e < 15 ? p.cache_pool + ((long)b * 15 + e) * 512 : UP + (long)(MP + b * 64 + e - 15) * 512;
    };
    float4 S0 = make_float4(0, 0, 0, 0), S1 = S0;
    const int e0 = sample ? 15 + w * 8 : 16 + (zrow0 - b * SEQ) + w * 8;
    if (!meta) {
      for (int k = 1; k <= 16; ++k) {
        const int e = e0 - k;
        if (e >= 0) {
          const float* ur = urow(e);
          if (k <= w0) { const float4 v = *(const float4*)(ur + 4 * lane); S0.x += v.x; S0.y += v.y; S0.z += v.z; S0.w += v.w; }
          if (k <= w1) { const float4 v = *(const float4*)(ur + 256 + 4 * lane); S1.x += v.x; S1.y += v.y; S1.z += v.z; S1.w += v.w; }
        }
      }
    }
    for (int i = 0; i < 8; ++i) {
      const int r = w * 8 + i;
      const bool valid = !meta || r < 16;
      const long zrow = zrow0 + r;
      float4 x = valid ? *(const float4*)(Z + zrow * ZW + QL + 4 * lane) : make_float4(0, 0, 0, 0);
      float ss = wave_sum(x.x * x.x + x.y * x.y + x.z * x.z + x.w * x.w);
      float rs = rsqrtf(ss * (1.f / 256.f) + EPS);
      const float4 gk = *(const float4*)(p.g_kv + 4 * lane);
      float4 c = make_float4(x.x * rs * gk.x, x.y * rs * gk.y, x.z * rs * gk.z, x.w * rs * gk.w);
      uint2 cb; cb.x = cvtpk(c.x, c.y); cb.y = cvtpk(c.z, c.w);
      *(uint2*)(Kd + r * 320 + 4 * lane) = cb;
      if (valid) *(float4*)(okv + (long)r * 256 + 4 * lane) = c;
      if (lane < 32) {
        float o1 = 0.f, o2 = 0.f;
        if (valid) {
          const float x1 = Z[zrow * ZW + 640 + lane], x2 = Z[zrow * ZW + 672 + lane];
          const float2 cs = TAB[(pos0 + r) * 32 + lane];
          o1 = x1 * cs.x - x2 * cs.y; o2 = x1 * cs.y + x2 * cs.x;
          ope[(long)r * 64 + lane] = o1; ope[(long)r * 64 + 32 + lane] = o2;
        }
        *(unsigned*)(Kd + r * 320 + 256 + 2 * lane) = cvtpk(o1, o2);
      }
      if (!meta) {
        float2 q[3];
#pragma unroll
        for (int j = 0; j < 3; ++j) q[j] = *(const float2*)(Z + zrow * ZW + 2 * lane + 128 * j);
        float qs = 0;
#pragma unroll
        for (int j = 0; j < 3; ++j) qs += q[j].x * q[j].x + q[j].y * q[j].y;
        qs = wave_sum(qs);
        const float qr = rsqrtf(qs * (1.f / 384.f) + EPS);
#pragma unroll
        for (int j = 0; j < 3; ++j) {
          const float2 gq = *(const float2*)(p.g_q + 2 * lane + 128 * j);
          *(unsigned*)((u16*)(ws + X_QN_) + zrow * 384 + 2 * lane + 128 * j) = cvtpk(q[j].x * qr * gq.x, q[j].y * qr * gq.y);
        }
        const int e = e0 + i;
        const float* ur = urow(e);
        const float4 u0 = *(const float4*)(ur + 4 * lane), u1 = *(const float4*)(ur + 256 + 4 * lane);
        float4 d0 = make_float4(0, 0, 0, 0), d1 = d0;
        if (e - w0 >= 0) d0 = *(const float4*)(urow(e - w0) + 4 * lane);
        if (e - w1 >= 0) d1 = *(const float4*)(urow(e - w1) + 256 + 4 * lane);
        S0.x += u0.x - d0.x; S0.y += u0.y - d0.y; S0.z += u0.z - d0.z; S0.w += u0.w - d0.w;
        S1.x += u1.x - d1.x; S1.y += u1.y - d1.y; S1.z += u1.z - d1.z; S1.w += u1.w - d1.w;
        const float i0 = 1.f / (float)w0, i1 = 1.f / (float)w1;
        uint2 pa, pb;
        pa.x = cvtpk(S0.x * i0 - u0.x, S0.y * i0 - u0.y); pa.y = cvtpk(S0.z * i0 - u0.z, S0.w * i0 - u0.w);
        pb.x = cvtpk(S1.x * i1 - u1.x, S1.y * i1 - u1.y); pb.y = cvtpk(S1.z * i1 - u1.z, S1.w * i1 - u1.w);
        *(uint2*)((u16*)(ws + X_PIN) + zrow * 512 + 4 * lane) = pa;
        *(uint2*)((u16*)(ws + X_PIN) + zrow * 512 + 256 + 4 * lane) = pb;
        if (opool != nullptr && r >= 49) {
          *(float4*)(opool + (long)(r - 49) * 512 + 4 * lane) = u0;
          *(float4*)(opool + (long)(r - 49) * 512 + 256 + 4 * lane) = u1;
        }
      }
    }
  }
}

DEVI int row_pos(int row) { return row < MP ? 16 + (row & (SEQ - 1)) : PAST + ((row - MP) & 63); }

DEVI void phase3(const Params& p, char* lds, const int wvs) {
  const int tid = fresh_tid(wvs);
  char* ws = p.ws;
  const int lane = tid & 63, wid = tid >> 6, wr = wid >> 1, wc = wid & 1, r32 = lane & 31, hi = lane >> 5;
  TILE_LOOP(t, (M / 256) * 4) {
    const int tm = t >> 2, g = t & 3;
    f32x16 acc[2][2]; zero_acc(acc);
    gemm_main<2, 2, 4, 2>(acc, (const u16*)(ws + X_PIN) + (long)tm * 256 * 512 + g * 128, 512, (const u16*)(ws + W_WGT) + g * 16384, 128, 128, lds, tid);
    char* stg = stage_base(lds, wid);
#pragma unroll
    for (int m = 0; m < 2; ++m)
#pragma unroll
      for (int n = 0; n < 2; ++n) {
        const float sc = p.pool_scale[g * 128 + wc * 64 + n * 32 + r32];
#pragma unroll
        for (int r = 0; r < 16; ++r) stage_put(stg, 32 * m + crow(r, hi), 32 * n + r32, acc[m][n][r] * sc);
      }
    stage_flush(stg, (u16*)(ws + W_XN) + (long)(tm * 256 + wr * 64) * 512 + g * 128 + wc * 64, 512, lane);
  }
}

struct EpiQ {
  static constexpr bool PERM = true, AFTER_DRAIN = false;
  u16* QB; const float2* TAB;
  __device__ __forceinline__ void operator()(const pg8::f32x4 (&acc)[2][2][4][2], const pg8::Unit& u, int wr, int wc, int fr_, int fq_) const {
    const int l_ = fresh_tid(0), fr = l_ & 15, fq = l_ >> 4;
    (void)fr_; (void)fq_;
#pragma unroll
    for (int bj = 0; bj < 2; ++bj) {
      const int c8 = PG8_COL8(u, bj), grp = u.pn * 256 + bj * 128 + wc * 32, head = grp / 320, hcol = grp - head * 320;
#pragma unroll
      for (int ai = 0; ai < 2; ++ai)
#pragma unroll
        for (int m = 0; m < 4; ++m) {
          const int row = PG8_ROW(u, ai, m);
          const pg8::f32x4 v0 = acc[ai][bj][m][0], v1 = acc[ai][bj][m][1];
          u32x4 w;
          if (hcol < 256) {
            w = (u32x4){cvtpk(v0[0] * QS, v0[1] * QS), cvtpk(v0[2] * QS, v0[3] * QS), cvtpk(v1[0] * QS, v1[1] * QS), cvtpk(v1[2] * QS, v1[3] * QS)};
          } else {
            const float2* tp = TAB + row_pos(row) * 32 + ((c8 - head * 320 - 256) >> 1);
#pragma unroll
            for (int i = 0; i < 4; ++i) {
              const float2 cs = tp[i];
              const float x1 = i < 2 ? v0[2 * i] : v1[2 * i - 4], x2 = i < 2 ? v0[2 * i + 1] : v1[2 * i - 3];
              w[i] = cvtpk((x1 * cs.x - x2 * cs.y) * QS, (x1 * cs.y + x2 * cs.x) * QS);
              __builtin_amdgcn_sched_barrier(0);
            }
          }
          *(u32x4*)(QB + (long)row * 2560 + c8) = w;
          __builtin_amdgcn_sched_barrier(0);
        }
    }
  }
};
DEVI void phase3q(const Params& p, char* lds, const int wvs) {
  const int tid = fresh_tid(wvs);
  char* ws = p.ws;
  __syncthreads();
  EpiQ E; E.QB = (u16*)(ws + X_QB); E.TAB = (const float2*)(ws + W_TAB);
  run_pg8(lds, (const u16*)(ws + X_QN_), (const u16*)(ws + W_COMBT), M, 2560, 384, E, tid);
}

using s16x4 = __attribute__((ext_vector_type(4))) short;
template <int OFF> DEVI s16x4 tr_read(int a) { s16x4 r; asm volatile("ds_read_b64_tr_b16 %0, %1 offset:%2" : "=&v"(r) : "v"(a), "i"(OFF) : "memory"); return r; }
struct TrSet { s16x4 lo[2], hi[2]; };
template <int D0> DEVI void tr_load2(TrSet& s, int a0, int a1) {
  constexpr int B = (D0 >> 1) * 8192;
  s.lo[0] = tr_read<B + 0 * 2048>(a0);        s.hi[0] = tr_read<B + 0 * 2048 + 1024>(a1);
  s.lo[1] = tr_read<B + 1 * 2048>(a0);        s.hi[1] = tr_read<B + 1 * 2048 + 1024>(a1);
}
DEVI bf16x8 pk8(s16x4 l, s16x4 h) { return (bf16x8){l[0], l[1], l[2], l[3], h[0], h[1], h[2], h[3]}; }
DEVI void pv2(f32x16& o, const TrSet& s, const bf16x8 (&pf)[2]) {
#pragma unroll
  for (int f = 0; f < 2; ++f) o = mfma(pk8(s.lo[f], s.hi[f]), pf[f], o);
}
#define WAIT_LGKM(n) asm volatile("s_waitcnt lgkmcnt(" #n ")" ::: "memory")
#define SBAR() __builtin_amdgcn_sched_barrier(0)
constexpr int KBUF = 40960;

constexpr int XP_OFF = 3 * KBUF;
constexpr int XM_OFF = XP_OFF + 8 * 2048;
constexpr int XF_OFF = XM_OFF + 8 * 256;
constexpr int ATT_LDS = XF_OFF + 64;
DEVI void raw_barrier() { asm volatile("s_waitcnt lgkmcnt(0)" ::: "memory"); __builtin_amdgcn_s_barrier(); asm volatile("" ::: "memory"); }

DEVI bool attn_job(int& seq, const bool preset, const float mref, const u16* __restrict__ Q0, const u16* __restrict__ Kt, int ntiles, bool maskfirst, u16* __restrict__ O0, char* lds, const int tid_in) {
  int tid = tid_in; asm volatile("" : "+v"(tid));
  const int lane = tid & 63, w = tid >> 6, r32 = lane & 31, hi = lane >> 5;
  const int pr = w >> 1, u = w & 1;
  const int h = 2 * pr + (r32 >> 4), qi = r32 & 15;
  const u16* qp = Q0 + ((long)qi * 8 + h) * 320 + hi * 8;
  bf16x8 qf[20];
#pragma unroll
  for (int ks = 0; ks < 20; ++ks) qf[ks] = *(const bf16x8*)(qp + ks * 16);
  f32x16 O[4];
#pragma unroll
  for (int d = 0; d < 4; ++d)
#pragma unroll
    for (int r = 0; r < 16; ++r) O[d][r] = 0.f;
  float mrun = mref, lrun = 0.f;
  const int fch = (tid & 7) ^ ((((tid >> 4) & 1) << 2) | ((tid >> 5) & 3));
  const u16* ksrc = Kt + (long)(tid >> 3) * 320 + fch * 8;
  char* lw = lds + w * 1024;
#define A_ISSUE(t_, buf_) do { _Pragma("unroll") for (int i_ = 0; i_ < 5; ++i_) glds16(ksrc + (long)(t_) * 64 * 320 + i_ * 64, lw + (buf_) * KBUF + i_ * 8192); } while (0)
  const int fr = ((r32 & 2) << 1) | ((r32 >> 2) & 3);
  const int frh = (fr ^ hi) * 16;
  const int kk = (lane & 15) >> 2, vh = (lane >> 4) & 1, cl = (lane & 3) >> 1;
  int tb[2][2];
#pragma unroll
  for (int dd = 0; dd < 2; ++dd)
#pragma unroll
    for (int hf = 0; hf < 2; ++hf)
      tb[dd][hf] = (int)(uintptr_t)lds + u * 16384 + (kk + 4 * hi) * 128 + ((((dd ^ (kk >> 1)) << 2) | ((2 * vh + cl) ^ (2 * hf + hi))) * 16) + (lane & 1) * 8;
#define xp_own (lds + XP_OFF + w * 2048 + lane * 32)
#define xp_oth (lds + XP_OFF + (w ^ 1) * 2048 + lane * 32)
#define xm_own ((float*)(lds + XM_OFF) + w * 64 + lane)
#define xm_oth ((const float*)(lds + XM_OFF) + (w ^ 1) * 64 + lane)
  A_ISSUE(0, 0);
  if (ntiles > 1) { A_ISSUE(1, 1); asm volatile("s_waitcnt vmcnt(5)" ::: "memory"); } else { WAIT_VM0(); }
  raw_barrier();
  int cbuf = 0;
#pragma unroll 1
  for (int t = 0; t < ntiles; ++t) {
    const bool more = t + 2 < ntiles;
    const int nbuf = cbuf == 0 ? 2 : cbuf - 1;
    if (more) A_ISSUE(t + 2, nbuf);
    const char* kb = lds + cbuf * KBUF;
    const char* ka = kb + (32 * u + r32) * 128;
    f32x16 s;
#pragma unroll
    for (int r = 0; r < 16; ++r) s[r] = 0.f;
    {
      const int kaddr = (int)(uintptr_t)ka;
      int kad[4];
#pragma unroll
      for (int j = 0; j < 4; ++j) kad[j] = kaddr + ((j * 32) ^ frh);
      bf16x8 fk[4];
#pragma unroll
      for (int ks = 0; ks < 3; ++ks) fk[ks] = lds_rd128(kad[ks & 3], (ks >> 2) * 8192);
#pragma unroll
      for (int ks = 0; ks < 20; ++ks) {
        if (ks + 3 < 20) fk[(ks + 3) & 3] = lds_rd128(kad[(ks + 3) & 3], ((ks + 3) >> 2) * 8192);
        const int ahead = (19 - ks) < 3 ? (19 - ks) : 3;
        if (ahead == 3) WAIT_LGKM(3); else if (ahead == 2) WAIT_LGKM(2); else if (ahead == 1) WAIT_LGKM(1); else WAIT_LGKM(0);
        SBAR();
        s = mfma(fk[ks & 3], qf[ks], s);
        SBAR();
      }
    }
    if (maskfirst && t == 0) {
#pragma unroll
      for (int r = 0; r < 16; ++r) { if (32 * u + crow(r, hi) >= 16) s[r] = -1e30f; }
    }
    if (t == 0 && !preset) {
      float mx = s[0];
#pragma unroll
      for (int r = 1; r < 16; ++r) mx = fmaxf(mx, s[r]);
      mx = fmaxf(mx, __shfl_xor(mx, 32, 64));
      *xm_own = mx;
      raw_barrier();
      mrun = fmaxf(mx, *xm_oth);
    }
    float ps = 0.f;
#pragma unroll
    for (int r = 0; r < 16; ++r) { s[r] = __builtin_amdgcn_exp2f(s[r] - mrun); ps += s[r]; }
    lrun += ps;
    u32x4 own0 = {cvtpk(s[0], s[1]), cvtpk(s[2], s[3]), cvtpk(s[4], s[5]), cvtpk(s[6], s[7])};
    u32x4 own1 = {cvtpk(s[8], s[9]), cvtpk(s[10], s[11]), cvtpk(s[12], s[13]), cvtpk(s[14], s[15])};
    *(u32x4*)xp_own = own0; *(u32x4*)(xp_own + 16) = own1;
    ++seq;
    asm volatile("s_waitcnt lgkmcnt(0)" ::: "memory");
    if (lane == 0) *(volatile int*)(lds + XF_OFF + w * 4) = seq;
    bf16x8 pf[2] = {__builtin_bit_cast(bf16x8, own0), __builtin_bit_cast(bf16x8, own1)};
    const int bo = cbuf * KBUF;
    {
      const int e0 = tb[0][0] + bo + u * 4096, e1 = tb[0][1] + bo + u * 4096, o0 = tb[1][0] + bo + u * 4096, o1 = tb[1][1] + bo + u * 4096;
      TrSet A;
      SBAR();
      tr_load2<0>(A, e0, e1); WAIT_LGKM(0); SBAR(); pv2(O[0], A, pf); SBAR();
      tr_load2<1>(A, o0, o1); WAIT_LGKM(0); SBAR(); pv2(O[1], A, pf); SBAR();
      tr_load2<2>(A, e0, e1); WAIT_LGKM(0); SBAR(); pv2(O[2], A, pf); SBAR();
      tr_load2<3>(A, o0, o1); WAIT_LGKM(0); SBAR(); pv2(O[3], A, pf); SBAR();
    }
    {
      const int faddr = (int)(uintptr_t)lds + XF_OFF + (w ^ 1) * 4;
      for (int spin = 0; spin < (1 << 22); ++spin) {
        int v; asm volatile("ds_read_b32 %0, %1\n\ts_waitcnt lgkmcnt(0)" : "=v"(v) : "v"(faddr) : "memory");
        if (__builtin_amdgcn_readfirstlane(v) - seq >= 0) break;
        __builtin_amdgcn_s_sleep(1);
      }
    }
    {
      const u32x4 oth0 = *(const u32x4*)xp_oth, oth1 = *(const u32x4*)(xp_oth + 16);
      bf16x8 pg[2] = {__builtin_bit_cast(bf16x8, oth0), __builtin_bit_cast(bf16x8, oth1)};
      const int uo = (u ^ 1) * 4096;
      const int e0 = tb[0][0] + bo + uo, e1 = tb[0][1] + bo + uo, o0 = tb[1][0] + bo + uo, o1 = tb[1][1] + bo + uo;
      TrSet A;
      asm volatile("s_waitcnt lgkmcnt(0)" ::: "memory");
      SBAR();
      tr_load2<0>(A, e0, e1); WAIT_LGKM(0); SBAR(); pv2(O[0], A, pg); SBAR();
      tr_load2<1>(A, o0, o1); WAIT_LGKM(0); SBAR(); pv2(O[1], A, pg); SBAR();
      tr_load2<2>(A, e0, e1); WAIT_LGKM(0); SBAR(); pv2(O[2], A, pg); SBAR();
      tr_load2<3>(A, o0, o1); WAIT_LGKM(0); SBAR(); pv2(O[3], A, pg); SBAR();
    }
    if (more) asm volatile("s_waitcnt vmcnt(5)" ::: "memory"); else WAIT_VM0();
    raw_barrier();
    cbuf = cbuf == 2 ? 0 : cbuf + 1;
  }
#undef A_ISSUE
  {
    const int badw = __any(!(lrun < 1.1805916e21f)) ? 1 : 0;
    volatile int* bf = (volatile int*)(lds + XF_OFF + 32);
    if (lane == 0) bf[w] = badw;
    __syncthreads();
    const int anyb = bf[0] | bf[1] | bf[2] | bf[3] | bf[4] | bf[5] | bf[6] | bf[7];
    __syncthreads();
    if (anyb) return true;
  }
  float lsum = lrun + __shfl_xor(lrun, 32, 64);
  *xm_own = lsum;
  __syncthreads();
  const float inv = 1.f / (lsum + *xm_oth);
  __syncthreads();
  u16* op = O0 + ((long)qi * 8 + h) * 256 + 128 * u + 4 * hi;
#pragma unroll
  for (int d = 0; d < 4; ++d)
#pragma unroll
    for (int g = 0; g < 4; ++g) {
      uint2 ov; ov.x = cvtpk(O[d][4 * g] * inv, O[d][4 * g + 1] * inv); ov.y = cvtpk(O[d][4 * g + 2] * inv, O[d][4 * g + 3] * inv);
      *(uint2*)(op + d * 32 + g * 8) = ov;
    }
  return false;
#undef xp_own
#undef xp_oth
#undef xm_own
#undef xm_oth
}

DEVI float attn_maxpass(const u16* __restrict__ Q0, const u16* __restrict__ Kt, int ntiles, bool maskfirst, char* lds, const int tid_in) {
  int tid = tid_in; asm volatile("" : "+v"(tid));
  const int lane = tid & 63, w = tid >> 6, r32 = lane & 31, hi = lane >> 5;
  const int h = 2 * (w >> 1) + (r32 >> 4), qi = r32 & 15;
  const u16* qp = Q0 + ((long)qi * 8 + h) * 320 + hi * 8;
  const int fch = (tid & 7) ^ ((((tid >> 4) & 1) << 2) | ((tid >> 5) & 3));
  const u16* ksrc = Kt + (long)(tid >> 3) * 320 + fch * 8;
  char* lw = lds + w * 1024;
  const int fr = ((r32 & 2) << 1) | ((r32 >> 2) & 3);
  float mrun = -1e30f;
#pragma unroll 1
  for (int t = 0; t < ntiles; ++t) {
#pragma unroll
    for (int i = 0; i < 5; ++i) glds16(ksrc + (long)t * 64 * 320 + i * 64, lw + i * 8192);
    WAIT_VM0(); __syncthreads();
    f32x16 s0, s1;
#pragma unroll
    for (int r = 0; r < 16; ++r) { s0[r] = 0.f; s1[r] = 0.f; }
    const char* ka = lds + r32 * 128;
#pragma unroll 2
    for (int ks = 0; ks < 20; ++ks) {
      const bf16x8 q = *(const bf16x8*)(qp + ks * 16);
      const int off = (ks >> 2) * 8192 + ((2 * (ks & 3) + hi) ^ fr) * 16;
      s0 = mfma(*(const bf16x8*)(ka + off), q, s0);
      s1 = mfma(*(const bf16x8*)(ka + 32 * 128 + off), q, s1);
    }
    if (maskfirst && t == 0) {
#pragma unroll
      for (int r = 0; r < 16; ++r) { if (crow(r, hi) >= 16) s0[r] = -1e30f; s1[r] = -1e30f; }
    }
#pragma unroll
    for (int r = 0; r < 16; ++r) mrun = fmaxf(mrun, fmaxf(s0[r], s1[r]));
    __syncthreads();
  }
  return fmaxf(mrun, __shfl_xor(mrun, 32, 64));
}

static_assert(ATT_LDS <= LDS_BYTES && 2 * 512 * 128 <= LDS_BYTES, "LDS");
DEVI void phase5(const Params& p, char* lds, const int wvs) {
  const int tid = fresh_tid(wvs);
  char* ws = p.ws;
  const u16* QB = (const u16*)(ws + X_QB); u16* OL = (u16*)(ws + X_OL);
  if (tid < 8) *(volatile int*)(lds + XF_OFF + tid * 4) = 0;
  __syncthreads();
  int seq = 0;
  const int ngrp = gridDim.x >> 2;
  const int xcd = blockIdx.x & 7, idx = blockIdx.x >> 3;
  const int grp = xcd + 8 * (idx >> 2), j = idx & 3;
  const int nsamp = blockIdx.x < 128 ? (int)((128 - blockIdx.x + gridDim.x - 1) / gridDim.x) : 0;
  for (int jj = -nsamp;; ++jj) {
    long qrow0; const u16* Kt; int nt; bool mask;
    if (jj < 0) {
      const int sit = (int)blockIdx.x + (jj + nsamp) * (int)gridDim.x;
      const int bd = sit >> 2, js = sit & 3;
      qrow0 = MP + bd * 64 + js * 16; Kt = (const u16*)(ws + W_KS) + (long)bd * LKS * 320; nt = 17; mask = false;
    } else {
      const int k = jj * ngrp + ((jj & 1) ? ngrp - 1 - grp : grp);
      if (k >= 512) break;
      const int c = 255 - (k >> 1), b = k & 1;
      qrow0 = (long)b * SEQ + c * 64 + j * 16; Kt = (const u16*)(ws + W_KP) + (long)b * LKP * 320; nt = c + 2; mask = true;
    }
    bool preset = false; float mref = -1e30f;
    while (true) {
      const bool bad = attn_job(seq, preset, mref, QB + qrow0 * 8 * 320, Kt, nt, mask, OL + qrow0 * 2048, lds, tid);
      if (!bad || preset) break;
      mref = attn_maxpass(QB + qrow0 * 8 * 320, Kt, nt, mask, lds, tid);
      preset = true;
    }
  }
}

DEVI void phase6(const Params& p, char* lds, const int wvs) {
  const int tid = fresh_tid(wvs);
  char* ws = p.ws;
  const int lane = tid & 63, wid = tid >> 6, wr = wid >> 1, wc = wid & 1, r32 = lane & 31, hi = lane >> 5;
  u16* OB = (u16*)(ws + X_OB);
  TILE_LOOP(tile, (M / 256) * 8) {
    const int tm = tile >> 3, h = tile & 7;
    f32x16 acc[2][2]; zero_acc(acc);
    gemm_main_reg<2, 2, 4, 2, 2>(acc, (const u16*)(ws + X_OL) + (long)tm * 256 * 2048 + h * 256, 2048, (const u16*)(ws + W_WUVT) + (long)h * 128 * 256, 256, 256, lds, tid);
    char* stg = stage_base(lds, wid);
#pragma unroll
    for (int m = 0; m < 2; ++m)
#pragma unroll
      for (int n = 0; n < 2; ++n)
#pragma unroll
        for (int r = 0; r < 16; ++r) stage_put(stg, 32 * m + crow(r, hi), 32 * n + r32, acc[m][n][r]);
    stage_flush(stg, OB + (long)(tm * 256 + wr * 64) * 1024 + h * 128 + wc * 64, 1024, lane);
  }
}

DEVI void phase7(const Params& p, char* lds, const int wvs) {
  const int tid = fresh_tid(wvs);
  char* ws = p.ws;
  const int lane = tid & 63, wid = tid >> 6, wr = wid >> 1, wc = wid & 1, r32 = lane & 31, hi = lane >> 5;
  const u16* G = (const u16*)p.out; u16* MG = (u16*)(ws + X_MG);
  TILE_LOOP(tile, (MP / 256) * 8) {
    const int tm = tile >> 3, tn = tile & 7;
    f32x16 acc[2][2], acp[2][2]; zero_acc(acc); zero_acc(acp);
    gemm_main<2, 2, 4, 2, 1>(acc, (const u16*)(ws + X_OL) + (long)tm * 256 * 2048, 2048, (const u16*)(ws + W_WPT) + (long)tn * 128 * 2048, 2048, 2048, lds, tid);
    gemm_main<2, 2, 4, 2, 1>(acp, (const u16*)(ws + W_XN) + (long)tm * 256 * 512, 512, (const u16*)(ws + W_WPBT) + (long)tn * 128 * 512, 512, 512, lds, tid);
    char* stg = stage_base(lds, wid);
#pragma unroll
    for (int m = 0; m < 2; ++m)
#pragma unroll
      for (int n = 0; n < 2; ++n) {
        const int brow = tm * 256 + wr * 64 + m * 32, col = tn * 128 + wc * 64 + n * 32 + r32;
#pragma unroll
        for (int r = 0; r < 16; ++r) {
          const long row = brow + crow(r, hi);
          const float ga = __uint_as_float((unsigned)G[row * 2048 + col] << 16), gp = __uint_as_float((unsigned)G[row * 2048 + 1024 + col] << 16);
          stage_put(stg, 32 * m + crow(r, hi), 32 * n + r32, ga * acc[m][n][r] + gp * acp[m][n][r]);
        }
        SBAR();
      }
    stage_flush(stg, MG + (long)(tm * 256 + wr * 64) * 1024 + tn * 128 + wc * 64, 1024, lane);
  }
}
DEVI void phase7s(const Params& p, char* lds, const int wvs) {
  const int tid = fresh_tid(wvs);
  char* ws = p.ws;
  const int lane = tid & 63, wid = tid >> 6, r32 = lane & 31, hi = lane >> 5, wr4 = wid >> 2, wc4 = wid & 3;
  const u16* G = (const u16*)p.out; u16* MG = (u16*)(ws + X_MG);
  TILE_LOOP(tile, 256) {
    const int tm = tile >> 3, tn = tile & 7;
    f32x16 acc[1][1], acp[1][1]; zero_acc(acc); zero_acc(acp);
    gemm_main_reg<1, 1, 2, 4, 2>(acc, (const u16*)(ws + X_OL) + (long)(MP + tm * 64) * 2048, 2048, (const u16*)(ws + W_WPT) + (long)tn * 128 * 2048, 2048, 2048, lds, tid);
    gemm_main_reg<1, 1, 2, 4, 2>(acp, (const u16*)(ws + W_XN) + (long)(MP + tm * 64) * 512, 512, (const u16*)(ws + W_WPBT) + (long)tn * 128 * 512, 512, 512, lds, tid);
    const int col = tn * 128 + wc4 * 32 + r32;
#pragma unroll
    for (int r = 0; r < 16; ++r) {
      const long row = MP + tm * 64 + wr4 * 32 + crow(r, hi);
      const float ga = __uint_as_float((unsigned)G[row * 2048 + col] << 16), gp = __uint_as_float((unsigned)G[row * 2048 + 1024 + col] << 16);
      MG[row * 1024 + col] = tobf(ga * acc[0][0][r] + gp * acp[0][0][r]);
    }
  }
}

DEVI void phase8(const Params& p, char* lds, const int wvs) {
  const int tid = fresh_tid(wvs);
  char* ws = p.ws;
  {
    const int lane = tid & 63, wid = tid >> 6, wr = wid >> 2, wc = wid & 3, r32 = lane & 31, hi = lane >> 5;
    TILE_LOOP(tile, 256) {
      const int tm = tile >> 3, tn = tile & 7;
      f32x16 acc[1][1]; zero_acc(acc);
      gemm_main_reg<1, 1, 2, 4, 2>(acc, (const u16*)(ws + X_MG) + (long)(MP + tm * 64) * 1024, 1024, (const u16*)(ws + W_WOT) + (long)tn * 128 * 1024, 1024, 1024, lds, tid);
      const int col = tn * 128 + wc * 32 + r32;
#pragma unroll
      for (int r = 0; r < 16; ++r) {
        const long srow = tm * 64 + wr * 32 + crow(r, hi);
        p.out[(MP + srow) * 1024 + col] = p.x_sample[srow * 1024 + col] + acc[0][0][r];
      }
    }
  }
  EpiP8 E; E.Y = p.out; E.xp = p.x_prompt; E.xs = p.x_sample;
  run_pg8(lds, (const u16*)(ws + X_MG), (const u16*)(ws + W_WOT), MP, 1024, 1024, E, tid);
}

DEVI void phase9(const Params& p, const int wvs) {
  const int tid = fresh_tid(wvs);
  const int lane = tid & 63, w = tid >> 6;
  for (int r0 = blockIdx.x * 32 + w; r0 < M; r0 += gridDim.x * 32) {
    const float* s[4]; char* d[4]; bool ok[4], z[4];
#pragma unroll
    for (int k = 0; k < 4; ++k) { const int row = r0 + 8 * k; ok[k] = row < M; z[k] = false; s[k] = p.out + (long)row * 1024; d[k] = (char*)((u16*)(p.ws + W_XN) + (long)row * 1024); }
    rms_rows<4, true>(s, ok, z, p.g_ffn, d, lane);
  }
}
DEVI void phase12(const Params& p, const int wvs) {
  const int tid = fresh_tid(wvs);
  const int lane = tid & 63, w = tid >> 6;
  for (int r0 = blockIdx.x * 32 + w; r0 < M; r0 += gridDim.x * 32) {
    const float* s[4]; char* d[4]; bool ok[4], z[4];
#pragma unroll
    for (int k = 0; k < 4; ++k) { const int row = r0 + 8 * k; ok[k] = row < M; z[k] = false; s[k] = p.out + (long)row * 1024; d[k] = (char*)(p.out + (long)row * 1024); }
    rms_rows<4, false>(s, ok, z, p.g_final, d, lane);
  }
}

DEVI void phase10(const Params& p, char* lds, const int wvs) {
  const int tid = fresh_tid(wvs);
  char* ws = p.ws;
  EpiP10 E; E.U = (u16*)(ws + X_U);
  run_pg8(lds, (const u16*)(ws + W_XN), (const u16*)(ws + W_WUPT), M, 4096, 1024, E, tid);
}

DEVI void phase11(const Params& p, char* lds, const int wvs) {
  const int tid = fresh_tid(wvs);
  char* ws = p.ws;
  {
    const int lane = tid & 63, wid = tid >> 6, wr = wid >> 2, wc = wid & 3, r32 = lane & 31, hi = lane >> 5;
    TILE_LOOP(tile, 256) {
      const int tm = tile >> 3, tn = tile & 7;
      f32x16 acc[1][1]; zero_acc(acc);
      gemm_main_reg<1, 1, 2, 4, 2>(acc, (const u16*)(ws + X_U) + (long)(MP + tm * 64) * 4096, 4096, (const u16*)(ws + W_WDT) + (long)tn * 128 * 4096, 4096, 4096, lds, tid);
      const int col = tn * 128 + wc * 32 + r32;
#pragma unroll
      for (int r = 0; r < 16; ++r) { float* y = p.out + (long)(MP + tm * 64 + wr * 32 + crow(r, hi)) * 1024 + col; *y = *y + acc[0][0][r]; }
    }
  }
  EpiP11 E; E.Y = p.out;
  run_pg8(lds, (const u16*)(ws + X_U), (const u16*)(ws + W_WDT), MP, 1024, 4096, E, tid);
}

__global__ void __launch_bounds__(512) fwd_megakernel(Params p) {
  extern __shared__ __attribute__((aligned(16))) char lds[];
  const int wvs = __builtin_amdgcn_readfirstlane(threadIdx.x >> 6);
  phase0(p, lds, wvs);  cg::this_grid().sync();
  phase1(p, lds, wvs);  grid_barrier(p.ws, 1, wvs);
  phase2w(p, lds, wvs); phase2(p, lds, wvs);  grid_barrier(p.ws, 2, wvs);
  phase3(p, lds, wvs);  phase3q(p, lds, wvs);  grid_barrier(p.ws, 3, wvs);
  phase5(p, lds, wvs);  grid_barrier(p.ws, 4, wvs);
  phase7(p, lds, wvs);  phase7s(p, lds, wvs);  grid_barrier(p.ws, 5, wvs);
  phase8(p, lds, wvs);  grid_barrier(p.ws, 6, wvs);
  phase9(p, wvs);       grid_barrier(p.ws, 7, wvs);
  phase10(p, lds, wvs); grid_barrier(p.ws, 8, wvs);
  phase11(p, lds, wvs); grid_barrier(p.ws, 9, wvs);
  phase12(p, wvs);
}

extern "C" void kernel_launch(void* const* d_in, const int* in_sizes, int n_in, void* d_out, int out_size, void* d_ws, size_t ws_size, hipStream_t stream) {
  static int grid_blocks = 0;
  if (!grid_blocks) {
    if (ws_size < WS_LIMIT + 4096) { fprintf(stderr, "kernel_launch: ws too small: %zu\n", ws_size); return; }
    if (hipFuncSetAttribute((const void*)fwd_megakernel, hipFuncAttributeMaxDynamicSharedMemorySize, LDS_BYTES) != hipSuccess) {
      fprintf(stderr, "kernel_launch: hipFuncSetAttribute failed\n"); return; }
    int dev = 0, cus = 0, per_cu = 0;
    hipGetDevice(&dev);
    hipDeviceGetAttribute(&cus, hipDeviceAttributeMultiprocessorCount, dev);
    hipOccupancyMaxActiveBlocksPerMultiprocessor(&per_cu, fwd_megakernel, 512, LDS_BYTES);
    if (per_cu < 1) { fprintf(stderr, "kernel_launch: occupancy 0\n"); return; }
    grid_blocks = cus - cus % 32;
    if (grid_blocks < 32) { fprintf(stderr, "kernel_launch: too few CUs\n"); grid_blocks = 0; return; }
  }
  Params p{};
  const float** f = (const float**)&p;
  for (int i = 0; i < 22; ++i) f[i] = (const float*)d_in[i];
  p.out = (float*)d_out; p.ws = (char*)d_ws;
  (void)hipMemsetAsync((char*)d_ws + WS_BAR, 0, 256, stream);
  void* args[] = {&p};
  hipError_t e = hipLaunchCooperativeKernel((void*)fwd_megakernel, dim3(grid_blocks), dim3(512), args, LDS_BYTES, stream);
  if (e != hipSuccess) fprintf(stderr, "cooperative launch failed: %s (grid %d)\n", hipGetErrorString(e), grid_blocks);
}
```

```cpp
#include <hip/hip_runtime.h>
#include <hip/hip_cooperative_groups.h>
#include <cstdio>
#include <cstdint>
namespace cg = cooperative_groups;

#define DEVI __device__ __forceinline__
typedef unsigned short u16;
using bf16x8 = __attribute__((ext_vector_type(8))) short;
using f32x16 = __attribute__((ext_vector_type(16))) float;
using u32x4 = __attribute__((ext_vector_type(4))) unsigned;

constexpr int DM = 1024, SEQ = 16384, PAST = 1024, QL = 384, KVL = 256, ROPE = 64, DPOOL = 512, DFF = 4096;
constexpr int DIN = 3264, DIN_PAD = 3328;
constexpr int MP = 2 * SEQ;
constexpr int MS = 32 * 64;
constexpr int M = MP + MS;
constexpr int RALL = M + 256;
constexpr int LKP = 64 + SEQ;
constexpr int LKS = PAST + 64;
constexpr float EPS = 1e-6f;
constexpr float QS = 0.07216878364870322f * 1.4426950408889634f;
constexpr int ZW = 704;

constexpr size_t al256(size_t x) { return (x + 255) / 256 * 256; }
constexpr size_t W_WINT = 0;
constexpr size_t W_WQT  = W_WINT + (size_t)DIN_PAD * 1024 * 2;
constexpr size_t W_WUK  = W_WQT + (size_t)1536 * 384 * 2;
constexpr size_t W_WUVT = W_WUK + (size_t)256 * 1024 * 2;
constexpr size_t W_WABT = W_WUVT + (size_t)1024 * 256 * 2;
constexpr size_t W_WGT  = W_WABT + (size_t)1024 * 1024 * 2;
constexpr size_t W_WPBT = W_WGT + (size_t)4 * 128 * 128 * 2;
constexpr size_t W_WOT  = W_WPBT + (size_t)1024 * 512 * 2;
constexpr size_t W_WUPT = W_WOT + (size_t)1024 * 1024 * 2;
constexpr size_t W_WDT  = W_WUPT + (size_t)4096 * 1024 * 2;
constexpr size_t W_TAB  = W_WDT + (size_t)1024 * 4096 * 2;
constexpr size_t W_XN   = al256(W_TAB + (size_t)16400 * 32 * 8);
constexpr size_t W_KP   = al256(W_XN + (size_t)RALL * 1024 * 2);
constexpr size_t W_VTP  = W_KP + (size_t)2 * LKP * 320 * 2;
constexpr size_t W_COMBT = W_VTP;
constexpr size_t W_WQN  = W_VTP + (size_t)4 * 1024 * 1024;
constexpr size_t W_WUVN = W_VTP + (size_t)6 * 1024 * 1024;
constexpr size_t W_WPT  = W_VTP + (size_t)8 * 1024 * 1024;
constexpr size_t W_KS   = W_VTP + (size_t)2 * 256 * LKP * 2;
constexpr size_t W_VTS  = W_KS + (size_t)32 * LKS * 320 * 2;
constexpr size_t W_X    = al256(W_VTS + (size_t)32 * 256 * LKS * 2);
constexpr size_t X_Z    = W_X;
constexpr size_t X_UP   = X_Z + (size_t)RALL * ZW * 4;
constexpr size_t X_QB   = W_X;
constexpr size_t X_QN_  = W_X + (size_t)190 * 1024 * 1024;
constexpr size_t X_PIN  = X_QN_ + (size_t)M * 384 * 2;
constexpr size_t X_QNOPE= X_PIN + (size_t)M * 512 * 2;
constexpr size_t X_OL   = W_X + (size_t)M * 8 * 320 * 2;
constexpr size_t X_OB   = W_X;
constexpr size_t X_MG   = W_X;
constexpr size_t X_U    = W_X;
constexpr size_t WS_END1 = X_OL + (size_t)M * 2048 * 2;
constexpr size_t WS_END2 = X_QNOPE + (size_t)M * 1024 * 2;
constexpr size_t WS_END3 = X_U + (size_t)M * 4096 * 2;
constexpr size_t WS_LIMIT = (size_t)512 * 1024 * 1024 - 4096;
constexpr size_t WS_BAR = WS_LIMIT;
static_assert(X_UP + (size_t)RALL * 512 * 4 <= X_QN_, "Z/Upool overlap qn");
static_assert(X_QB + (size_t)M * 8 * 320 * 2 <= X_QN_, "Qb overlaps qn");
static_assert(WS_END1 <= WS_LIMIT && WS_END2 <= WS_LIMIT && WS_END3 <= WS_LIMIT, "ws too small");

constexpr size_t O_Y = 0;
constexpr size_t O_KVP = (size_t)M * 1024;
constexpr size_t O_PEP = O_KVP + (size_t)2 * 16400 * 256;
constexpr size_t O_POOLP = O_PEP + (size_t)2 * 16400 * 64;
constexpr size_t O_KVS = O_POOLP + (size_t)2 * 15 * 512;
constexpr size_t O_PES = O_KVS + (size_t)32 * 64 * 256;
constexpr size_t O_POOLS = O_PES + (size_t)32 * 64 * 64;

constexpr int ABUF = 64 * 640 + 256 * 128;
constexpr int LDS_BYTES = 141568;

struct Params {
  const float *x_prompt, *x_sample, *cache_kv, *cache_rope, *cache_pool, *meta, *w_in, *g_mix, *g_q, *g_kv, *w_q_up, *w_uk, *w_uv,
      *w_attn_br, *w_pool_grp, *pool_scale, *w_pool_br, *w_out, *g_ffn, *w_up, *w_down, *g_final;
  float* out; char* ws;
};

DEVI unsigned cvtpk(float lo, float hi) { unsigned r; asm("v_cvt_pk_bf16_f32 %0, %1, %2" : "=v"(r) : "v"(lo), "v"(hi)); return r; }
DEVI u16 tobf(float x) { return (u16)(cvtpk(x, 0.f) & 0xffffu); }
DEVI uint2 pack4(float a, float b, float c, float d) { uint2 o; o.x = cvtpk(a, b); o.y = cvtpk(c, d); return o; }
DEVI int crow(int r, int hi) { return (r & 3) + 8 * (r >> 2) + 4 * hi; }
DEVI float wave_sum(float v) {
#pragma unroll
  for (int o = 32; o; o >>= 1) v += __shfl_xor(v, o, 64);
  return v;
}
DEVI f32x16 mfma(bf16x8 a, bf16x8 b, f32x16 c) { return __builtin_amdgcn_mfma_f32_32x32x16_bf16(a, b, c, 0, 0, 0); }
DEVI int fresh_tid(int ws) { int l; asm volatile("v_mbcnt_lo_u32_b32 %0, -1, 0\n\tv_mbcnt_hi_u32_b32 %0, -1, %0" : "=v"(l)); return ws * 64 + l; }
DEVI void grid_barrier(char* wsbase, unsigned k, int wvs) {
  unsigned* ctr = (unsigned*)(wsbase + ((size_t)512 * 1024 * 1024 - 4096));
  const unsigned target = k * gridDim.x;
  __threadfence();
  __syncthreads();
  if (fresh_tid(wvs) == 0) {
    __hip_atomic_fetch_add(ctr, 1u, __ATOMIC_RELAXED, __HIP_MEMORY_SCOPE_AGENT);
    while (__hip_atomic_load(ctr, __ATOMIC_RELAXED, __HIP_MEMORY_SCOPE_AGENT) < target) __builtin_amdgcn_s_sleep(2);
  }
  __syncthreads();
  __threadfence();
}


DEVI bf16x8 lds_rd128(int a, const int off) { bf16x8 r; asm volatile("ds_read_b128 %0, %1 offset:%2" : "=&v"(r) : "v"(a), "i"(off) : "memory"); return r; }
DEVI void glds16(const void* g, void* l) { __builtin_amdgcn_global_load_lds((const unsigned*)g, (unsigned*)l, 16, 0, 0); }
#define WAIT_VM0() asm volatile("s_waitcnt vmcnt(0)" ::: "memory")

template <int TM, int TN, int WR, int WC, int DEP = (TM + TN > 4 ? 1 : 2)>
DEVI void gemm_main_dma(f32x16 (&acc)[TM][TN], const u16* __restrict__ A, long lda, const u16* __restrict__ Bt, long ldb, int K, char* lds, const int tid,
                    const bool pre = false, const u16* __restrict__ nA = nullptr, const u16* __restrict__ nBt = nullptr) {
  static_assert(WR * WC == 8, "8 waves");
  constexpr int BM = 32 * TM * WR, BN = 32 * TN * WC, NA = BM / 64, NB = BN / 64, BUF = (BM + BN) * 128;
  const int lane = tid & 63, wid = tid >> 6, wr = wid / WC, wc = wid % WC, r32 = lane & 31, hi = lane >> 5;
  const int lrow = tid >> 3, lch = (tid & 7) ^ ((((tid >> 4) & 1) << 2) | ((tid >> 5) & 3));
  const u16* ag = A + (long)lrow * lda + lch * 8;
  const u16* bg = Bt + (long)lrow * ldb + lch * 8;
  char* lw = lds + wid * 1024;
#define G_ISSUE(kt_, buf_) do { \
    _Pragma("unroll") for (int i_ = 0; i_ < NA; ++i_) glds16(ag + (long)(64 * i_) * lda + (kt_) * 64, lw + (buf_) * BUF + i_ * 8192); \
    _Pragma("unroll") for (int i_ = 0; i_ < NB; ++i_) glds16(bg + (long)(64 * i_) * ldb + (kt_) * 64, lw + (buf_) * BUF + (NA + i_) * 8192); } while (0)
  const int fr = ((r32 & 2) << 1) | ((r32 >> 2) & 3);
  int o[4];
#pragma unroll
  for (int j = 0; j < 4; ++j) o[j] = ((2 * j + hi) ^ fr) * 16;
  const int KT = K / 64;
  if (!pre) G_ISSUE(0, 0);
  WAIT_VM0(); __syncthreads();
#pragma unroll 1
  for (int kt = 0; kt < KT; ++kt) {
    if (kt + 1 < KT) G_ISSUE(kt + 1, (kt + 1) & 1);
    const int abase = (int)(uintptr_t)lds + (kt & 1) * BUF + (wr * 32 * TM + r32) * 128;
    const int bbase = (int)(uintptr_t)lds + (kt & 1) * BUF + (BM + wc * 32 * TN + r32) * 128;
    bf16x8 fs[DEP + 1][TM + TN];
#define F_LOAD(set_, ks_) do { const int aa_ = abase + o[ks_], bb_ = bbase + o[ks_]; \
      _Pragma("unroll") for (int m_ = 0; m_ < TM; ++m_) fs[set_][m_] = lds_rd128(aa_, m_ * 4096); \
      _Pragma("unroll") for (int n_ = 0; n_ < TN; ++n_) fs[set_][TM + n_] = lds_rd128(bb_, n_ * 4096); } while (0)
#pragma unroll
    for (int pks = 0; pks < DEP; ++pks) F_LOAD(pks, pks);
#pragma unroll
    for (int ks = 0; ks < 4; ++ks) {
      if (ks + DEP < 4) F_LOAD((ks + DEP) % (DEP + 1), ks + DEP);
      constexpr int NF = TM + TN;
      const int ahead = (4 - 1 - ks) < DEP ? (4 - 1 - ks) : DEP;
      if (ahead == 2) asm volatile("s_waitcnt lgkmcnt(%0)" :: "n"(2 * NF) : "memory");
      else if (ahead == 1) asm volatile("s_waitcnt lgkmcnt(%0)" :: "n"(NF) : "memory");
      else asm volatile("s_waitcnt lgkmcnt(0)" ::: "memory");
      __builtin_amdgcn_sched_barrier(0);
#pragma unroll
      for (int m = 0; m < TM; ++m)
#pragma unroll
        for (int n = 0; n < TN; ++n) acc[m][n] = mfma(fs[ks % (DEP + 1)][m], fs[ks % (DEP + 1)][TM + n], acc[m][n]);
      __builtin_amdgcn_sched_barrier(0);
    }
#undef F_LOAD
    WAIT_VM0(); __syncthreads();
  }
  if (nA != nullptr) {
    const u16* ag2 = nA + (long)lrow * lda + lch * 8;
    const u16* bg2 = nBt + (long)lrow * ldb + lch * 8;
#pragma unroll
    for (int i = 0; i < NA; ++i) glds16(ag2 + (long)(64 * i) * lda, lw + i * 8192);
#pragma unroll
    for (int i = 0; i < NB; ++i) glds16(bg2 + (long)(64 * i) * ldb, lw + (NA + i) * 8192);
  }
#undef G_ISSUE
}
template <int TM, int TN, int WR, int WC, int DEP = (TM + TN > 4 ? 1 : 2)>
DEVI void gemm_main_reg(f32x16 (&acc)[TM][TN], const u16* __restrict__ A, long lda, const u16* __restrict__ Bt, long ldb, int K, char* lds, const int tid,
                    const bool pre = false, const u16* __restrict__ nA = nullptr, const u16* __restrict__ nBt = nullptr) {
  static_assert(WR * WC == 8, "8 waves");
  constexpr int BM = 32 * TM * WR, BN = 32 * TN * WC, NA = BM / 64, NB = BN / 64, BUF = (BM + BN) * 128;
  const int lane = tid & 63, wid = tid >> 6, wr = wid / WC, wc = wid % WC, r32 = lane & 31, hi = lane >> 5;
  const int lrow = tid >> 3, lpos = (tid & 7) ^ ((((tid >> 4) & 1) << 2) | ((tid >> 5) & 3));
  const u16* ag = A + (long)lrow * lda + (tid & 7) * 8;
  const u16* bg = Bt + (long)lrow * ldb + (tid & 7) * 8;
  char* lwr = lds + lrow * 128 + lpos * 16;
  u32x4 r0[NA + NB], r1[NA + NB];
#define G_LOAD(R_, kt_) do { \
    _Pragma("unroll") for (int i_ = 0; i_ < NA; ++i_) R_[i_] = *(const u32x4*)(ag + (long)(64 * i_) * lda + (kt_) * 64); \
    _Pragma("unroll") for (int i_ = 0; i_ < NB; ++i_) R_[NA + i_] = *(const u32x4*)(bg + (long)(64 * i_) * ldb + (kt_) * 64); } while (0)
#define S_WRITE(R_, buf_) do { _Pragma("unroll") for (int i_ = 0; i_ < NA + NB; ++i_) *(u32x4*)(lwr + (buf_) * BUF + i_ * 8192) = R_[i_]; } while (0)
  const int fr = ((r32 & 2) << 1) | ((r32 >> 2) & 3);
  int o[4];
#pragma unroll
  for (int j = 0; j < 4; ++j) o[j] = ((2 * j + hi) ^ fr) * 16;
  const int KT = K / 64;
  (void)pre; (void)nA; (void)nBt;
#define K_TILE(buf_) do { \
    const int abase = (int)(uintptr_t)lds + (buf_) * BUF + (wr * 32 * TM + r32) * 128; \
    const int bbase = (int)(uintptr_t)lds + (buf_) * BUF + (BM + wc * 32 * TN + r32) * 128; \
    bf16x8 fs[DEP + 1][TM + TN]; \
    _Pragma("unroll") for (int pks = 0; pks < DEP; ++pks) { const int aa_ = abase + o[pks], bb_ = bbase + o[pks]; \
      _Pragma("unroll") for (int m_ = 0; m_ < TM; ++m_) fs[pks][m_] = lds_rd128(aa_, m_ * 4096); \
      _Pragma("unroll") for (int n_ = 0; n_ < TN; ++n_) fs[pks][TM + n_] = lds_rd128(bb_, n_ * 4096); } \
    _Pragma("unroll") for (int ks = 0; ks < 4; ++ks) { \
      if (ks + DEP < 4) { const int aa_ = abase + o[(ks + DEP) & 3], bb_ = bbase + o[(ks + DEP) & 3]; \
        _Pragma("unroll") for (int m_ = 0; m_ < TM; ++m_) fs[(ks + DEP) % (DEP + 1)][m_] = lds_rd128(aa_, m_ * 4096); \
        _Pragma("unroll") for (int n_ = 0; n_ < TN; ++n_) fs[(ks + DEP) % (DEP + 1)][TM + n_] = lds_rd128(bb_, n_ * 4096); } \
      const int ahead = (4 - 1 - ks) < DEP ? (4 - 1 - ks) : DEP; \
      if (ahead == 2) asm volatile("s_waitcnt lgkmcnt(%0)" :: "n"(2 * (TM + TN)) : "memory"); \
      else if (ahead == 1) asm volatile("s_waitcnt lgkmcnt(%0)" :: "n"(TM + TN) : "memory"); \
      else asm volatile("s_waitcnt lgkmcnt(0)" ::: "memory"); \
      __builtin_amdgcn_sched_barrier(0); \
      _Pragma("unroll") for (int m = 0; m < TM; ++m) \
        _Pragma("unroll") for (int n = 0; n < TN; ++n) acc[m][n] = mfma(fs[ks % (DEP + 1)][m], fs[ks % (DEP + 1)][TM + n], acc[m][n]); \
      __builtin_amdgcn_sched_barrier(0); \
    } } while (0)
  G_LOAD(r0, 0); S_WRITE(r0, 0); G_LOAD(r1, 1);
  __syncthreads();
#pragma unroll 1
  for (int kt = 0; kt < KT; kt += 2) {
    if (kt + 2 < KT) G_LOAD(r0, kt + 2);
    K_TILE(0);
    S_WRITE(r1, 1);
    __syncthreads();
    if (kt + 3 < KT) G_LOAD(r1, kt + 3);
    K_TILE(1);
    if (kt + 2 < KT) S_WRITE(r0, 0);
    __syncthreads();
  }
#undef K_TILE
#undef G_LOAD
#undef S_WRITE
}
template <int TM, int TN, int WR, int WC, int DEP = (TM + TN > 4 ? 1 : 2)>
DEVI void gemm_main(f32x16 (&acc)[TM][TN], const u16* __restrict__ A, long lda, const u16* __restrict__ Bt, long ldb, int K, char* lds, const int tid,
                    const bool pre = false, const u16* __restrict__ nA = nullptr, const u16* __restrict__ nBt = nullptr) {
  gemm_main_dma<TM, TN, WR, WC, DEP>(acc, A, lda, Bt, ldb, K, lds, tid, pre, nA, nBt);
}
#define TILE_LOOP(tile, NT) \
  for (int it_ = 0, tile = 0; it_ * 8 * (int)(gridDim.x >> 3) < (NT); ++it_) \
    if ((tile = (it_ * 8 + (int)(blockIdx.x & 7)) * (int)(gridDim.x >> 3) + (int)(blockIdx.x >> 3)) < (NT))
template <int TM, int TN> DEVI void zero_acc(f32x16 (&acc)[TM][TN]) {
#pragma unroll
  for (int m = 0; m < TM; ++m)
#pragma unroll
    for (int n = 0; n < TN; ++n)
#pragma unroll
      for (int r = 0; r < 16; ++r) acc[m][n][r] = 0.f;
}

template <int R, bool BF>
DEVI void rms_rows(const float* const (&src)[R], const bool (&ok)[R], const bool (&zero)[R], const float* __restrict__ g, char* const (&dst)[R], const int lane) {
  float4 v[R][4];
#pragma unroll
  for (int k = 0; k < R; ++k)
#pragma unroll
    for (int i = 0; i < 4; ++i) v[k][i] = (ok[k] && !zero[k]) ? *(const float4*)(src[k] + 4 * lane + 256 * i) : make_float4(0, 0, 0, 0);
  float ss[R];
#pragma unroll
  for (int k = 0; k < R; ++k) {
    ss[k] = 0;
#pragma unroll
    for (int i = 0; i < 4; ++i) ss[k] += v[k][i].x * v[k][i].x + v[k][i].y * v[k][i].y + v[k][i].z * v[k][i].z + v[k][i].w * v[k][i].w;
  }
#pragma unroll
  for (int o = 32; o; o >>= 1)
#pragma unroll
    for (int k = 0; k < R; ++k) ss[k] += __shfl_xor(ss[k], o, 64);
#pragma unroll
  for (int i = 0; i < 4; ++i) {
    const float4 gg = *(const float4*)(g + 4 * lane + 256 * i);
#pragma unroll
    for (int k = 0; k < R; ++k) {
      if (!ok[k]) continue;
      const float rs = rsqrtf(ss[k] * (1.f / 1024.f) + EPS);
      const float4 y = make_float4(v[k][i].x * rs * gg.x, v[k][i].y * rs * gg.y, v[k][i].z * rs * gg.z, v[k][i].w * rs * gg.w);
      if (BF) *(uint2*)((u16*)dst[k] + 4 * lane + 256 * i) = pack4(y.x, y.y, y.z, y.w);
      else *(float4*)((float*)dst[k] + 4 * lane + 256 * i) = y;
    }
  }
}

DEVI void phase0(const Params& p, char* lds, const int wvs) {
  const int tid512 = fresh_tid(wvs);
  char* ws = p.ws;
  const int half = tid512 >> 8, tid = tid512 & 255, lane = tid & 63, w = tid >> 6;
  float* T = (float*)lds + half * (64 * 65);
  constexpr int U_T = 3728, U_C = U_T + 512, U_X = U_C + 548, U_R = U_X + 513, U_K = U_R + 256, U_P = U_K + 32;
  for (int it = blockIdx.x; 2 * it < U_P; it += gridDim.x) {
    const int u = 2 * it + half;
    const float* src = nullptr; u16* dst = nullptr; int N = 0, Kd = 0, k0 = 0, n0 = 0; bool isq = false;
    const bool tr = u < U_T;
    if (tr) {
      int t = u;
      if (t < 816) { src = p.w_in; dst = (u16*)(ws + W_WINT); Kd = 1024; N = DIN; }
      else if (t < 960) { t -= 816; src = p.w_q_up; dst = (u16*)(ws + W_WQT); Kd = 384; N = 1536; isq = true; }
      else if (t < 1024) { t -= 960; src = p.w_uv; dst = (u16*)(ws + W_WUVT); Kd = 256; N = 1024; }
      else if (t < 1280) { t -= 1024; src = p.w_attn_br; dst = (u16*)(ws + W_WABT); Kd = 1024; N = 1024; }
      else if (t < 1296) { t -= 1280; const int g = t >> 2; t &= 3; src = p.w_pool_grp + g * 16384; dst = (u16*)(ws + W_WGT) + g * 16384; Kd = 128; N = 128; }
      else if (t < 1424) { t -= 1296; src = p.w_pool_br; dst = (u16*)(ws + W_WPBT); Kd = 512; N = 1024; }
      else if (t < 1680) { t -= 1424; src = p.w_out; dst = (u16*)(ws + W_WOT); Kd = 1024; N = 1024; }
      else if (t < 2704) { t -= 1680; src = p.w_up; dst = (u16*)(ws + W_WUPT); Kd = 1024; N = 4096; }
      else { t -= 2704; src = p.w_down; dst = (u16*)(ws + W_WDT); Kd = 4096; N = 1024; }
      const int nt = N / 64; const int tk = t / nt, tn = t - tk * nt;
      k0 = tk * 64; n0 = tn * 64;
#pragma unroll
      for (int i = 0; i < 16; ++i) { const int k = w + 4 * i; const float v = src[(long)(k0 + k) * N + n0 + lane]; T[k * 65 + lane] = v;
        if (isq) ((u16*)(ws + W_WQN))[(long)(k0 + k) * 1536 + n0 + lane] = tobf(v); }
    }
    __syncthreads();
    if (tr) {
      const int n = tid >> 2, kc = (tid & 3) * 16;
      unsigned pk[8];
#pragma unroll
      for (int j = 0; j < 8; ++j) pk[j] = cvtpk(T[(kc + 2 * j) * 65 + n], T[(kc + 2 * j + 1) * 65 + n]);
      uint4* d = (uint4*)(dst + (long)(n0 + n) * Kd + k0 + kc);
      d[0] = make_uint4(pk[0], pk[1], pk[2], pk[3]); d[1] = make_uint4(pk[4], pk[5], pk[6], pk[7]);
      if (isq && n0 % 192 == 128) {
        uint4* d2 = (uint4*)((u16*)(ws + W_COMBT) + (long)((n0 / 192) * 320 + 256 + (n < 32 ? 2 * n : 2 * (n - 32) + 1)) * 384 + k0 + kc);
        d2[0] = make_uint4(pk[0], pk[1], pk[2], pk[3]); d2[1] = make_uint4(pk[4], pk[5], pk[6], pk[7]);
      }
    } else if (u < U_C) {
      const int c = u - U_T, bd = c >> 4, ct = c & 15;
      u16* Kd2 = (u16*)(ws + W_KS) + ((long)bd * LKS + ct * 64) * 320;
#pragma unroll 4
      for (int i = 0; i < 16; ++i) {
        const int r = w * 16 + i;
        const float4 v = *(const float4*)(p.cache_kv + ((long)(bd * PAST + ct * 64 + r)) * 256 + 4 * lane);
        uint2 o; o.x = cvtpk(v.x, v.y); o.y = cvtpk(v.z, v.w);
        *(uint2*)(Kd2 + r * 320 + 4 * lane) = o;
        const float kr = p.cache_rope[((long)(bd * PAST + ct * 64 + r)) * 64 + lane];
        Kd2[r * 320 + 256 + (lane < 32 ? 2 * lane : 2 * (lane - 32) + 1)] = tobf(kr);
      }
    } else if (u < U_X) {
      const int ru = u - U_C;
      for (int i = 0; i < 16; i += 4) {
        const float* s[4]; char* d[4]; bool ok[4], z[4];
#pragma unroll
        for (int k = 0; k < 4; ++k) {
          const int R = ru * 64 + w * 16 + i + k;
          s[k] = R < MP ? p.x_prompt + (long)R * 1024 : (R < M ? p.x_sample + (long)(R - MP) * 1024 : p.meta + (long)(R - M) * 1024);
          ok[k] = true; z[k] = R >= M + 16; d[k] = (char*)((u16*)(ws + W_XN) + (long)R * 1024);
        }
        rms_rows<4, true>(s, ok, z, p.g_mix, d, lane);
      }
    } else if (u < U_R) {
      const int base = (u - U_X) * 1024;
      for (int i = 0; i < 4; ++i) {
        const int e = base + i * 256 + tid;
        if (e < 16400 * 32) {
          const int pos = e >> 5, j = e & 31;
          const float inv = exp2f(-(float)j * 0.41524101186092029f);
          const double rev = (double)pos * (double)inv * 0.15915494309189535;
          const float fr = (float)(rev - floor(rev));
          float2 cs; cs.x = __builtin_amdgcn_cosf(fr); cs.y = __builtin_amdgcn_sinf(fr);
          ((float2*)(ws + W_TAB))[e] = cs;
        }
      }
    } else if (u < U_K) {
      const int e = ((u - U_R) * 256 + tid) * 4;
      const float4 v = *(const float4*)(p.w_uk + e);
      uint2 o; o.x = cvtpk(v.x, v.y); o.y = cvtpk(v.z, v.w);
      *(uint2*)((u16*)(ws + W_WUK) + e) = o;
      const float4 v2 = *(const float4*)(p.w_uv + e);
      uint2 o2; o2.x = cvtpk(v2.x, v2.y); o2.y = cvtpk(v2.z, v2.w);
      *(uint2*)((u16*)(ws + W_WUVN) + e) = o2;
    } else if (u < U_P) {
      const int e = (u - U_K) * 256 + tid;
      ((uint4*)((u16*)(ws + W_WINT) + (long)DIN * 1024))[e] = make_uint4(0, 0, 0, 0);
    }
    __syncthreads();
  }
}

DEVI char* stage_base(char* lds, int wid) { return lds + 65536 + wid * 8192; }
DEVI void stage_put(char* stg, int row, int col, float v) { *(u16*)(stg + row * 128 + col * 2) = tobf(v); }
DEVI void stage_flush(const char* stg, u16* __restrict__ out, long ld, int lane) {
#pragma unroll
  for (int j = 0; j < 8; ++j) {
    const int q = lane + 64 * j, row = q >> 3, c = q & 7;
    const uint4 v = *(const uint4*)(stg + row * 128 + c * 16);
    *(uint4*)(out + (long)row * ld + c * 8) = v;
  }
}


namespace pg8 {
#define PG8_LAS __attribute__((address_space(3)))
typedef unsigned short bf16_t;
typedef float f32x4 __attribute__((ext_vector_type(4)));
constexpr int BM = 256, BK = 64, HALF = 128, HTB = HALF * BK * 2, STAGE_BYTES = 8 * HTB, NXCD = 8, WGM = 8;
__device__ __forceinline__ int lds_byte(int r, int c) { const int st = (r >> 4) * 2 + (c >> 5), rr = r & 15, cc = c & 31, ob = rr * 64 + cc * 2; return st * 1024 + (ob ^ (((ob >> 9) & 1) << 5)); }
__device__ __forceinline__ void stage_rc(int b, int& R, int& C) { const int st = b / 1024, sb = b % 1024, swz = sb ^ (((sb >> 9) & 1) << 5); R = (st >> 1) * 16 + swz / 64; C = (st & 1) * 32 + (swz % 64) / 2; }
__device__ __forceinline__ int perm32(int rho) { const int n = rho >> 4, i = rho & 15; return 8 * (i >> 2) + 4 * n + (i & 3); }
struct Unit { int pm, pn; };
struct Gemm { const bf16_t* A; const bf16_t* Bt; int M, N, K; };
struct StaticOrder {
    int nM, nN, nwg, G, c;
    __device__ void init(int M, int N, int G_, int c_) { nM = M / BM; nN = N / BM; nwg = nM * nN; G = G_; c = c_; }
    __device__ bool next(int i, Unit& u) const {
        const long L = (long)i * G + c; if (L >= nwg) return false;
        int wgid = (int)L; { const int q = nwg / NXCD, r = nwg % NXCD, xcd = wgid % NXCD, off = wgid / NXCD; wgid = (xcd < r ? xcd * (q + 1) : r * (q + 1) + (xcd - r) * q) + off; }
        const int nig = WGM * nN, gid = wgid / nig, fm = gid * WGM, gsz = (nM - fm) < WGM ? (nM - fm) : WGM;
        u.pm = fm + ((wgid % nig) % gsz); u.pn = (wgid % nig) / gsz; return true;
    }
    __device__ __forceinline__ void a_ready(const Unit&) const {}
    __device__ __forceinline__ void done(const Unit&) const {}
};
template <class Epi, class Sched>
__device__ __forceinline__ void gemm_phase(PG8_LAS unsigned char* lds, const Gemm g, const Sched& S, const Epi& E, const int tid) {
    const int wid = __builtin_amdgcn_readfirstlane(tid >> 6), lane = tid & 63, wr = wid >> 2, wc = wid & 3, fr = lane & 15, fq = lane >> 4;
    const int K = g.K, nt = K / BK;
    unsigned voffA[2], voffB[2];
#pragma unroll
    for (int i = 0; i < 2; ++i) { int R, C; stage_rc(tid * 16 + i * 8192, R, C); const int Rb = Epi::PERM ? ((R & ~31) + perm32(R & 31)) : R;
        voffA[i] = (unsigned)(R * K + C) * 2u; voffB[i] = (unsigned)(Rb * K + C) * 2u; }
    const size_t kstep = (size_t)(BK * 2);
    const size_t hstep = (size_t)HALF * K * 2;
    const size_t tstep = 2 * hstep;
    const unsigned ldsw = (unsigned)wid * 1024u;
    const int aoff = lds_byte(wr * 64 + fr, fq * 8), boff = lds_byte(wc * 32 + fr, fq * 8);
#define PG8_SA(b, h) (((b) * 2 + (h)) * HTB)
#define PG8_SB(b, h) ((4 + (b) * 2 + (h)) * HTB)
#define PG8_STAGE(bufoff, gbase, voff) do { _Pragma("unroll") for (int _i = 0; _i < 2; ++_i) \
        __builtin_amdgcn_global_load_lds((const unsigned*)((const char*)(gbase) + (voff)[_i]), (PG8_LAS unsigned*)(lds + (bufoff) + ldsw + _i * 8192), 16, 0, 0); } while (0)
#define PG8_LDA(dst, b, h) do { _Pragma("unroll") for (int m = 0; m < 4; ++m) _Pragma("unroll") for (int k = 0; k < 2; ++k) dst[m][k] = *(const PG8_LAS bf16x8*)(lds + PG8_SA(b, h) + aoff + m * 2048 + k * 1024); } while (0)
#define PG8_LDB(dst, b, h) do { _Pragma("unroll") for (int n = 0; n < 2; ++n) _Pragma("unroll") for (int k = 0; k < 2; ++k) dst[n][k] = *(const PG8_LAS bf16x8*)(lds + PG8_SB(b, h) + boff + n * 2048 + k * 1024); } while (0)
#define PG8_MMA(ai, bj, At, Bt) do { __builtin_amdgcn_s_setprio(1); _Pragma("unroll") for (int m = 0; m < 4; ++m) _Pragma("unroll") for (int n = 0; n < 2; ++n) _Pragma("unroll") for (int k = 0; k < 2; ++k) \
        acc[ai][bj][m][n] = __builtin_amdgcn_mfma_f32_16x16x32_bf16(Bt[n][k], At[m][k], acc[ai][bj][m][n], 0, 0, 0); __builtin_amdgcn_s_setprio(0); } while (0)
#define PG8_WAIT_V(n) asm volatile("s_waitcnt vmcnt(" #n ")" ::: "memory")
#define PG8_WAIT_L(n) asm volatile("s_waitcnt lgkmcnt(" #n ")" ::: "memory")
#define PG8_BAR __builtin_amdgcn_s_barrier()
#define PG8_SCHED __builtin_amdgcn_sched_barrier(0)
    Unit cur, nxt; int ui = 0;
    if (!S.next(0, cur)) return;
    f32x4 acc[2][2][4][2];
#pragma unroll
    for (int a = 0; a < 2; ++a)
#pragma unroll
        for (int b = 0; b < 2; ++b)
#pragma unroll
            for (int m = 0; m < 4; ++m)
#pragma unroll
                for (int n = 0; n < 2; ++n) acc[a][b][m][n] = (f32x4){0.f, 0.f, 0.f, 0.f};
    bf16x8 At[4][2], B0[2][2], B1[2][2];
    const char* cA = (const char*)g.A + (size_t)cur.pm * tstep; const char* cB = (const char*)g.Bt + (size_t)cur.pn * tstep;
    S.a_ready(cur);
    PG8_STAGE(PG8_SB(0, 0), cB, voffB); PG8_STAGE(PG8_SA(0, 0), cA, voffA); PG8_STAGE(PG8_SB(0, 1), cB + hstep, voffB); PG8_STAGE(PG8_SA(0, 1), cA + hstep, voffA);
    if (wr == 1) PG8_BAR;
    PG8_WAIT_V(4); PG8_BAR;
    PG8_STAGE(PG8_SB(1, 0), cB + kstep, voffB); PG8_STAGE(PG8_SA(1, 0), cA + kstep, voffA); PG8_STAGE(PG8_SB(1, 1), cB + hstep + kstep, voffB);
    PG8_WAIT_V(6); PG8_BAR;
    for (;;) {
        const bool has_next = S.next(ui + 1, nxt);
        const char* nA = has_next ? (const char*)g.A + (size_t)nxt.pm * tstep : cA; const char* nB = has_next ? (const char*)g.Bt + (size_t)nxt.pn * tstep : cB;
        for (int t = 0; t < nt; t += 2) {
            const bool last = (t == nt - 2);
            const char* a1 = cA + (size_t)(t + 1) * kstep;
            const char* a2 = last ? nA : cA + (size_t)(t + 2) * kstep; const char* b2 = last ? nB : cB + (size_t)(t + 2) * kstep;
            const char* a3 = a2 + kstep; const char* b3 = b2 + kstep;
            if (last && has_next) S.a_ready(nxt);
            PG8_LDB(B0, 0, 0); PG8_SCHED; PG8_LDA(At, 0, 0); PG8_STAGE(PG8_SA(1, 1), a1 + hstep, voffA);
            PG8_WAIT_L(8); PG8_BAR; PG8_WAIT_L(0); PG8_MMA(0, 0, At, B0); PG8_BAR; PG8_SCHED;
            PG8_LDB(B1, 0, 1); PG8_STAGE(PG8_SB(0, 0), b2, voffB);
            PG8_BAR; PG8_WAIT_L(0); PG8_MMA(0, 1, At, B1); PG8_BAR;
            PG8_LDA(At, 0, 1); PG8_STAGE(PG8_SA(0, 0), a2, voffA);
            PG8_BAR; PG8_WAIT_L(0); PG8_MMA(1, 0, At, B0); PG8_BAR; PG8_SCHED;
            PG8_STAGE(PG8_SB(0, 1), b2 + hstep, voffB);
            PG8_WAIT_V(6); PG8_BAR; PG8_MMA(1, 1, At, B1); PG8_BAR;
            PG8_LDB(B0, 1, 0); PG8_SCHED; PG8_LDA(At, 1, 0); PG8_STAGE(PG8_SA(0, 1), a2 + hstep, voffA);
            PG8_WAIT_L(8); PG8_BAR; PG8_WAIT_L(0); PG8_MMA(0, 0, At, B0); PG8_BAR; PG8_SCHED;
            PG8_LDB(B1, 1, 1); PG8_STAGE(PG8_SB(1, 0), b3, voffB);
            PG8_BAR; PG8_WAIT_L(0); PG8_MMA(0, 1, At, B1); PG8_BAR;
            PG8_LDA(At, 1, 1); PG8_STAGE(PG8_SA(1, 0), a3, voffA);
            PG8_BAR; PG8_WAIT_L(0); PG8_MMA(1, 0, At, B0); PG8_BAR; PG8_SCHED;
            PG8_STAGE(PG8_SB(1, 1), b3 + hstep, voffB);
            PG8_WAIT_V(6); PG8_BAR; PG8_MMA(1, 1, At, B1); PG8_BAR;
        }
            if constexpr (!Epi::AFTER_DRAIN) { E(acc, cur, wr, wc, fr, fq); S.done(cur); }
            if (!has_next) break;
#pragma unroll
        for (int a = 0; a < 2; ++a)
#pragma unroll
            for (int b = 0; b < 2; ++b)
#pragma unroll
                for (int m = 0; m < 4; ++m)
#pragma unroll
                    for (int n = 0; n < 2; ++n) acc[a][b][m][n] = (f32x4){0.f, 0.f, 0.f, 0.f};
        cur = nxt; cA = nA; cB = nB; ++ui;
    }
    PG8_WAIT_V(0);
    if (wr == 0) PG8_BAR;
    PG8_BAR;
    if constexpr (Epi::AFTER_DRAIN) { E.fused(acc, cur, wr, wc, fr, fq, lds, wid, lane); S.done(cur); }
#undef PG8_SA
#undef PG8_SB
#undef PG8_STAGE
#undef PG8_LDA
#undef PG8_LDB
#undef PG8_MMA
#undef PG8_WAIT_V
#undef PG8_WAIT_L
#undef PG8_BAR
#undef PG8_SCHED
}
}

#define PG8_ROW(u, ai, m) ((u).pm * 256 + (ai) * 128 + wr * 64 + (m) * 16 + fr)
#define PG8_COL8(u, bj) ((u).pn * 256 + (bj) * 128 + wc * 32 + 8 * fq)
struct EpiP1 {
  static constexpr bool PERM = true, AFTER_DRAIN = false;
  float* Z; float* UP; u16* G;
  __device__ __forceinline__ void operator()(const pg8::f32x4 (&acc)[2][2][4][2], const pg8::Unit& u, int wr, int wc, int fr, int fq) const {
#pragma unroll
    for (int bj = 0; bj < 2; ++bj) {
      const int c8 = PG8_COL8(u, bj), grp = u.pn * 256 + bj * 128 + wc * 32;
#pragma unroll
      for (int ai = 0; ai < 2; ++ai)
#pragma unroll
        for (int m = 0; m < 4; ++m) {
          const long row = PG8_ROW(u, ai, m);
          if (grp < ZW) { *(pg8::f32x4*)(Z + row * ZW + c8) = acc[ai][bj][m][0]; *(pg8::f32x4*)(Z + row * ZW + c8 + 4) = acc[ai][bj][m][1]; }
          else if (grp < ZW + DPOOL) { *(pg8::f32x4*)(UP + row * 512 + c8 - ZW) = acc[ai][bj][m][0]; *(pg8::f32x4*)(UP + row * 512 + c8 - ZW + 4) = acc[ai][bj][m][1]; }
          else if (grp < DIN && row < M) {
            float s[8];
#pragma unroll
            for (int j = 0; j < 4; ++j) { s[j] = 1.f / (1.f + __expf(-acc[ai][bj][m][0][j])); s[4 + j] = 1.f / (1.f + __expf(-acc[ai][bj][m][1][j])); }
            u32x4 w = {cvtpk(s[0], s[1]), cvtpk(s[2], s[3]), cvtpk(s[4], s[5]), cvtpk(s[6], s[7])};
            *(u32x4*)(G + row * 2048 + c8 - (ZW + DPOOL)) = w;
          }
        }
    }
  }
};
struct EpiP8 {
  static constexpr bool PERM = true, AFTER_DRAIN = false;
  float* Y; const float* xp; const float* xs;
  __device__ __forceinline__ void operator()(const pg8::f32x4 (&acc)[2][2][4][2], const pg8::Unit& u, int wr, int wc, int fr, int fq) const {
#pragma unroll
    for (int ai = 0; ai < 2; ++ai)
#pragma unroll
      for (int m = 0; m < 4; ++m) {
        const long row = PG8_ROW(u, ai, m);
        const float* xr = row < MP ? xp + row * 1024 : xs + (row - MP) * 1024;
#pragma unroll
        for (int bj = 0; bj < 2; ++bj) {
          const int c8 = PG8_COL8(u, bj);
          const pg8::f32x4 x0 = *(const pg8::f32x4*)(xr + c8), x1 = *(const pg8::f32x4*)(xr + c8 + 4);
          *(pg8::f32x4*)(Y + row * 1024 + c8) = x0 + acc[ai][bj][m][0]; *(pg8::f32x4*)(Y + row * 1024 + c8 + 4) = x1 + acc[ai][bj][m][1];
        }
      }
  }
};
struct EpiP10 {
  static constexpr bool PERM = true, AFTER_DRAIN = false;
  u16* U;
  __device__ __forceinline__ void operator()(const pg8::f32x4 (&acc)[2][2][4][2], const pg8::Unit& u, int wr, int wc, int fr, int fq) const {
#pragma unroll
    for (int ai = 0; ai < 2; ++ai)
#pragma unroll
      for (int m = 0; m < 4; ++m) {
        const long row = PG8_ROW(u, ai, m);
#pragma unroll
        for (int bj = 0; bj < 2; ++bj) {
          float v[8];
#pragma unroll
          for (int j = 0; j < 4; ++j) { const float a = fmaxf(acc[ai][bj][m][0][j], 0.f), b = fmaxf(acc[ai][bj][m][1][j], 0.f); v[j] = a * a; v[4 + j] = b * b; }
          u32x4 w = {cvtpk(v[0], v[1]), cvtpk(v[2], v[3]), cvtpk(v[4], v[5]), cvtpk(v[6], v[7])};
          *(u32x4*)(U + row * 4096 + PG8_COL8(u, bj)) = w;
        }
      }
  }
};
struct EpiP11 {
  static constexpr bool PERM = true, AFTER_DRAIN = false;
  float* Y;
  __device__ __forceinline__ void operator()(const pg8::f32x4 (&acc)[2][2][4][2], const pg8::Unit& u, int wr, int wc, int fr, int fq) const {
#pragma unroll
    for (int ai = 0; ai < 2; ++ai)
#pragma unroll
      for (int m = 0; m < 4; ++m) {
        const long row = PG8_ROW(u, ai, m);
#pragma unroll
        for (int bj = 0; bj < 2; ++bj) {
          float* y = Y + row * 1024 + PG8_COL8(u, bj);
          const pg8::f32x4 h0 = *(const pg8::f32x4*)y, h1 = *(const pg8::f32x4*)(y + 4);
          *(pg8::f32x4*)y = h0 + acc[ai][bj][m][0]; *(pg8::f32x4*)(y + 4) = h1 + acc[ai][bj][m][1];
        }
      }
  }
};
template <class Epi>
DEVI void run_pg8(char* lds, const u16* A, const u16* Bt, int Mr, int Nc, int K, const Epi& E, const int tid) {
  pg8::StaticOrder S; S.init(Mr, Nc, (int)gridDim.x, (int)blockIdx.x);
  pg8::Gemm g; g.A = A; g.Bt = Bt; g.M = Mr; g.N = Nc; g.K = K;
  pg8::gemm_phase<Epi, pg8::StaticOrder>((PG8_LAS unsigned char*)lds, g, S, E, tid);
}

DEVI void phase1(const Params& p, char* lds, const int wvs) {
  const int tid = fresh_tid(wvs);
  char* ws = p.ws;
  EpiP1 E; E.Z = (float*)(ws + X_Z); E.UP = (float*)(ws + X_UP); E.G = (u16*)p.out;
  run_pg8(lds, (const u16*)(ws + W_XN), (const u16*)(ws + W_WINT), RALL, DIN_PAD, 1024, E, tid);
}

DEVI void phase2w(const Params& p, char* lds, const int wvs) {
  const int tid = fresh_tid(wvs);
  char* ws = p.ws;
  const int lane = tid & 63;
  for (int ct = blockIdx.x; ct < 24; ct += gridDim.x) {
    const int h = ct / 3, t3 = ct - 3 * h, wid = tid >> 6, wr = wid >> 1, wc = wid & 1, r32 = lane & 31, hi = lane >> 5;
    f32x16 acc[2][2]; zero_acc(acc);
    gemm_main<2, 2, 4, 2>(acc, (const u16*)(ws + W_WUK) + h * 128, 1024, (const u16*)(ws + W_WQN) + (long)(t3 * 128) * 1536 + h * 192, 1536, 128, lds, tid);
    char* stg = stage_base(lds, wid);
#pragma unroll
    for (int m = 0; m < 2; ++m)
#pragma unroll
      for (int n = 0; n < 2; ++n)
#pragma unroll
        for (int r = 0; r < 16; ++r) stage_put(stg, 32 * m + crow(r, hi), 32 * n + r32, acc[m][n][r]);
    stage_flush(stg, (u16*)(ws + W_COMBT) + (long)(h * 320 + wr * 64) * 384 + t3 * 128 + wc * 64, 384, lane);
    __syncthreads();
  }
  for (int ct = (int)blockIdx.x - 24; ct < 64; ct += gridDim.x) {
    if (ct < 0) continue;
    const int h = ct >> 3, jt = (ct >> 1) & 3, cn = ct & 1, wid = tid >> 6, wr = wid >> 1, wc = wid & 1, r32 = lane & 31, hi = lane >> 5;
    f32x16 acc[2][2]; zero_acc(acc);
    gemm_main<2, 2, 4, 2>(acc, (const u16*)(ws + W_WABT) + (long)(jt * 256) * 1024 + h * 128, 1024, (const u16*)(ws + W_WUVN) + (long)(cn * 128) * 1024 + h * 128, 1024, 128, lds, tid);
    char* stg = stage_base(lds, wid);
#pragma unroll
    for (int m = 0; m < 2; ++m)
#pragma unroll
      for (int n = 0; n < 2; ++n)
#pragma unroll
        for (int r = 0; r < 16; ++r) stage_put(stg, 32 * m + crow(r, hi), 32 * n + r32, acc[m][n][r]);
    stage_flush(stg, (u16*)(ws + W_WPT) + (long)(jt * 256 + wr * 64) * 2048 + h * 256 + cn * 128 + wc * 64, 2048, lane);
    __syncthreads();
  }
}
DEVI void phase2(const Params& p, char* lds, const int wvs) {
  const int tid = fresh_tid(wvs);
  char* ws = p.ws;
  const int lane = tid & 63, w = tid >> 6;
  const float* Z = (const float*)(ws + X_Z); const float* UP = (const float*)(ws + X_UP);
  const float2* TAB = (const float2*)(ws + W_TAB);
  for (int u = blockIdx.x; u < 546; u += gridDim.x) {
    int zrow0, pos0, keybase, b = 0; long ldvt; u16 *Kd, *VT; float *okv, *ope, *opool = nullptr; bool meta = false, sample = false;
    if (u < 512) {
      b = u >> 8; const int ft = u & 255;
      zrow0 = b * SEQ + ft * 64; pos0 = 16 + ft * 64; keybase = 64 + ft * 64; ldvt = LKP;
      Kd = (u16*)(ws + W_KP) + ((long)b * LKP + keybase) * 320; VT = (u16*)(ws + W_VTP) + (long)b * 256 * LKP;
      okv = p.out + O_KVP + ((long)b * 16400 + pos0) * 256; ope = p.out + O_PEP + ((long)b * 16400 + pos0) * 64;
      if (ft == 255) opool = p.out + O_POOLP + (long)b * 15 * 512;
    } else if (u < 544) {
      b = u - 512; sample = true;
      zrow0 = MP + b * 64; pos0 = PAST; keybase = PAST; ldvt = LKS;
      Kd = (u16*)(ws + W_KS) + ((long)b * LKS + keybase) * 320; VT = (u16*)(ws + W_VTS) + (long)b * 256 * LKS;
      okv = p.out + O_KVS + (long)b * 64 * 256; ope = p.out + O_PES + (long)b * 64 * 64;
      opool = p.out + O_POOLS + (long)b * 15 * 512;
    } else {
      b = u - 544; meta = true;
      zrow0 = M; pos0 = 0; keybase = 0; ldvt = LKP;
      Kd = (u16*)(ws + W_KP) + (long)b * LKP * 320; VT = (u16*)(ws + W_VTP) + (long)b * 256 * LKP;
      okv = p.out + O_KVP + (long)b * 16400 * 256; ope = p.out + O_PEP + (long)b * 16400 * 64;
    }
    const int w0 = lane < 32 ? 2 : 4, w1 = lane < 32 ? 8 : 16;
    auto urow = [&](int e) -> const float* {
      if (!sample) return e < 16 ? UP + (long)(M + e) * 512 : UP + (long)(b * SEQ + e - 16) * 512;
      return e < 15 ? p.cache_pool + ((long)b * 15 + e) * 512 : UP + (long)(MP + b * 64 + e - 15) * 512;
    };
    float4 S0 = make_float4(0, 0, 0, 0), S1 = S0;
    const int e0 = sample ? 15 + w * 8 : 16 + (zrow0 - b * SEQ) + w * 8;
    if (!meta) {
      for (int k = 1; k <= 16; ++k) {
        const int e = e0 - k;
        if (e >= 0) {
          const float* ur = urow(e);
          if (k <= w0) { const float4 v = *(const float4*)(ur + 4 * lane); S0.x += v.x; S0.y += v.y; S0.z += v.z; S0.w += v.w; }
          if (k <= w1) { const float4 v = *(const float4*)(ur + 256 + 4 * lane); S1.x += v.x; S1.y += v.y; S1.z += v.z; S1.w += v.w; }
        }
      }
    }
    for (int i = 0; i < 8; ++i) {
      const int r = w * 8 + i;
      const bool valid = !meta || r < 16;
      const long zrow = zrow0 + r;
      float4 x = valid ? *(const float4*)(Z + zrow * ZW + QL + 4 * lane) : make_float4(0, 0, 0, 0);
      float ss = wave_sum(x.x * x.x + x.y * x.y + x.z * x.z + x.w * x.w);
      float rs = rsqrtf(ss * (1.f / 256.f) + EPS);
      const float4 gk = *(const float4*)(p.g_kv + 4 * lane);
      float4 c = make_float4(x.x * rs * gk.x, x.y * rs * gk.y, x.z * rs * gk.z, x.w * rs * gk.w);
      uint2 cb; cb.x = cvtpk(c.x, c.y); cb.y = cvtpk(c.z, c.w);
      *(uint2*)(Kd + r * 320 + 4 * lane) = cb;
      if (valid) *(float4*)(okv + (long)r * 256 + 4 * lane) = c;
      if (lane < 32) {
        float o1 = 0.f, o2 = 0.f;
        if (valid) {
          const float x1 = Z[zrow * ZW + 640 + lane], x2 = Z[zrow * ZW + 672 + lane];
          const float2 cs = TAB[(pos0 + r) * 32 + lane];
          o1 = x1 * cs.x - x2 * cs.y; o2 = x1 * cs.y + x2 * cs.x;
          ope[(long)r * 64 + lane] = o1; ope[(long)r * 64 + 32 + lane] = o2;
        }
        *(unsigned*)(Kd + r * 320 + 256 + 2 * lane) = cvtpk(o1, o2);
      }
      if (!meta) {
        float2 q[3];
#pragma unroll
        for (int j = 0; j < 3; ++j) q[j] = *(const float2*)(Z + zrow * ZW + 2 * lane + 128 * j);
        float qs = 0;
#pragma unroll
        for (int j = 0; j < 3; ++j) qs += q[j].x * q[j].x + q[j].y * q[j].y;
        qs = wave_sum(qs);
        const float qr = rsqrtf(qs * (1.f / 384.f) + EPS);
#pragma unroll
        for (int j = 0; j < 3; ++j) {
          const float2 gq = *(const float2*)(p.g_q + 2 * lane + 128 * j);
          *(unsigned*)((u16*)(ws + X_QN_) + zrow * 384 + 2 * lane + 128 * j) = cvtpk(q[j].x * qr * gq.x, q[j].y * qr * gq.y);
        }
        const int e = e0 + i;
        const float* ur = urow(e);
        const float4 u0 = *(const float4*)(ur + 4 * lane), u1 = *(const float4*)(ur + 256 + 4 * lane);
        float4 d0 = make_float4(0, 0, 0, 0), d1 = d0;
        if (e - w0 >= 0) d0 = *(const float4*)(urow(e - w0) + 4 * lane);
        if (e - w1 >= 0) d1 = *(const float4*)(urow(e - w1) + 256 + 4 * lane);
        S0.x += u0.x - d0.x; S0.y += u0.y - d0.y; S0.z += u0.z - d0.z; S0.w += u0.w - d0.w;
        S1.x += u1.x - d1.x; S1.y += u1.y - d1.y; S1.z += u1.z - d1.z; S1.w += u1.w - d1.w;
        const float i0 = 1.f / (float)w0, i1 = 1.f / (float)w1;
        uint2 pa, pb;
        pa.x = cvtpk(S0.x * i0 - u0.x, S0.y * i0 - u0.y); pa.y = cvtpk(S0.z * i0 - u0.z, S0.w * i0 - u0.w);
        pb.x = cvtpk(S1.x * i1 - u1.x, S1.y * i1 - u1.y); pb.y = cvtpk(S1.z * i1 - u1.z, S1.w * i1 - u1.w);
        *(uint2*)((u16*)(ws + X_PIN) + zrow * 512 + 4 * lane) = pa;
        *(uint2*)((u16*)(ws + X_PIN) + zrow * 512 + 256 + 4 * lane) = pb;
        if (opool != nullptr && r >= 49) {
          *(float4*)(opool + (long)(r - 49) * 512 + 4 * lane) = u0;
          *(float4*)(opool + (long)(r - 49) * 512 + 256 + 4 * lane) = u1;
        }
      }
    }
  }
}

DEVI int row_pos(int row) { return row < MP ? 16 + (row & (SEQ - 1)) : PAST + ((row - MP) & 63); }

DEVI void phase3(const Params& p, char* lds, const int wvs) {
  const int tid = fresh_tid(wvs);
  char* ws = p.ws;
  const int lane = tid & 63, wid = tid >> 6, wr = wid >> 1, wc = wid & 1, r32 = lane & 31, hi = lane >> 5;
  TILE_LOOP(t, (M / 256) * 4) {
    const int tm = t >> 2, g = t & 3;
    f32x16 acc[2][2]; zero_acc(acc);
    gemm_main<2, 2, 4, 2>(acc, (const u16*)(ws + X_PIN) + (long)tm * 256 * 512 + g * 128, 512, (const u16*)(ws + W_WGT) + g * 16384, 128, 128, lds, tid);
    char* stg = stage_base(lds, wid);
#pragma unroll
    for (int m = 0; m < 2; ++m)
#pragma unroll
      for (int n = 0; n < 2; ++n) {
        const float sc = p.pool_scale[g * 128 + wc * 64 + n * 32 + r32];
#pragma unroll
        for (int r = 0; r < 16; ++r) stage_put(stg, 32 * m + crow(r, hi), 32 * n + r32, acc[m][n][r] * sc);
      }
    stage_flush(stg, (u16*)(ws + W_XN) + (long)(tm * 256 + wr * 64) * 512 + g * 128 + wc * 64, 512, lane);
  }
}

struct EpiQ {
  static constexpr bool PERM = true, AFTER_DRAIN = false;
  u16* QB; const float2* TAB;
  __device__ __forceinline__ void operator()(const pg8::f32x4 (&acc)[2][2][4][2], const pg8::Unit& u, int wr, int wc, int fr_, int fq_) const {
    const int l_ = fresh_tid(0), fr = l_ & 15, fq = l_ >> 4;
    (void)fr_; (void)fq_;
#pragma unroll
    for (int bj = 0; bj < 2; ++bj) {
      const int c8 = PG8_COL8(u, bj), grp = u.pn * 256 + bj * 128 + wc * 32, head = grp / 320, hcol = grp - head * 320;
#pragma unroll
      for (int ai = 0; ai < 2; ++ai)
#pragma unroll
        for (int m = 0; m < 4; ++m) {
          const int row = PG8_ROW(u, ai, m);
          const pg8::f32x4 v0 = acc[ai][bj][m][0], v1 = acc[ai][bj][m][1];
          u32x4 w;
          if (hcol < 256) {
            w = (u32x4){cvtpk(v0[0] * QS, v0[1] * QS), cvtpk(v0[2] * QS, v0[3] * QS), cvtpk(v1[0] * QS, v1[1] * QS), cvtpk(v1[2] * QS, v1[3] * QS)};
          } else {
            const float2* tp = TAB + row_pos(row) * 32 + ((c8 - head * 320 - 256) >> 1);
#pragma unroll
            for (int i = 0; i < 4; ++i) {
              const float2 cs = tp[i];
              const float x1 = i < 2 ? v0[2 * i] : v1[2 * i - 4], x2 = i < 2 ? v0[2 * i + 1] : v1[2 * i - 3];
              w[i] = cvtpk((x1 * cs.x - x2 * cs.y) * QS, (x1 * cs.y + x2 * cs.x) * QS);
              __builtin_amdgcn_sched_barrier(0);
            }
          }
          *(u32x4*)(QB + (long)row * 2560 + c8) = w;
          __builtin_amdgcn_sched_barrier(0);
        }
    }
  }
};
DEVI void phase3q(const Params& p, char* lds, const int wvs) {
  const int tid = fresh_tid(wvs);
  char* ws = p.ws;
  __syncthreads();
  EpiQ E; E.QB = (u16*)(ws + X_QB); E.TAB = (const float2*)(ws + W_TAB);
  run_pg8(lds, (const u16*)(ws + X_QN_), (const u16*)(ws + W_COMBT), M, 2560, 384, E, tid);
}

using s16x4 = __attribute__((ext_vector_type(4))) short;
template <int OFF> DEVI s16x4 tr_read(int a) { s16x4 r; asm volatile("ds_read_b64_tr_b16 %0, %1 offset:%2" : "=&v"(r) : "v"(a), "i"(OFF) : "memory"); return r; }
struct TrSet { s16x4 lo[2], hi[2]; };
template <int D0> DEVI void tr_load2(TrSet& s, int a0, int a1) {
  constexpr int B = (D0 >> 1) * 8192;
  s.lo[0] = tr_read<B + 0 * 2048>(a0);        s.hi[0] = tr_read<B + 0 * 2048 + 1024>(a1);
  s.lo[1] = tr_read<B + 1 * 2048>(a0);        s.hi[1] = tr_read<B + 1 * 2048 + 1024>(a1);
}
DEVI bf16x8 pk8(s16x4 l, s16x4 h) { return (bf16x8){l[0], l[1], l[2], l[3], h[0], h[1], h[2], h[3]}; }
DEVI void pv2(f32x16& o, const TrSet& s, const bf16x8 (&pf)[2]) {
#pragma unroll
  for (int f = 0; f < 2; ++f) o = mfma(pk8(s.lo[f], s.hi[f]), pf[f], o);
}
#define WAIT_LGKM(n) asm volatile("s_waitcnt lgkmcnt(" #n ")" ::: "memory")
#define SBAR() __builtin_amdgcn_sched_barrier(0)
constexpr int KBUF = 40960;

constexpr int XP_OFF = 3 * KBUF;
constexpr int XM_OFF = XP_OFF + 8 * 2048;
constexpr int XF_OFF = XM_OFF + 8 * 256;
constexpr int ATT_LDS = XF_OFF + 64;
DEVI void raw_barrier() { asm volatile("s_waitcnt lgkmcnt(0)" ::: "memory"); __builtin_amdgcn_s_barrier(); asm volatile("" ::: "memory"); }

DEVI bool attn_job(int& seq, const bool preset, const float mref, const u16* __restrict__ Q0, const u16* __restrict__ Kt, int ntiles, bool maskfirst, u16* __restrict__ O0, char* lds, const int tid_in) {
  int tid = tid_in; asm volatile("" : "+v"(tid));
  const int lane = tid & 63, w = tid >> 6, r32 = lane & 31, hi = lane >> 5;
  const int pr = w >> 1, u = w & 1;
  const int h = 2 * pr + (r32 >> 4), qi = r32 & 15;
  const u16* qp = Q0 + ((long)qi * 8 + h) * 320 + hi * 8;
  bf16x8 qf[20];
#pragma unroll
  for (int ks = 0; ks < 20; ++ks) qf[ks] = *(const bf16x8*)(qp + ks * 16);
  f32x16 O[4];
#pragma unroll
  for (int d = 0; d < 4; ++d)
#pragma unroll
    for (int r = 0; r < 16; ++r) O[d][r] = 0.f;
  float mrun = mref, lrun = 0.f;
  const int fch = (tid & 7) ^ ((((tid >> 4) & 1) << 2) | ((tid >> 5) & 3));
  const u16* ksrc = Kt + (long)(tid >> 3) * 320 + fch * 8;
  char* lw = lds + w * 1024;
#define A_ISSUE(t_, buf_) do { _Pragma("unroll") for (int i_ = 0; i_ < 5; ++i_) glds16(ksrc + (long)(t_) * 64 * 320 + i_ * 64, lw + (buf_) * KBUF + i_ * 8192); } while (0)
  const int fr = ((r32 & 2) << 1) | ((r32 >> 2) & 3);
  const int frh = (fr ^ hi) * 16;
  const int kk = (lane & 15) >> 2, vh = (lane >> 4) & 1, cl = (lane & 3) >> 1;
  int tb[2][2];
#pragma unroll
  for (int dd = 0; dd < 2; ++dd)
#pragma unroll
    for (int hf = 0; hf < 2; ++hf)
      tb[dd][hf] = (int)(uintptr_t)lds + u * 16384 + (kk + 4 * hi) * 128 + ((((dd ^ (kk >> 1)) << 2) | ((2 * vh + cl) ^ (2 * hf + hi))) * 16) + (lane & 1) * 8;
#define xp_own (lds + XP_OFF + w * 2048 + lane * 32)
#define xp_oth (lds + XP_OFF + (w ^ 1) * 2048 + lane * 32)
#define xm_own ((float*)(lds + XM_OFF) + w * 64 + lane)
#define xm_oth ((const float*)(lds + XM_OFF) + (w ^ 1) * 64 + lane)
  A_ISSUE(0, 0);
  if (ntiles > 1) { A_ISSUE(1, 1); asm volatile("s_waitcnt vmcnt(5)" ::: "memory"); } else { WAIT_VM0(); }
  raw_barrier();
  int cbuf = 0;
#pragma unroll 1
  for (int t = 0; t < ntiles; ++t) {
    const bool more = t + 2 < ntiles;
    const int nbuf = cbuf == 0 ? 2 : cbuf - 1;
    if (more) A_ISSUE(t + 2, nbuf);
    const char* kb = lds + cbuf * KBUF;
    const char* ka = kb + (32 * u + r32) * 128;
    f32x16 s;
#pragma unroll
    for (int r = 0; r < 16; ++r) s[r] = 0.f;
    {
      const int kaddr = (int)(uintptr_t)ka;
      int kad[4];
#pragma unroll
      for (int j = 0; j < 4; ++j) kad[j] = kaddr + ((j * 32) ^ frh);
      bf16x8 fk[4];
#pragma unroll
      for (int ks = 0; ks < 3; ++ks) fk[ks] = lds_rd128(kad[ks & 3], (ks >> 2) * 8192);
#pragma unroll
      for (int ks = 0; ks < 20; ++ks) {
        if (ks + 3 < 20) fk[(ks + 3) & 3] = lds_rd128(kad[(ks + 3) & 3], ((ks + 3) >> 2) * 8192);
        const int ahead = (19 - ks) < 3 ? (19 - ks) : 3;
        if (ahead == 3) WAIT_LGKM(3); else if (ahead == 2) WAIT_LGKM(2); else if (ahead == 1) WAIT_LGKM(1); else WAIT_LGKM(0);
        SBAR();
        s = mfma(fk[ks & 3], qf[ks], s);
        SBAR();
      }
    }
    if (maskfirst && t == 0) {
#pragma unroll
      for (int r = 0; r < 16; ++r) { if (32 * u + crow(r, hi) >= 16) s[r] = -1e30f; }
    }
    if (t == 0 && !preset) {
      float mx = s[0];
#pragma unroll
      for (int r = 1; r < 16; ++r) mx = fmaxf(mx, s[r]);
      mx = fmaxf(mx, __shfl_xor(mx, 32, 64));
      *xm_own = mx;
      raw_barrier();
      mrun = fmaxf(mx, *xm_oth);
    }
    float ps = 0.f;
#pragma unroll
    for (int r = 0; r < 16; ++r) { s[r] = __builtin_amdgcn_exp2f(s[r] - mrun); ps += s[r]; }
    lrun += ps;
    u32x4 own0 = {cvtpk(s[0], s[1]), cvtpk(s[2], s[3]), cvtpk(s[4], s[5]), cvtpk(s[6], s[7])};
    u32x4 own1 = {cvtpk(s[8], s[9]), cvtpk(s[10], s[11]), cvtpk(s[12], s[13]), cvtpk(s[14], s[15])};
    *(u32x4*)xp_own = own0; *(u32x4*)(xp_own + 16) = own1;
    ++seq;
    asm volatile("s_waitcnt lgkmcnt(0)" ::: "memory");
    if (lane == 0) *(volatile int*)(lds + XF_OFF + w * 4) = seq;
    bf16x8 pf[2] = {__builtin_bit_cast(bf16x8, own0), __builtin_bit_cast(bf16x8, own1)};
    const int bo = cbuf * KBUF;
    {
      const int e0 = tb[0][0] + bo + u * 4096, e1 = tb[0][1] + bo + u * 4096, o0 = tb[1][0] + bo + u * 4096, o1 = tb[1][1] + bo + u * 4096;
      TrSet A;
      SBAR();
      tr_load2<0>(A, e0, e1); WAIT_LGKM(0); SBAR(); pv2(O[0], A, pf); SBAR();
      tr_load2<1>(A, o0, o1); WAIT_LGKM(0); SBAR(); pv2(O[1], A, pf); SBAR();
      tr_load2<2>(A, e0, e1); WAIT_LGKM(0); SBAR(); pv2(O[2], A, pf); SBAR();
      tr_load2<3>(A, o0, o1); WAIT_LGKM(0); SBAR(); pv2(O[3], A, pf); SBAR();
    }
    {
      const int faddr = (int)(uintptr_t)lds + XF_OFF + (w ^ 1) * 4;
      for (int spin = 0; spin < (1 << 22); ++spin) {
        int v; asm volatile("ds_read_b32 %0, %1\n\ts_waitcnt lgkmcnt(0)" : "=v"(v) : "v"(faddr) : "memory");
        if (__builtin_amdgcn_readfirstlane(v) - seq >= 0) break;
        __builtin_amdgcn_s_sleep(1);
      }
    }
    {
      const u32x4 oth0 = *(const u32x4*)xp_oth, oth1 = *(const u32x4*)(xp_oth + 16);
      bf16x8 pg[2] = {__builtin_bit_cast(bf16x8, oth0), __builtin_bit_cast(bf16x8, oth1)};
      const int uo = (u ^ 1) * 4096;
      const int e0 = tb[0][0] + bo + uo, e1 = tb[0][1] + bo + uo, o0 = tb[1][0] + bo + uo, o1 = tb[1][1] + bo + uo;
      TrSet A;
      asm volatile("s_waitcnt lgkmcnt(0)" ::: "memory");
      SBAR();
      tr_load2<0>(A, e0, e1); WAIT_LGKM(0); SBAR(); pv2(O[0], A, pg); SBAR();
      tr_load2<1>(A, o0, o1); WAIT_LGKM(0); SBAR(); pv2(O[1], A, pg); SBAR();
      tr_load2<2>(A, e0, e1); WAIT_LGKM(0); SBAR(); pv2(O[2], A, pg); SBAR();
      tr_load2<3>(A, o0, o1); WAIT_LGKM(0); SBAR(); pv2(O[3], A, pg); SBAR();
    }
    if (more) asm volatile("s_waitcnt vmcnt(5)" ::: "memory"); else WAIT_VM0();
    raw_barrier();
    cbuf = cbuf == 2 ? 0 : cbuf + 1;
  }
#undef A_ISSUE
  {
    const int badw = __any(!(lrun < 1.1805916e21f)) ? 1 : 0;
    volatile int* bf = (volatile int*)(lds + XF_OFF + 32);
    if (lane == 0) bf[w] = badw;
    __syncthreads();
    const int anyb = bf[0] | bf[1] | bf[2] | bf[3] | bf[4] | bf[5] | bf[6] | bf[7];
    __syncthreads();
    if (anyb) return true;
  }
  float lsum = lrun + __shfl_xor(lrun, 32, 64);
  *xm_own = lsum;
  __syncthreads();
  const float inv = 1.f / (lsum + *xm_oth);
  __syncthreads();
  u16* op = O0 + ((long)qi * 8 + h) * 256 + 128 * u + 4 * hi;
#pragma unroll
  for (int d = 0; d < 4; ++d)
#pragma unroll
    for (int g = 0; g < 4; ++g) {
      uint2 ov; ov.x = cvtpk(O[d][4 * g] * inv, O[d][4 * g + 1] * inv); ov.y = cvtpk(O[d][4 * g + 2] * inv, O[d][4 * g + 3] * inv);
      *(uint2*)(op + d * 32 + g * 8) = ov;
    }
  return false;
#undef xp_own
#undef xp_oth
#undef xm_own
#undef xm_oth
}

DEVI float attn_maxpass(const u16* __restrict__ Q0, const u16* __restrict__ Kt, int ntiles, bool maskfirst, char* lds, const int tid_in) {
  int tid = tid_in; asm volatile("" : "+v"(tid));
  const int lane = tid & 63, w = tid >> 6, r32 = lane & 31, hi = lane >> 5;
  const int h = 2 * (w >> 1) + (r32 >> 4), qi = r32 & 15;
  const u16* qp = Q0 + ((long)qi * 8 + h) * 320 + hi * 8;
  const int fch = (tid & 7) ^ ((((tid >> 4) & 1) << 2) | ((tid >> 5) & 3));
  const u16* ksrc = Kt + (long)(tid >> 3) * 320 + fch * 8;
  char* lw = lds + w * 1024;
  const int fr = ((r32 & 2) << 1) | ((r32 >> 2) & 3);
  float mrun = -1e30f;
#pragma unroll 1
  for (int t = 0; t < ntiles; ++t) {
#pragma unroll
    for (int i = 0; i < 5; ++i) glds16(ksrc + (long)t * 64 * 320 + i * 64, lw + i * 8192);
    WAIT_VM0(); __syncthreads();
    f32x16 s0, s1;
#pragma unroll
    for (int r = 0; r < 16; ++r) { s0[r] = 0.f; s1[r] = 0.f; }
    const char* ka = lds + r32 * 128;
#pragma unroll 2
    for (int ks = 0; ks < 20; ++ks) {
      const bf16x8 q = *(const bf16x8*)(qp + ks * 16);
      const int off = (ks >> 2) * 8192 + ((2 * (ks & 3) + hi) ^ fr) * 16;
      s0 = mfma(*(const bf16x8*)(ka + off), q, s0);
      s1 = mfma(*(const bf16x8*)(ka + 32 * 128 + off), q, s1);
    }
    if (maskfirst && t == 0) {
#pragma unroll
      for (int r = 0; r < 16; ++r) { if (crow(r, hi) >= 16) s0[r] = -1e30f; s1[r] = -1e30f; }
    }
#pragma unroll
    for (int r = 0; r < 16; ++r) mrun = fmaxf(mrun, fmaxf(s0[r], s1[r]));
    __syncthreads();
  }
  return fmaxf(mrun, __shfl_xor(mrun, 32, 64));
}

static_assert(ATT_LDS <= LDS_BYTES && 2 * 512 * 128 <= LDS_BYTES, "LDS");
DEVI void phase5(const Params& p, char* lds, const int wvs) {
  const int tid = fresh_tid(wvs);
  char* ws = p.ws;
  const u16* QB = (const u16*)(ws + X_QB); u16* OL = (u16*)(ws + X_OL);
  if (tid < 8) *(volatile int*)(lds + XF_OFF + tid * 4) = 0;
  __syncthreads();
  int seq = 0;
  const int ngrp = gridDim.x >> 2;
  const int xcd = blockIdx.x & 7, idx = blockIdx.x >> 3;
  const int grp = xcd + 8 * (idx >> 2), j = idx & 3;
  const int nsamp = blockIdx.x < 128 ? (int)((128 - blockIdx.x + gridDim.x - 1) / gridDim.x) : 0;
  for (int jj = -nsamp;; ++jj) {
    long qrow0; const u16* Kt; int nt; bool mask;
    if (jj < 0) {
      const int sit = (int)blockIdx.x + (jj + nsamp) * (int)gridDim.x;
      const int bd = sit >> 2, js = sit & 3;
      qrow0 = MP + bd * 64 + js * 16; Kt = (const u16*)(ws + W_KS) + (long)bd * LKS * 320; nt = 17; mask = false;
    } else {
      const int k = jj * ngrp + ((jj & 1) ? ngrp - 1 - grp : grp);
      if (k >= 512) break;
      const int c = 255 - (k >> 1), b = k & 1;
      qrow0 = (long)b * SEQ + c * 64 + j * 16; Kt = (const u16*)(ws + W_KP) + (long)b * LKP * 320; nt = c + 2; mask = true;
    }
    bool preset = false; float mref = -1e30f;
    while (true) {
      const bool bad = attn_job(seq, preset, mref, QB + qrow0 * 8 * 320, Kt, nt, mask, OL + qrow0 * 2048, lds, tid);
      if (!bad || preset) break;
      mref = attn_maxpass(QB + qrow0 * 8 * 320, Kt, nt, mask, lds, tid);
      preset = true;
    }
  }
}


DEVI void phase7(const Params& p, char* lds, const int wvs) {
  const int tid = fresh_tid(wvs);
  char* ws = p.ws;
  const int lane = tid & 63, wid = tid >> 6, wr = wid >> 1, wc = wid & 1, r32 = lane & 31, hi = lane >> 5;
  const u16* G = (const u16*)p.out; u16* MG = (u16*)(ws + X_MG);
  TILE_LOOP(tile, (MP / 256) * 8) {
    const int tm = tile >> 3, tn = tile & 7;
    f32x16 acc[2][2], acp[2][2]; zero_acc(acc); zero_acc(acp);
    gemm_main<2, 2, 4, 2, 1>(acc, (const u16*)(ws + X_OL) + (long)tm * 256 * 2048, 2048, (const u16*)(ws + W_WPT) + (long)tn * 128 * 2048, 2048, 2048, lds, tid);
    gemm_main<2, 2, 4, 2, 1>(acp, (const u16*)(ws + W_XN) + (long)tm * 256 * 512, 512, (const u16*)(ws + W_WPBT) + (long)tn * 128 * 512, 512, 512, lds, tid);
    char* stg = stage_base(lds, wid);
#pragma unroll
    for (int m = 0; m < 2; ++m)
#pragma unroll
      for (int n = 0; n < 2; ++n) {
        const int brow = tm * 256 + wr * 64 + m * 32, col = tn * 128 + wc * 64 + n * 32 + r32;
#pragma unroll
        for (int r = 0; r < 16; ++r) {
          const long row = brow + crow(r, hi);
          const float ga = __uint_as_float((unsigned)G[row * 2048 + col] << 16), gp = __uint_as_float((unsigned)G[row * 2048 + 1024 + col] << 16);
          stage_put(stg, 32 * m + crow(r, hi), 32 * n + r32, ga * acc[m][n][r] + gp * acp[m][n][r]);
        }
        SBAR();
      }
    stage_flush(stg, MG + (long)(tm * 256 + wr * 64) * 1024 + tn * 128 + wc * 64, 1024, lane);
  }
}
DEVI void phase7s(const Params& p, char* lds, const int wvs) {
  const int tid = fresh_tid(wvs);
  char* ws = p.ws;
  const int lane = tid & 63, wid = tid >> 6, r32 = lane & 31, hi = lane >> 5, wr4 = wid >> 2, wc4 = wid & 3;
  const u16* G = (const u16*)p.out; u16* MG = (u16*)(ws + X_MG);
  TILE_LOOP(tile, 256) {
    const int tm = tile >> 3, tn = tile & 7;
    f32x16 acc[1][1], acp[1][1]; zero_acc(acc); zero_acc(acp);
    gemm_main_reg<1, 1, 2, 4, 2>(acc, (const u16*)(ws + X_OL) + (long)(MP + tm * 64) * 2048, 2048, (const u16*)(ws + W_WPT) + (long)tn * 128 * 2048, 2048, 2048, lds, tid);
    gemm_main_reg<1, 1, 2, 4, 2>(acp, (const u16*)(ws + W_XN) + (long)(MP + tm * 64) * 512, 512, (const u16*)(ws + W_WPBT) + (long)tn * 128 * 512, 512, 512, lds, tid);
    const int col = tn * 128 + wc4 * 32 + r32;
#pragma unroll
    for (int r = 0; r < 16; ++r) {
      const long row = MP + tm * 64 + wr4 * 32 + crow(r, hi);
      const float ga = __uint_as_float((unsigned)G[row * 2048 + col] << 16), gp = __uint_as_float((unsigned)G[row * 2048 + 1024 + col] << 16);
      MG[row * 1024 + col] = tobf(ga * acc[0][0][r] + gp * acp[0][0][r]);
    }
  }
}

DEVI void phase8(const Params& p, char* lds, const int wvs) {
  const int tid = fresh_tid(wvs);
  char* ws = p.ws;
  {
    const int lane = tid & 63, wid = tid >> 6, wr = wid >> 2, wc = wid & 3, r32 = lane & 31, hi = lane >> 5;
    TILE_LOOP(tile, 256) {
      const int tm = tile >> 3, tn = tile & 7;
      f32x16 acc[1][1]; zero_acc(acc);
      gemm_main_reg<1, 1, 2, 4, 2>(acc, (const u16*)(ws + X_MG) + (long)(MP + tm * 64) * 1024, 1024, (const u16*)(ws + W_WOT) + (long)tn * 128 * 1024, 1024, 1024, lds, tid);
      const int col = tn * 128 + wc * 32 + r32;
#pragma unroll
      for (int r = 0; r < 16; ++r) {
        const long srow = tm * 64 + wr * 32 + crow(r, hi);
        p.out[(MP + srow) * 1024 + col] = p.x_sample[srow * 1024 + col] + acc[0][0][r];
      }
    }
  }
  EpiP8 E; E.Y = p.out; E.xp = p.x_prompt; E.xs = p.x_sample;
  run_pg8(lds, (const u16*)(ws + X_MG), (const u16*)(ws + W_WOT), MP, 1024, 1024, E, tid);
}

DEVI void phase9(const Params& p, const int wvs) {
  const int tid = fresh_tid(wvs);
  const int lane = tid & 63, w = tid >> 6;
  for (int r0 = blockIdx.x * 32 + w; r0 < M; r0 += gridDim.x * 32) {
    const float* s[4]; char* d[4]; bool ok[4], z[4];
#pragma unroll
    for (int k = 0; k < 4; ++k) { const int row = r0 + 8 * k; ok[k] = row < M; z[k] = false; s[k] = p.out + (long)row * 1024; d[k] = (char*)((u16*)(p.ws + W_XN) + (long)row * 1024); }
    rms_rows<4, true>(s, ok, z, p.g_ffn, d, lane);
  }
}
DEVI void phase12(const Params& p, const int wvs) {
  const int tid = fresh_tid(wvs);
  const int lane = tid & 63, w = tid >> 6;
  for (int r0 = blockIdx.x * 32 + w; r0 < M; r0 += gridDim.x * 32) {
    const float* s[4]; char* d[4]; bool ok[4], z[4];
#pragma unroll
    for (int k = 0; k < 4; ++k) { const int row = r0 + 8 * k; ok[k] = row < M; z[k] = false; s[k] = p.out + (long)row * 1024; d[k] = (char*)(p.out + (long)row * 1024); }
    rms_rows<4, false>(s, ok, z, p.g_final, d, lane);
  }
}

DEVI void phase10(const Params& p, char* lds, const int wvs) {
  const int tid = fresh_tid(wvs);
  char* ws = p.ws;
  EpiP10 E; E.U = (u16*)(ws + X_U);
  run_pg8(lds, (const u16*)(ws + W_XN), (const u16*)(ws + W_WUPT), M, 4096, 1024, E, tid);
}

DEVI void phase11(const Params& p, char* lds, const int wvs) {
  const int tid = fresh_tid(wvs);
  char* ws = p.ws;
  {
    const int lane = tid & 63, wid = tid >> 6, wr = wid >> 2, wc = wid & 3, r32 = lane & 31, hi = lane >> 5;
    TILE_LOOP(tile, 256) {
      const int tm = tile >> 3, tn = tile & 7;
      f32x16 acc[1][1]; zero_acc(acc);
      gemm_main_reg<1, 1, 2, 4, 2>(acc, (const u16*)(ws + X_U) + (long)(MP + tm * 64) * 4096, 4096, (const u16*)(ws + W_WDT) + (long)tn * 128 * 4096, 4096, 4096, lds, tid);
      const int col = tn * 128 + wc * 32 + r32;
#pragma unroll
      for (int r = 0; r < 16; ++r) { float* y = p.out + (long)(MP + tm * 64 + wr * 32 + crow(r, hi)) * 1024 + col; *y = *y + acc[0][0][r]; }
    }
  }
  EpiP11 E; E.Y = p.out;
  run_pg8(lds, (const u16*)(ws + X_U), (const u16*)(ws + W_WDT), MP, 1024, 4096, E, tid);
}

__global__ void __launch_bounds__(512) fwd_megakernel(Params p) {
  extern __shared__ __attribute__((aligned(16))) char lds[];
  const int wvs = __builtin_amdgcn_readfirstlane(threadIdx.x >> 6);
  phase0(p, lds, wvs);  cg::this_grid().sync();
  phase1(p, lds, wvs);  grid_barrier(p.ws, 1, wvs);
  phase2w(p, lds, wvs); phase2(p, lds, wvs);  grid_barrier(p.ws, 2, wvs);
  phase3(p, lds, wvs);  phase3q(p, lds, wvs);  grid_barrier(p.ws, 3, wvs);
  phase5(p, lds, wvs);  grid_barrier(p.ws, 4, wvs);
  phase7(p, lds, wvs);  phase7s(p, lds, wvs);  grid_barrier(p.ws, 5, wvs);
  phase8(p, lds, wvs);  grid_barrier(p.ws, 6, wvs);
  phase9(p, wvs);       grid_barrier(p.ws, 7, wvs);
  phase10(p, lds, wvs); grid_barrier(p.ws, 8, wvs);
  phase11(p, lds, wvs); grid_barrier(p.ws, 9, wvs);
  phase12(p, wvs);
}

extern "C" void kernel_launch(void* const* d_in, const int* in_sizes, int n_in, void* d_out, int out_size, void* d_ws, size_t ws_size, hipStream_t stream) {
  static int grid_blocks = 0;
  if (!grid_blocks) {
    if (ws_size < WS_LIMIT + 4096) { fprintf(stderr, "kernel_launch: ws too small: %zu\n", ws_size); return; }
    if (hipFuncSetAttribute((const void*)fwd_megakernel, hipFuncAttributeMaxDynamicSharedMemorySize, LDS_BYTES) != hipSuccess) {
      fprintf(stderr, "kernel_launch: hipFuncSetAttribute failed\n"); return; }
    int dev = 0, cus = 0, per_cu = 0;
    hipGetDevice(&dev);
    hipDeviceGetAttribute(&cus, hipDeviceAttributeMultiprocessorCount, dev);
    hipOccupancyMaxActiveBlocksPerMultiprocessor(&per_cu, fwd_megakernel, 512, LDS_BYTES);
    if (per_cu < 1) { fprintf(stderr, "kernel_launch: occupancy 0\n"); return; }
    grid_blocks = cus - cus % 32;
    if (grid_blocks < 32) { fprintf(stderr, "kernel_launch: too few CUs\n"); grid_blocks = 0; return; }
  }
  Params p{};
  const float** f = (const float**)&p;
  for (int i = 0; i < 22; ++i) f[i] = (const float*)d_in[i];
  p.out = (float*)d_out; p.ws = (char*)d_ws;
  (void)hipMemsetAsync((char*)d_ws + WS_BAR, 0, 256, stream);
  void* args[] = {&p};
  hipError_t e = hipLaunchCooperativeKernel((void*)fwd_megakernel, dim3(grid_blocks), dim3(512), args, LDS_BYTES, stream);
  if (e != hipSuccess) fprintf(stderr, "cooperative launch failed: %s (grid %d)\n", hipGetErrorString(e), grid_blocks);
}
```

```cpp
#include <hip/hip_runtime.h>
#include <hip/hip_cooperative_groups.h>
#include <cstdio>
#include <cstdint>
namespace cg = cooperative_groups;

#define DEVI __device__ __forceinline__
typedef unsigned short u16;
using bf16x8 = __attribute__((ext_vector_type(8))) short;
using f32x16 = __attribute__((ext_vector_type(16))) float;
using u32x4 = __attribute__((ext_vector_type(4))) unsigned;

constexpr int DM = 1024, SEQ = 16384, PAST = 1024, QL = 384, KVL = 256, ROPE = 64, DPOOL = 512, DFF = 4096;
constexpr int DIN = 3264, DIN_PAD = 3328;
constexpr int MP = 2 * SEQ;
constexpr int MS = 32 * 64;
constexpr int M = MP + MS;
constexpr int RALL = M + 256;
constexpr int LKP = 64 + SEQ;
constexpr int LKS = PAST + 64;
constexpr float EPS = 1e-6f;
constexpr float QS = 0.07216878364870322f * 1.4426950408889634f;
constexpr int ZW = 704;

constexpr size_t al256(size_t x) { return (x + 255) / 256 * 256; }
constexpr size_t W_WINT = 0;
constexpr size_t W_WQT  = W_WINT + (size_t)DIN_PAD * 1024 * 2;
constexpr size_t W_WUK  = W_WQT + (size_t)1536 * 384 * 2;
constexpr size_t W_WUVT = W_WUK + (size_t)256 * 1024 * 2;
constexpr size_t W_WABT = W_WUVT + (size_t)1024 * 256 * 2;
constexpr size_t W_WGT  = W_WABT + (size_t)1024 * 1024 * 2;
constexpr size_t W_WPBT = W_WGT + (size_t)4 * 128 * 128 * 2;
constexpr size_t W_WOT  = W_WPBT + (size_t)1024 * 512 * 2;
constexpr size_t W_WUPT = W_WOT + (size_t)1024 * 1024 * 2;
constexpr size_t W_WDT  = W_WUPT + (size_t)4096 * 1024 * 2;
constexpr size_t W_TAB  = W_WDT + (size_t)1024 * 4096 * 2;
constexpr size_t W_XN   = al256(W_TAB + (size_t)16400 * 32 * 8);
constexpr size_t W_KP   = al256(W_XN + (size_t)RALL * 1024 * 2);
constexpr size_t W_VTP  = W_KP + (size_t)2 * LKP * 320 * 2;
constexpr size_t W_COMBT = W_VTP;
constexpr size_t W_WQN  = W_VTP + (size_t)4 * 1024 * 1024;
constexpr size_t W_WUVN = W_VTP + (size_t)6 * 1024 * 1024;
constexpr size_t W_WPT  = W_VTP + (size_t)8 * 1024 * 1024;
constexpr size_t W_KS   = W_VTP + (size_t)2 * 256 * LKP * 2;
constexpr size_t W_VTS  = W_KS + (size_t)32 * LKS * 320 * 2;
constexpr size_t W_X    = al256(W_VTS + (size_t)32 * 256 * LKS * 2);
constexpr size_t X_Z    = W_X;
constexpr size_t X_UP   = X_Z + (size_t)RALL * ZW * 4;
constexpr size_t X_QB   = W_X;
constexpr size_t X_QN_  = W_X + (size_t)190 * 1024 * 1024;
constexpr size_t X_PIN  = X_QN_ + (size_t)M * 384 * 2;
constexpr size_t X_QNOPE= X_PIN + (size_t)M * 512 * 2;
constexpr size_t X_OL   = W_X + (size_t)M * 8 * 320 * 2;
constexpr size_t X_OB   = W_X;
constexpr size_t X_MG   = W_X;
constexpr size_t X_U    = W_X;
constexpr size_t WS_END1 = X_OL + (size_t)M * 2048 * 2;
constexpr size_t WS_END2 = X_QNOPE + (size_t)M * 1024 * 2;
constexpr size_t WS_END3 = X_U + (size_t)M * 4096 * 2;
constexpr size_t WS_LIMIT = (size_t)512 * 1024 * 1024 - 4096;
constexpr size_t WS_BAR = WS_LIMIT;
static_assert(X_UP + (size_t)RALL * 512 * 4 <= X_QN_, "Z/Upool overlap qn");
static_assert(X_QB + (size_t)M * 8 * 320 * 2 <= X_QN_, "Qb overlaps qn");
static_assert(WS_END1 <= WS_LIMIT && WS_END2 <= WS_LIMIT && WS_END3 <= WS_LIMIT, "ws too small");

constexpr size_t O_Y = 0;
constexpr size_t O_KVP = (size_t)M * 1024;
constexpr size_t O_PEP = O_KVP + (size_t)2 * 16400 * 256;
constexpr size_t O_POOLP = O_PEP + (size_t)2 * 16400 * 64;
constexpr size_t O_KVS = O_POOLP + (size_t)2 * 15 * 512;
constexpr size_t O_PES = O_KVS + (size_t)32 * 64 * 256;
constexpr size_t O_POOLS = O_PES + (size_t)32 * 64 * 64;

constexpr int ABUF = 64 * 640 + 256 * 128;
constexpr int LDS_BYTES = 141568;

struct Params {
  const float *x_prompt, *x_sample, *cache_kv, *cache_rope, *cache_pool, *meta, *w_in, *g_mix, *g_q, *g_kv, *w_q_up, *w_uk, *w_uv,
      *w_attn_br, *w_pool_grp, *pool_scale, *w_pool_br, *w_out, *g_ffn, *w_up, *w_down, *g_final;
  float* out; char* ws;
};

DEVI unsigned cvtpk(float lo, float hi) { unsigned r; asm("v_cvt_pk_bf16_f32 %0, %1, %2" : "=v"(r) : "v"(lo), "v"(hi)); return r; }
DEVI u16 tobf(float x) { return (u16)(cvtpk(x, 0.f) & 0xffffu); }
DEVI uint2 pack4(float a, float b, float c, float d) { uint2 o; o.x = cvtpk(a, b); o.y = cvtpk(c, d); return o; }
DEVI int crow(int r, int hi) { return (r & 3) + 8 * (r >> 2) + 4 * hi; }
DEVI float wave_sum(float v) {
#pragma unroll
  for (int o = 32; o; o >>= 1) v += __shfl_xor(v, o, 64);
  return v;
}
DEVI f32x16 mfma(bf16x8 a, bf16x8 b, f32x16 c) { return __builtin_amdgcn_mfma_f32_32x32x16_bf16(a, b, c, 0, 0, 0); }
DEVI int fresh_tid(int ws) { int l; asm volatile("v_mbcnt_lo_u32_b32 %0, -1, 0\n\tv_mbcnt_hi_u32_b32 %0, -1, %0" : "=v"(l)); return ws * 64 + l; }
DEVI void grid_barrier(char* wsbase, unsigned k, int wvs) {
  unsigned* ctr = (unsigned*)(wsbase + ((size_t)512 * 1024 * 1024 - 4096));
  const unsigned target = k * gridDim.x;
  asm volatile("s_waitcnt vmcnt(0)" ::: "memory");
  __syncthreads();
  if (fresh_tid(wvs) == 0) {
    __builtin_amdgcn_fence(__ATOMIC_RELEASE, "agent");
    asm volatile("s_waitcnt vmcnt(0)" ::: "memory");
    __hip_atomic_fetch_add(ctr, 1u, __ATOMIC_RELAXED, __HIP_MEMORY_SCOPE_AGENT);
    while (__hip_atomic_load(ctr, __ATOMIC_RELAXED, __HIP_MEMORY_SCOPE_AGENT) < target) __builtin_amdgcn_s_sleep(1);
    __builtin_amdgcn_fence(__ATOMIC_ACQUIRE, "agent");
    asm volatile("s_waitcnt vmcnt(0)" ::: "memory");
  }
  __syncthreads();
}


DEVI bf16x8 lds_rd128(int a, const int off) { bf16x8 r; asm volatile("ds_read_b128 %0, %1 offset:%2" : "=&v"(r) : "v"(a), "i"(off) : "memory"); return r; }
DEVI void glds16(const void* g, void* l) { __builtin_amdgcn_global_load_lds((const unsigned*)g, (unsigned*)l, 16, 0, 0); }
#define WAIT_VM0() asm volatile("s_waitcnt vmcnt(0)" ::: "memory")

template <int TM, int TN, int WR, int WC, int DEP = (TM + TN > 4 ? 1 : 2)>
DEVI void gemm_main_dma(f32x16 (&acc)[TM][TN], const u16* __restrict__ A, long lda, const u16* __restrict__ Bt, long ldb, int K, char* lds, const int tid,
                    const bool pre = false, const u16* __restrict__ nA = nullptr, const u16* __restrict__ nBt = nullptr) {
  static_assert(WR * WC == 8, "8 waves");
  constexpr int BM = 32 * TM * WR, BN = 32 * TN * WC, NA = BM / 64, NB = BN / 64, BUF = (BM + BN) * 128;
  const int lane = tid & 63, wid = tid >> 6, wr = wid / WC, wc = wid % WC, r32 = lane & 31, hi = lane >> 5;
  const int lrow = tid >> 3, lch = (tid & 7) ^ ((((tid >> 4) & 1) << 2) | ((tid >> 5) & 3));
  const u16* ag = A + (long)lrow * lda + lch * 8;
  const u16* bg = Bt + (long)lrow * ldb + lch * 8;
  char* lw = lds + wid * 1024;
#define G_ISSUE(kt_, buf_) do { \
    _Pragma("unroll") for (int i_ = 0; i_ < NA; ++i_) glds16(ag + (long)(64 * i_) * lda + (kt_) * 64, lw + (buf_) * BUF + i_ * 8192); \
    _Pragma("unroll") for (int i_ = 0; i_ < NB; ++i_) glds16(bg + (long)(64 * i_) * ldb + (kt_) * 64, lw + (buf_) * BUF + (NA + i_) * 8192); } while (0)
  const int fr = ((r32 & 2) << 1) | ((r32 >> 2) & 3);
  int o[4];
#pragma unroll
  for (int j = 0; j < 4; ++j) o[j] = ((2 * j + hi) ^ fr) * 16;
  const int KT = K / 64;
  if (!pre) G_ISSUE(0, 0);
  WAIT_VM0(); __syncthreads();
#pragma unroll 1
  for (int kt = 0; kt < KT; ++kt) {
    if (kt + 1 < KT) G_ISSUE(kt + 1, (kt + 1) & 1);
    const int abase = (int)(uintptr_t)lds + (kt & 1) * BUF + (wr * 32 * TM + r32) * 128;
    const int bbase = (int)(uintptr_t)lds + (kt & 1) * BUF + (BM + wc * 32 * TN + r32) * 128;
    bf16x8 fs[DEP + 1][TM + TN];
#define F_LOAD(set_, ks_) do { const int aa_ = abase + o[ks_], bb_ = bbase + o[ks_]; \
      _Pragma("unroll") for (int m_ = 0; m_ < TM; ++m_) fs[set_][m_] = lds_rd128(aa_, m_ * 4096); \
      _Pragma("unroll") for (int n_ = 0; n_ < TN; ++n_) fs[set_][TM + n_] = lds_rd128(bb_, n_ * 4096); } while (0)
#pragma unroll
    for (int pks = 0; pks < DEP; ++pks) F_LOAD(pks, pks);
#pragma unroll
    for (int ks = 0; ks < 4; ++ks) {
      if (ks + DEP < 4) F_LOAD((ks + DEP) % (DEP + 1), ks + DEP);
      constexpr int NF = TM + TN;
      const int ahead = (4 - 1 - ks) < DEP ? (4 - 1 - ks) : DEP;
      if (ahead == 2) asm volatile("s_waitcnt lgkmcnt(%0)" :: "n"(2 * NF) : "memory");
      else if (ahead == 1) asm volatile("s_waitcnt lgkmcnt(%0)" :: "n"(NF) : "memory");
      else asm volatile("s_waitcnt lgkmcnt(0)" ::: "memory");
      __builtin_amdgcn_sched_barrier(0);
#pragma unroll
      for (int m = 0; m < TM; ++m)
#pragma unroll
        for (int n = 0; n < TN; ++n) acc[m][n] = mfma(fs[ks % (DEP + 1)][m], fs[ks % (DEP + 1)][TM + n], acc[m][n]);
      __builtin_amdgcn_sched_barrier(0);
    }
#undef F_LOAD
    WAIT_VM0(); __syncthreads();
  }
  if (nA != nullptr) {
    const u16* ag2 = nA + (long)lrow * lda + lch * 8;
    const u16* bg2 = nBt + (long)lrow * ldb + lch * 8;
#pragma unroll
    for (int i = 0; i < NA; ++i) glds16(ag2 + (long)(64 * i) * lda, lw + i * 8192);
#pragma unroll
    for (int i = 0; i < NB; ++i) glds16(bg2 + (long)(64 * i) * ldb, lw + (NA + i) * 8192);
  }
#undef G_ISSUE
}
template <int TM, int TN, int WR, int WC, int DEP = (TM + TN > 4 ? 1 : 2)>
DEVI void gemm_main_reg(f32x16 (&acc)[TM][TN], const u16* __restrict__ A, long lda, const u16* __restrict__ Bt, long ldb, int K, char* lds, const int tid,
                    const bool pre = false, const u16* __restrict__ nA = nullptr, const u16* __restrict__ nBt = nullptr) {
  static_assert(WR * WC == 8, "8 waves");
  constexpr int BM = 32 * TM * WR, BN = 32 * TN * WC, NA = BM / 64, NB = BN / 64, BUF = (BM + BN) * 128;
  const int lane = tid & 63, wid = tid >> 6, wr = wid / WC, wc = wid % WC, r32 = lane & 31, hi = lane >> 5;
  const int lrow = tid >> 3, lpos = (tid & 7) ^ ((((tid >> 4) & 1) << 2) | ((tid >> 5) & 3));
  const u16* ag = A + (long)lrow * lda + (tid & 7) * 8;
  const u16* bg = Bt + (long)lrow * ldb + (tid & 7) * 8;
  char* lwr = lds + lrow * 128 + lpos * 16;
  u32x4 r0[NA + NB], r1[NA + NB];
#define G_LOAD(R_, kt_) do { \
    _Pragma("unroll") for (int i_ = 0; i_ < NA; ++i_) R_[i_] = *(const u32x4*)(ag + (long)(64 * i_) * lda + (kt_) * 64); \
    _Pragma("unroll") for (int i_ = 0; i_ < NB; ++i_) R_[NA + i_] = *(const u32x4*)(bg + (long)(64 * i_) * ldb + (kt_) * 64); } while (0)
#define S_WRITE(R_, buf_) do { _Pragma("unroll") for (int i_ = 0; i_ < NA + NB; ++i_) *(u32x4*)(lwr + (buf_) * BUF + i_ * 8192) = R_[i_]; } while (0)
  const int fr = ((r32 & 2) << 1) | ((r32 >> 2) & 3);
  int o[4];
#pragma unroll
  for (int j = 0; j < 4; ++j) o[j] = ((2 * j + hi) ^ fr) * 16;
  const int KT = K / 64;
  (void)pre; (void)nA; (void)nBt;
#define K_TILE(buf_) do { \
    const int abase = (int)(uintptr_t)lds + (buf_) * BUF + (wr * 32 * TM + r32) * 128; \
    const int bbase = (int)(uintptr_t)lds + (buf_) * BUF + (BM + wc * 32 * TN + r32) * 128; \
    bf16x8 fs[DEP + 1][TM + TN]; \
    _Pragma("unroll") for (int pks = 0; pks < DEP; ++pks) { const int aa_ = abase + o[pks], bb_ = bbase + o[pks]; \
      _Pragma("unroll") for (int m_ = 0; m_ < TM; ++m_) fs[pks][m_] = lds_rd128(aa_, m_ * 4096); \
      _Pragma("unroll") for (int n_ = 0; n_ < TN; ++n_) fs[pks][TM + n_] = lds_rd128(bb_, n_ * 4096); } \
    _Pragma("unroll") for (int ks = 0; ks < 4; ++ks) { \
      if (ks + DEP < 4) { const int aa_ = abase + o[(ks + DEP) & 3], bb_ = bbase + o[(ks + DEP) & 3]; \
        _Pragma("unroll") for (int m_ = 0; m_ < TM; ++m_) fs[(ks + DEP) % (DEP + 1)][m_] = lds_rd128(aa_, m_ * 4096); \
        _Pragma("unroll") for (int n_ = 0; n_ < TN; ++n_) fs[(ks + DEP) % (DEP + 1)][TM + n_] = lds_rd128(bb_, n_ * 4096); } \
      const int ahead = (4 - 1 - ks) < DEP ? (4 - 1 - ks) : DEP; \
      if (ahead == 2) asm volatile("s_waitcnt lgkmcnt(%0)" :: "n"(2 * (TM + TN)) : "memory"); \
      else if (ahead == 1) asm volatile("s_waitcnt lgkmcnt(%0)" :: "n"(TM + TN) : "memory"); \
      else asm volatile("s_waitcnt lgkmcnt(0)" ::: "memory"); \
      __builtin_amdgcn_sched_barrier(0); \
      _Pragma("unroll") for (int m = 0; m < TM; ++m) \
        _Pragma("unroll") for (int n = 0; n < TN; ++n) acc[m][n] = mfma(fs[ks % (DEP + 1)][m], fs[ks % (DEP + 1)][TM + n], acc[m][n]); \
      __builtin_amdgcn_sched_barrier(0); \
    } } while (0)
  G_LOAD(r0, 0); S_WRITE(r0, 0); G_LOAD(r1, 1);
  __syncthreads();
#pragma unroll 1
  for (int kt = 0; kt < KT; kt += 2) {
    if (kt + 2 < KT) G_LOAD(r0, kt + 2);
    K_TILE(0);
    S_WRITE(r1, 1);
    __syncthreads();
    if (kt + 3 < KT) G_LOAD(r1, kt + 3);
    K_TILE(1);
    if (kt + 2 < KT) S_WRITE(r0, 0);
    __syncthreads();
  }
#undef K_TILE
#undef G_LOAD
#undef S_WRITE
}
template <int TM, int TN, int WR, int WC, int DEP = (TM + TN > 4 ? 1 : 2)>
DEVI void gemm_main(f32x16 (&acc)[TM][TN], const u16* __restrict__ A, long lda, const u16* __restrict__ Bt, long ldb, int K, char* lds, const int tid,
                    const bool pre = false, const u16* __restrict__ nA = nullptr, const u16* __restrict__ nBt = nullptr) {
  gemm_main_dma<TM, TN, WR, WC, DEP>(acc, A, lda, Bt, ldb, K, lds, tid, pre, nA, nBt);
}
#define TILE_LOOP(tile, NT) \
  for (int it_ = 0, tile = 0; it_ * 8 * (int)(gridDim.x >> 3) < (NT); ++it_) \
    if ((tile = (it_ * 8 + (int)(blockIdx.x & 7)) * (int)(gridDim.x >> 3) + (int)(blockIdx.x >> 3)) < (NT))
template <int TM, int TN> DEVI void zero_acc(f32x16 (&acc)[TM][TN]) {
#pragma unroll
  for (int m = 0; m < TM; ++m)
#pragma unroll
    for (int n = 0; n < TN; ++n)
#pragma unroll
      for (int r = 0; r < 16; ++r) acc[m][n][r] = 0.f;
}

template <int R, bool BF>
DEVI void rms_rows(const float* const (&src)[R], const bool (&ok)[R], const bool (&zero)[R], const float* __restrict__ g, char* const (&dst)[R], const int lane) {
  float4 v[R][4];
#pragma unroll
  for (int k = 0; k < R; ++k)
#pragma unroll
    for (int i = 0; i < 4; ++i) v[k][i] = (ok[k] && !zero[k]) ? *(const float4*)(src[k] + 4 * lane + 256 * i) : make_float4(0, 0, 0, 0);
  float ss[R];
#pragma unroll
  for (int k = 0; k < R; ++k) {
    ss[k] = 0;
#pragma unroll
    for (int i = 0; i < 4; ++i) ss[k] += v[k][i].x * v[k][i].x + v[k][i].y * v[k][i].y + v[k][i].z * v[k][i].z + v[k][i].w * v[k][i].w;
  }
#pragma unroll
  for (int o = 32; o; o >>= 1)
#pragma unroll
    for (int k = 0; k < R; ++k) ss[k] += __shfl_xor(ss[k], o, 64);
#pragma unroll
  for (int i = 0; i < 4; ++i) {
    const float4 gg = *(const float4*)(g + 4 * lane + 256 * i);
#pragma unroll
    for (int k = 0; k < R; ++k) {
      if (!ok[k]) continue;
      const float rs = rsqrtf(ss[k] * (1.f / 1024.f) + EPS);
      const float4 y = make_float4(v[k][i].x * rs * gg.x, v[k][i].y * rs * gg.y, v[k][i].z * rs * gg.z, v[k][i].w * rs * gg.w);
      if (BF) *(uint2*)((u16*)dst[k] + 4 * lane + 256 * i) = pack4(y.x, y.y, y.z, y.w);
      else *(float4*)((float*)dst[k] + 4 * lane + 256 * i) = y;
    }
  }
}

DEVI void phase0(const Params& p, char* lds, const int wvs) {
  const int tid512 = fresh_tid(wvs);
  char* ws = p.ws;
  const int half = tid512 >> 8, tid = tid512 & 255, lane = tid & 63, w = tid >> 6;
  float* T = (float*)lds + half * (64 * 65);
  constexpr int U_T = 3728, U_C = U_T + 512, U_X = U_C + 548, U_R = U_X + 513, U_K = U_R + 256, U_P = U_K + 32;
  for (int it = blockIdx.x; 2 * it < U_P; it += gridDim.x) {
    const int u = 2 * it + half;
    const float* src = nullptr; u16* dst = nullptr; int N = 0, Kd = 0, k0 = 0, n0 = 0; bool isq = false;
    const bool tr = u < U_T;
    if (tr) {
      int t = u;
      if (t < 816) { src = p.w_in; dst = (u16*)(ws + W_WINT); Kd = 1024; N = DIN; }
      else if (t < 960) { t -= 816; src = p.w_q_up; dst = (u16*)(ws + W_WQT); Kd = 384; N = 1536; isq = true; }
      else if (t < 1024) { t -= 960; src = p.w_uv; dst = (u16*)(ws + W_WUVT); Kd = 256; N = 1024; }
      else if (t < 1280) { t -= 1024; src = p.w_attn_br; dst = (u16*)(ws + W_WABT); Kd = 1024; N = 1024; }
      else if (t < 1296) { t -= 1280; const int g = t >> 2; t &= 3; src = p.w_pool_grp + g * 16384; dst = (u16*)(ws + W_WGT) + g * 16384; Kd = 128; N = 128; }
      else if (t < 1424) { t -= 1296; src = p.w_pool_br; dst = (u16*)(ws + W_WPBT); Kd = 512; N = 1024; }
      else if (t < 1680) { t -= 1424; src = p.w_out; dst = (u16*)(ws + W_WOT); Kd = 1024; N = 1024; }
      else if (t < 2704) { t -= 1680; src = p.w_up; dst = (u16*)(ws + W_WUPT); Kd = 1024; N = 4096; }
      else { t -= 2704; src = p.w_down; dst = (u16*)(ws + W_WDT); Kd = 4096; N = 1024; }
      const int nt = N / 64; const int tk = t / nt, tn = t - tk * nt;
      k0 = tk * 64; n0 = tn * 64;
#pragma unroll
      for (int i = 0; i < 16; ++i) { const int k = w + 4 * i; const float v = src[(long)(k0 + k) * N + n0 + lane]; T[k * 65 + lane] = v;
        if (isq) ((u16*)(ws + W_WQN))[(long)(k0 + k) * 1536 + n0 + lane] = tobf(v); }
    }
    __syncthreads();
    if (tr) {
      const int n = tid >> 2, kc = (tid & 3) * 16;
      unsigned pk[8];
#pragma unroll
      for (int j = 0; j < 8; ++j) pk[j] = cvtpk(T[(kc + 2 * j) * 65 + n], T[(kc + 2 * j + 1) * 65 + n]);
      uint4* d = (uint4*)(dst + (long)(n0 + n) * Kd + k0 + kc);
      d[0] = make_uint4(pk[0], pk[1], pk[2], pk[3]); d[1] = make_uint4(pk[4], pk[5], pk[6], pk[7]);
      if (isq && n0 % 192 == 128) {
        uint4* d2 = (uint4*)((u16*)(ws + W_COMBT) + (long)((n0 / 192) * 320 + 256 + (n < 32 ? 2 * n : 2 * (n - 32) + 1)) * 384 + k0 + kc);
        d2[0] = make_uint4(pk[0], pk[1], pk[2], pk[3]); d2[1] = make_uint4(pk[4], pk[5], pk[6], pk[7]);
      }
    } else if (u < U_C) {
      const int c = u - U_T, bd = c >> 4, ct = c & 15;
      u16* Kd2 = (u16*)(ws + W_KS) + ((long)bd * LKS + ct * 64) * 320;
#pragma unroll 4
      for (int i = 0; i < 16; ++i) {
        const int r = w * 16 + i;
        const float4 v = *(const float4*)(p.cache_kv + ((long)(bd * PAST + ct * 64 + r)) * 256 + 4 * lane);
        uint2 o; o.x = cvtpk(v.x, v.y); o.y = cvtpk(v.z, v.w);
        *(uint2*)(Kd2 + r * 320 + 4 * lane) = o;
        const float kr = p.cache_rope[((long)(bd * PAST + ct * 64 + r)) * 64 + lane];
        Kd2[r * 320 + 256 + (lane < 32 ? 2 * lane : 2 * (lane - 32) + 1)] = tobf(kr);
      }
    } else if (u < U_X) {
      const int ru = u - U_C;
      for (int i = 0; i < 16; i += 4) {
        const float* s[4]; char* d[4]; bool ok[4], z[4];
#pragma unroll
        for (int k = 0; k < 4; ++k) {
          const int R = ru * 64 + w * 16 + i + k;
          s[k] = R < MP ? p.x_prompt + (long)R * 1024 : (R < M ? p.x_sample + (long)(R - MP) * 1024 : p.meta + (long)(R - M) * 1024);
          ok[k] = true; z[k] = R >= M + 16; d[k] = (char*)((u16*)(ws + W_XN) + (long)R * 1024);
        }
        rms_rows<4, true>(s, ok, z, p.g_mix, d, lane);
      }
    } else if (u < U_R) {
      const int base = (u - U_X) * 1024;
      for (int i = 0; i < 4; ++i) {
        const int e = base + i * 256 + tid;
        if (e < 16400 * 32) {
          const int pos = e >> 5, j = e & 31;
          const float inv = exp2f(-(float)j * 0.41524101186092029f);
          const double rev = (double)pos * (double)inv * 0.15915494309189535;
          const float fr = (float)(rev - floor(rev));
          float2 cs; cs.x = __builtin_amdgcn_cosf(fr); cs.y = __builtin_amdgcn_sinf(fr);
          ((float2*)(ws + W_TAB))[e] = cs;
        }
      }
    } else if (u < U_K) {
      const int e = ((u - U_R) * 256 + tid) * 4;
      const float4 v = *(const float4*)(p.w_uk + e);
      uint2 o; o.x = cvtpk(v.x, v.y); o.y = cvtpk(v.z, v.w);
      *(uint2*)((u16*)(ws + W_WUK) + e) = o;
      const float4 v2 = *(const float4*)(p.w_uv + e);
      uint2 o2; o2.x = cvtpk(v2.x, v2.y); o2.y = cvtpk(v2.z, v2.w);
      *(uint2*)((u16*)(ws + W_WUVN) + e) = o2;
    } else if (u < U_P) {
      const int e = (u - U_K) * 256 + tid;
      ((uint4*)((u16*)(ws + W_WINT) + (long)DIN * 1024))[e] = make_uint4(0, 0, 0, 0);
    }
    __syncthreads();
  }
}

DEVI char* stage_base(char* lds, int wid) { return lds + 65536 + wid * 8192; }
DEVI void stage_put(char* stg, int row, int col, float v) { *(u16*)(stg + row * 128 + col * 2) = tobf(v); }
DEVI void stage_flush(const char* stg, u16* __restrict__ out, long ld, int lane) {
#pragma unroll
  for (int j = 0; j < 8; ++j) {
    const int q = lane + 64 * j, row = q >> 3, c = q & 7;
    const uint4 v = *(const uint4*)(stg + row * 128 + c * 16);
    *(uint4*)(out + (long)row * ld + c * 8) = v;
  }
}


namespace pg8 {
#define PG8_LAS __attribute__((address_space(3)))
typedef unsigned short bf16_t;
typedef float f32x4 __attribute__((ext_vector_type(4)));
constexpr int BM = 256, BK = 64, HALF = 128, HTB = HALF * BK * 2, STAGE_BYTES = 8 * HTB, NXCD = 8, WGM = 8;
__device__ __forceinline__ int lds_byte(int r, int c) { const int st = (r >> 4) * 2 + (c >> 5), rr = r & 15, cc = c & 31, ob = rr * 64 + cc * 2; return st * 1024 + (ob ^ (((ob >> 9) & 1) << 5)); }
__device__ __forceinline__ void stage_rc(int b, int& R, int& C) { const int st = b / 1024, sb = b % 1024, swz = sb ^ (((sb >> 9) & 1) << 5); R = (st >> 1) * 16 + swz / 64; C = (st & 1) * 32 + (swz % 64) / 2; }
__device__ __forceinline__ int perm32(int rho) { const int n = rho >> 4, i = rho & 15; return 8 * (i >> 2) + 4 * n + (i & 3); }
struct Unit { int pm, pn; };
struct Gemm { const bf16_t* A; const bf16_t* Bt; int M, N, K; };
struct StaticOrder {
    int nM, nN, nwg, G, c;
    __device__ void init(int M, int N, int G_, int c_) { nM = M / BM; nN = N / BM; nwg = nM * nN; G = G_; c = c_; }
    __device__ bool next(int i, Unit& u) const {
        const long L = (long)i * G + c; if (L >= nwg) return false;
        int wgid = (int)L; { const int q = nwg / NXCD, r = nwg % NXCD, xcd = wgid % NXCD, off = wgid / NXCD; wgid = (xcd < r ? xcd * (q + 1) : r * (q + 1) + (xcd - r) * q) + off; }
        const int nig = WGM * nN, gid = wgid / nig, fm = gid * WGM, gsz = (nM - fm) < WGM ? (nM - fm) : WGM;
        u.pm = fm + ((wgid % nig) % gsz); u.pn = (wgid % nig) / gsz; return true;
    }
    __device__ __forceinline__ void a_ready(const Unit&) const {}
    __device__ __forceinline__ void done(const Unit&) const {}
};
template <class Epi, class Sched>
__device__ __forceinline__ void gemm_phase(PG8_LAS unsigned char* lds, const Gemm g, const Sched& S, const Epi& E, const int tid) {
    const int wid = __builtin_amdgcn_readfirstlane(tid >> 6), lane = tid & 63, wr = wid >> 2, wc = wid & 3, fr = lane & 15, fq = lane >> 4;
    const int K = g.K, nt = K / BK;
    unsigned voffA[2], voffB[2];
#pragma unroll
    for (int i = 0; i < 2; ++i) { int R, C; stage_rc(tid * 16 + i * 8192, R, C); const int Rb = Epi::PERM ? ((R & ~31) + perm32(R & 31)) : R;
        voffA[i] = (unsigned)(R * K + C) * 2u; voffB[i] = (unsigned)(Rb * K + C) * 2u; }
    const size_t kstep = (size_t)(BK * 2);
    const size_t hstep = (size_t)HALF * K * 2;
    const size_t tstep = 2 * hstep;
    const unsigned ldsw = (unsigned)wid * 1024u;
    const int aoff = lds_byte(wr * 64 + fr, fq * 8), boff = lds_byte(wc * 32 + fr, fq * 8);
#define PG8_SA(b, h) (((b) * 2 + (h)) * HTB)
#define PG8_SB(b, h) ((4 + (b) * 2 + (h)) * HTB)
#define PG8_STAGE(bufoff, gbase, voff) do { _Pragma("unroll") for (int _i = 0; _i < 2; ++_i) \
        __builtin_amdgcn_global_load_lds((const unsigned*)((const char*)(gbase) + (voff)[_i]), (PG8_LAS unsigned*)(lds + (bufoff) + ldsw + _i * 8192), 16, 0, 0); } while (0)
#define PG8_LDA(dst, b, h) do { _Pragma("unroll") for (int m = 0; m < 4; ++m) _Pragma("unroll") for (int k = 0; k < 2; ++k) dst[m][k] = *(const PG8_LAS bf16x8*)(lds + PG8_SA(b, h) + aoff + m * 2048 + k * 1024); } while (0)
#define PG8_LDB(dst, b, h) do { _Pragma("unroll") for (int n = 0; n < 2; ++n) _Pragma("unroll") for (int k = 0; k < 2; ++k) dst[n][k] = *(const PG8_LAS bf16x8*)(lds + PG8_SB(b, h) + boff + n * 2048 + k * 1024); } while (0)
#define PG8_MMA(ai, bj, At, Bt) do { __builtin_amdgcn_s_setprio(1); _Pragma("unroll") for (int m = 0; m < 4; ++m) _Pragma("unroll") for (int n = 0; n < 2; ++n) _Pragma("unroll") for (int k = 0; k < 2; ++k) \
        acc[ai][bj][m][n] = __builtin_amdgcn_mfma_f32_16x16x32_bf16(Bt[n][k], At[m][k], acc[ai][bj][m][n], 0, 0, 0); __builtin_amdgcn_s_setprio(0); } while (0)
#define PG8_WAIT_V(n) asm volatile("s_waitcnt vmcnt(" #n ")" ::: "memory")
#define PG8_WAIT_L(n) asm volatile("s_waitcnt lgkmcnt(" #n ")" ::: "memory")
#define PG8_BAR __builtin_amdgcn_s_barrier()
#define PG8_SCHED __builtin_amdgcn_sched_barrier(0)
    Unit cur, nxt; int ui = 0;
    if (!S.next(0, cur)) return;
    f32x4 acc[2][2][4][2];
#pragma unroll
    for (int a = 0; a < 2; ++a)
#pragma unroll
        for (int b = 0; b < 2; ++b)
#pragma unroll
            for (int m = 0; m < 4; ++m)
#pragma unroll
                for (int n = 0; n < 2; ++n) acc[a][b][m][n] = (f32x4){0.f, 0.f, 0.f, 0.f};
    bf16x8 At[4][2], B0[2][2], B1[2][2];
    const char* cA = (const char*)g.A + (size_t)cur.pm * tstep; const char* cB = (const char*)g.Bt + (size_t)cur.pn * tstep;
    S.a_ready(cur);
    PG8_STAGE(PG8_SB(0, 0), cB, voffB); PG8_STAGE(PG8_SA(0, 0), cA, voffA); PG8_STAGE(PG8_SB(0, 1), cB + hstep, voffB); PG8_STAGE(PG8_SA(0, 1), cA + hstep, voffA);
    if (wr == 1) PG8_BAR;
    PG8_WAIT_V(4); PG8_BAR;
    PG8_STAGE(PG8_SB(1, 0), cB + kstep, voffB); PG8_STAGE(PG8_SA(1, 0), cA + kstep, voffA); PG8_STAGE(PG8_SB(1, 1), cB + hstep + kstep, voffB);
    PG8_WAIT_V(6); PG8_BAR;
    for (;;) {
        const bool has_next = S.next(ui + 1, nxt);
        const char* nA = has_next ? (const char*)g.A + (size_t)nxt.pm * tstep : cA; const char* nB = has_next ? (const char*)g.Bt + (size_t)nxt.pn * tstep : cB;
        for (int t = 0; t < nt; t += 2) {
            const bool last = (t == nt - 2);
            const char* a1 = cA + (size_t)(t + 1) * kstep;
            const char* a2 = last ? nA : cA + (size_t)(t + 2) * kstep; const char* b2 = last ? nB : cB + (size_t)(t + 2) * kstep;
            const char* a3 = a2 + kstep; const char* b3 = b2 + kstep;
            if (last && has_next) S.a_ready(nxt);
            PG8_LDB(B0, 0, 0); PG8_SCHED; PG8_LDA(At, 0, 0); PG8_STAGE(PG8_SA(1, 1), a1 + hstep, voffA);
            PG8_WAIT_L(8); PG8_BAR; PG8_WAIT_L(0); PG8_MMA(0, 0, At, B0); PG8_BAR; PG8_SCHED;
            PG8_LDB(B1, 0, 1); PG8_STAGE(PG8_SB(0, 0), b2, voffB);
            PG8_BAR; PG8_WAIT_L(0); PG8_MMA(0, 1, At, B1); PG8_BAR;
            PG8_LDA(At, 0, 1); PG8_STAGE(PG8_SA(0, 0), a2, voffA);
            PG8_BAR; PG8_WAIT_L(0); PG8_MMA(1, 0, At, B0); PG8_BAR; PG8_SCHED;
            PG8_STAGE(PG8_SB(0, 1), b2 + hstep, voffB);
            PG8_WAIT_V(6); PG8_BAR; PG8_MMA(1, 1, At, B1); PG8_BAR;
            PG8_LDB(B0, 1, 0); PG8_SCHED; PG8_LDA(At, 1, 0); PG8_STAGE(PG8_SA(0, 1), a2 + hstep, voffA);
            PG8_WAIT_L(8); PG8_BAR; PG8_WAIT_L(0); PG8_MMA(0, 0, At, B0); PG8_BAR; PG8_SCHED;
            PG8_LDB(B1, 1, 1); PG8_STAGE(PG8_SB(1, 0), b3, voffB);
            PG8_BAR; PG8_WAIT_L(0); PG8_MMA(0, 1, At, B1); PG8_BAR;
            PG8_LDA(At, 1, 1); PG8_STAGE(PG8_SA(1, 0), a3, voffA);
            PG8_BAR; PG8_WAIT_L(0); PG8_MMA(1, 0, At, B0); PG8_BAR; PG8_SCHED;
            PG8_STAGE(PG8_SB(1, 1), b3 + hstep, voffB);
            PG8_WAIT_V(6); PG8_BAR; PG8_MMA(1, 1, At, B1); PG8_BAR;
        }
            if constexpr (!Epi::AFTER_DRAIN) { E(acc, cur, wr, wc, fr, fq); S.done(cur); }
            if (!has_next) break;
#pragma unroll
        for (int a = 0; a < 2; ++a)
#pragma unroll
            for (int b = 0; b < 2; ++b)
#pragma unroll
                for (int m = 0; m < 4; ++m)
#pragma unroll
                    for (int n = 0; n < 2; ++n) acc[a][b][m][n] = (f32x4){0.f, 0.f, 0.f, 0.f};
        cur = nxt; cA = nA; cB = nB; ++ui;
    }
    PG8_WAIT_V(0);
    if (wr == 0) PG8_BAR;
    PG8_BAR;
    if constexpr (Epi::AFTER_DRAIN) { E.fused(acc, cur, wr, wc, fr, fq, lds, wid, lane); S.done(cur); }
#undef PG8_SA
#undef PG8_SB
#undef PG8_STAGE
#undef PG8_LDA
#undef PG8_LDB
#undef PG8_MMA
#undef PG8_WAIT_V
#undef PG8_WAIT_L
#undef PG8_BAR
#undef PG8_SCHED
}
}

#define PG8_ROW(u, ai, m) ((u).pm * 256 + (ai) * 128 + wr * 64 + (m) * 16 + fr)
#define PG8_COL8(u, bj) ((u).pn * 256 + (bj) * 128 + wc * 32 + 8 * fq)
struct EpiP1 {
  static constexpr bool PERM = true, AFTER_DRAIN = false;
  float* Z; float* UP; u16* G;
  __device__ __forceinline__ void operator()(const pg8::f32x4 (&acc)[2][2][4][2], const pg8::Unit& u, int wr, int wc, int fr, int fq) const {
#pragma unroll
    for (int bj = 0; bj < 2; ++bj) {
      const int c8 = PG8_COL8(u, bj), grp = u.pn * 256 + bj * 128 + wc * 32;
#pragma unroll
      for (int ai = 0; ai < 2; ++ai)
#pragma unroll
        for (int m = 0; m < 4; ++m) {
          const long row = PG8_ROW(u, ai, m);
          if (grp < ZW) { *(pg8::f32x4*)(Z + row * ZW + c8) = acc[ai][bj][m][0]; *(pg8::f32x4*)(Z + row * ZW + c8 + 4) = acc[ai][bj][m][1]; }
          else if (grp < ZW + DPOOL) { *(pg8::f32x4*)(UP + row * 512 + c8 - ZW) = acc[ai][bj][m][0]; *(pg8::f32x4*)(UP + row * 512 + c8 - ZW + 4) = acc[ai][bj][m][1]; }
          else if (grp < DIN && row < M) {
            float s[8];
#pragma unroll
            for (int j = 0; j < 4; ++j) { s[j] = 1.f / (1.f + __expf(-acc[ai][bj][m][0][j])); s[4 + j] = 1.f / (1.f + __expf(-acc[ai][bj][m][1][j])); }
            u32x4 w = {cvtpk(s[0], s[1]), cvtpk(s[2], s[3]), cvtpk(s[4], s[5]), cvtpk(s[6], s[7])};
            *(u32x4*)(G + row * 2048 + c8 - (ZW + DPOOL)) = w;
          }
        }
    }
  }
};
struct EpiP8 {
  static constexpr bool PERM = true, AFTER_DRAIN = false;
  float* Y; const float* xp; const float* xs;
  __device__ __forceinline__ void operator()(const pg8::f32x4 (&acc)[2][2][4][2], const pg8::Unit& u, int wr, int wc, int fr, int fq) const {
#pragma unroll
    for (int ai = 0; ai < 2; ++ai)
#pragma unroll
      for (int m = 0; m < 4; ++m) {
        const long row = PG8_ROW(u, ai, m);
        const float* xr = row < MP ? xp + row * 1024 : xs + (row - MP) * 1024;
#pragma unroll
        for (int bj = 0; bj < 2; ++bj) {
          const int c8 = PG8_COL8(u, bj);
          const pg8::f32x4 x0 = *(const pg8::f32x4*)(xr + c8), x1 = *(const pg8::f32x4*)(xr + c8 + 4);
          *(pg8::f32x4*)(Y + row * 1024 + c8) = x0 + acc[ai][bj][m][0]; *(pg8::f32x4*)(Y + row * 1024 + c8 + 4) = x1 + acc[ai][bj][m][1];
        }
      }
  }
};
struct EpiP10 {
  static constexpr bool PERM = true, AFTER_DRAIN = false;
  u16* U;
  __device__ __forceinline__ void operator()(const pg8::f32x4 (&acc)[2][2][4][2], const pg8::Unit& u, int wr, int wc, int fr, int fq) const {
#pragma unroll
    for (int ai = 0; ai < 2; ++ai)
#pragma unroll
      for (int m = 0; m < 4; ++m) {
        const long row = PG8_ROW(u, ai, m);
#pragma unroll
        for (int bj = 0; bj < 2; ++bj) {
          float v[8];
#pragma unroll
          for (int j = 0; j < 4; ++j) { const float a = fmaxf(acc[ai][bj][m][0][j], 0.f), b = fmaxf(acc[ai][bj][m][1][j], 0.f); v[j] = a * a; v[4 + j] = b * b; }
          u32x4 w = {cvtpk(v[0], v[1]), cvtpk(v[2], v[3]), cvtpk(v[4], v[5]), cvtpk(v[6], v[7])};
          *(u32x4*)(U + row * 4096 + PG8_COL8(u, bj)) = w;
        }
      }
  }
};
struct EpiP11 {
  static constexpr bool PERM = true, AFTER_DRAIN = false;
  float* Y;
  __device__ __forceinline__ void operator()(const pg8::f32x4 (&acc)[2][2][4][2], const pg8::Unit& u, int wr, int wc, int fr, int fq) const {
#pragma unroll
    for (int ai = 0; ai < 2; ++ai)
#pragma unroll
      for (int m = 0; m < 4; ++m) {
        const long row = PG8_ROW(u, ai, m);
#pragma unroll
        for (int bj = 0; bj < 2; ++bj) {
          float* y = Y + row * 1024 + PG8_COL8(u, bj);
          const pg8::f32x4 h0 = *(const pg8::f32x4*)y, h1 = *(const pg8::f32x4*)(y + 4);
          *(pg8::f32x4*)y = h0 + acc[ai][bj][m][0]; *(pg8::f32x4*)(y + 4) = h1 + acc[ai][bj][m][1];
        }
      }
  }
};
template <class Epi>
DEVI void run_pg8(char* lds, const u16* A, const u16* Bt, int Mr, int Nc, int K, const Epi& E, const int tid) {
  pg8::StaticOrder S; S.init(Mr, Nc, (int)gridDim.x, (int)blockIdx.x);
  pg8::Gemm g; g.A = A; g.Bt = Bt; g.M = Mr; g.N = Nc; g.K = K;
  pg8::gemm_phase<Epi, pg8::StaticOrder>((PG8_LAS unsigned char*)lds, g, S, E, tid);
}

DEVI void phase1(const Params& p, char* lds, const int wvs) {
  const int tid = fresh_tid(wvs);
  char* ws = p.ws;
  EpiP1 E; E.Z = (float*)(ws + X_Z); E.UP = (float*)(ws + X_UP); E.G = (u16*)p.out;
  run_pg8(lds, (const u16*)(ws + W_XN), (const u16*)(ws + W_WINT), RALL, DIN_PAD, 1024, E, tid);
}

DEVI void phase2w(const Params& p, char* lds, const int wvs) {
  const int tid = fresh_tid(wvs);
  char* ws = p.ws;
  const int lane = tid & 63;
  for (int ct = blockIdx.x; ct < 24; ct += gridDim.x) {
    const int h = ct / 3, t3 = ct - 3 * h, wid = tid >> 6, wr = wid >> 1, wc = wid & 1, r32 = lane & 31, hi = lane >> 5;
    f32x16 acc[2][2]; zero_acc(acc);
    gemm_main<2, 2, 4, 2>(acc, (const u16*)(ws + W_WUK) + h * 128, 1024, (const u16*)(ws + W_WQN) + (long)(t3 * 128) * 1536 + h * 192, 1536, 128, lds, tid);
    char* stg = stage_base(lds, wid);
#pragma unroll
    for (int m = 0; m < 2; ++m)
#pragma unroll
      for (int n = 0; n < 2; ++n)
#pragma unroll
        for (int r = 0; r < 16; ++r) stage_put(stg, 32 * m + crow(r, hi), 32 * n + r32, acc[m][n][r]);
    stage_flush(stg, (u16*)(ws + W_COMBT) + (long)(h * 320 + wr * 64) * 384 + t3 * 128 + wc * 64, 384, lane);
    __syncthreads();
  }
  for (int ct = (int)blockIdx.x - 24; ct < 64; ct += gridDim.x) {
    if (ct < 0) continue;
    const int h = ct >> 3, jt = (ct >> 1) & 3, cn = ct & 1, wid = tid >> 6, wr = wid >> 1, wc = wid & 1, r32 = lane & 31, hi = lane >> 5;
    f32x16 acc[2][2]; zero_acc(acc);
    gemm_main<2, 2, 4, 2>(acc, (const u16*)(ws + W_WABT) + (long)(jt * 256) * 1024 + h * 128, 1024, (const u16*)(ws + W_WUVN) + (long)(cn * 128) * 1024 + h * 128, 1024, 128, lds, tid);
    char* stg = stage_base(lds, wid);
#pragma unroll
    for (int m = 0; m < 2; ++m)
#pragma unroll
      for (int n = 0; n < 2; ++n)
#pragma unroll
        for (int r = 0; r < 16; ++r) stage_put(stg, 32 * m + crow(r, hi), 32 * n + r32, acc[m][n][r]);
    stage_flush(stg, (u16*)(ws + W_WPT) + (long)(jt * 256 + wr * 64) * 2048 + h * 256 + cn * 128 + wc * 64, 2048, lane);
    __syncthreads();
  }
}
DEVI void phase2(const Params& p, char* lds, const int wvs) {
  const int tid = fresh_tid(wvs);
  char* ws = p.ws;
  const int lane = tid & 63, w = tid >> 6;
  const float* Z = (const float*)(ws + X_Z); const float* UP = (const float*)(ws + X_UP);
  const float2* TAB = (const float2*)(ws + W_TAB);
  for (int u = blockIdx.x; u < 546; u += gridDim.x) {
    int zrow0, pos0, keybase, b = 0; long ldvt; u16 *Kd, *VT; float *okv, *ope, *opool = nullptr; bool meta = false, sample = false;
    if (u < 512) {
      b = u >> 8; const int ft = u & 255;
      zrow0 = b * SEQ + ft * 64; pos0 = 16 + ft * 64; keybase = 64 + ft * 64; ldvt = LKP;
      Kd = (u16*)(ws + W_KP) + ((long)b * LKP + keybase) * 320; VT = (u16*)(ws + W_VTP) + (long)b * 256 * LKP;
      okv = p.out + O_KVP + ((long)b * 16400 + pos0) * 256; ope = p.out + O_PEP + ((long)b * 16400 + pos0) * 64;
      if (ft == 255) opool = p.out + O_POOLP + (long)b * 15 * 512;
    } else if (u < 544) {
      b = u - 512; sample = true;
      zrow0 = MP + b * 64; pos0 = PAST; keybase = PAST; ldvt = LKS;
      Kd = (u16*)(ws + W_KS) + ((long)b * LKS + keybase) * 320; VT = (u16*)(ws + W_VTS) + (long)b * 256 * LKS;
      okv = p.out + O_KVS + (long)b * 64 * 256; ope = p.out + O_PES + (long)b * 64 * 64;
      opool = p.out + O_POOLS + (long)b * 15 * 512;
    } else {
      b = u - 544; meta = true;
      zrow0 = M; pos0 = 0; keybase = 0; ldvt = LKP;
      Kd = (u16*)(ws + W_KP) + (long)b * LKP * 320; VT = (u16*)(ws + W_VTP) + (long)b * 256 * LKP;
      okv = p.out + O_KVP + (long)b * 16400 * 256; ope = p.out + O_PEP + (long)b * 16400 * 64;
    }
    const int w0 = lane < 32 ? 2 : 4, w1 = lane < 32 ? 8 : 16;
    auto urow = [&](int e) -> const float* {
      if (!sample) return e < 16 ? UP + (long)(M + e) * 512 : UP + (long)(b * SEQ + e - 16) * 512;
      return e < 15 ? p.cache_pool + ((long)b * 15 + e) * 512 : UP + (long)(MP + b * 64 + e - 15) * 512;
    };
    float4 S0 = make_float4(0, 0, 0, 0), S1 = S0;
    const int e0 = sample ? 15 + w * 8 : 16 + (zrow0 - b * SEQ) + w * 8;
    if (!meta) {
      for (int k = 1; k <= 16; ++k) {
        const int e = e0 - k;
        if (e >= 0) {
          const float* ur = urow(e);
          if (k <= w0) { const float4 v = *(const float4*)(ur + 4 * lane); S0.x += v.x; S0.y += v.y; S0.z += v.z; S0.w += v.w; }
          if (k <= w1) { const float4 v = *(const float4*)(ur + 256 + 4 * lane); S1.x += v.x; S1.y += v.y; S1.z += v.z; S1.w += v.w; }
        }
      }
    }
    for (int i = 0; i < 8; ++i) {
      const int r = w * 8 + i;
      const bool valid = !meta || r < 16;
      const long zrow = zrow0 + r;
      float4 x = valid ? *(const float4*)(Z + zrow * ZW + QL + 4 * lane) : make_float4(0, 0, 0, 0);
      float ss = wave_sum(x.x * x.x + x.y * x.y + x.z * x.z + x.w * x.w);
      float rs = rsqrtf(ss * (1.f / 256.f) + EPS);
      const float4 gk = *(const float4*)(p.g_kv + 4 * lane);
      float4 c = make_float4(x.x * rs * gk.x, x.y * rs * gk.y, x.z * rs * gk.z, x.w * rs * gk.w);
      uint2 cb; cb.x = cvtpk(c.x, c.y); cb.y = cvtpk(c.z, c.w);
      *(uint2*)(Kd + r * 320 + 4 * lane) = cb;
      if (valid) *(float4*)(okv + (long)r * 256 + 4 * lane) = c;
      if (lane < 32) {
        float o1 = 0.f, o2 = 0.f;
        if (valid) {
          const float x1 = Z[zrow * ZW + 640 + lane], x2 = Z[zrow * ZW + 672 + lane];
          const float2 cs = TAB[(pos0 + r) * 32 + lane];
          o1 = x1 * cs.x - x2 * cs.y; o2 = x1 * cs.y + x2 * cs.x;
          ope[(long)r * 64 + lane] = o1; ope[(long)r * 64 + 32 + lane] = o2;
        }
        *(unsigned*)(Kd + r * 320 + 256 + 2 * lane) = cvtpk(o1, o2);
      }
      if (!meta) {
        float2 q[3];
#pragma unroll
        for (int j = 0; j < 3; ++j) q[j] = *(const float2*)(Z + zrow * ZW + 2 * lane + 128 * j);
        float qs = 0;
#pragma unroll
        for (int j = 0; j < 3; ++j) qs += q[j].x * q[j].x + q[j].y * q[j].y;
        qs = wave_sum(qs);
        const float qr = rsqrtf(qs * (1.f / 384.f) + EPS);
#pragma unroll
        for (int j = 0; j < 3; ++j) {
          const float2 gq = *(const float2*)(p.g_q + 2 * lane + 128 * j);
          *(unsigned*)((u16*)(ws + X_QN_) + zrow * 384 + 2 * lane + 128 * j) = cvtpk(q[j].x * qr * gq.x, q[j].y * qr * gq.y);
        }
        const int e = e0 + i;
        const float* ur = urow(e);
        const float4 u0 = *(const float4*)(ur + 4 * lane), u1 = *(const float4*)(ur + 256 + 4 * lane);
        float4 d0 = make_float4(0, 0, 0, 0), d1 = d0;
        if (e - w0 >= 0) d0 = *(const float4*)(urow(e - w0) + 4 * lane);
        if (e - w1 >= 0) d1 = *(const float4*)(urow(e - w1) + 256 + 4 * lane);
        S0.x += u0.x - d0.x; S0.y += u0.y - d0.y; S0.z += u0.z - d0.z; S0.w += u0.w - d0.w;
        S1.x += u1.x - d1.x; S1.y += u1.y - d1.y; S1.z += u1.z - d1.z; S1.w += u1.w - d1.w;
        const float i0 = 1.f / (float)w0, i1 = 1.f / (float)w1;
        uint2 pa, pb;
        pa.x = cvtpk(S0.x * i0 - u0.x, S0.y * i0 - u0.y); pa.y = cvtpk(S0.z * i0 - u0.z, S0.w * i0 - u0.w);
        pb.x = cvtpk(S1.x * i1 - u1.x, S1.y * i1 - u1.y); pb.y = cvtpk(S1.z * i1 - u1.z, S1.w * i1 - u1.w);
        *(uint2*)((u16*)(ws + X_PIN) + zrow * 512 + 4 * lane) = pa;
        *(uint2*)((u16*)(ws + X_PIN) + zrow * 512 + 256 + 4 * lane) = pb;
        if (opool != nullptr && r >= 49) {
          *(float4*)(opool + (long)(r - 49) * 512 + 4 * lane) = u0;
          *(float4*)(opool + (long)(r - 49) * 512 + 256 + 4 * lane) = u1;
        }
      }
    }
  }
}

DEVI int row_pos(int row) { return row < MP ? 16 + (row & (SEQ - 1)) : PAST + ((row - MP) & 63); }

DEVI void phase3(const Params& p, char* lds, const int wvs) {
  const int tid = fresh_tid(wvs);
  char* ws = p.ws;
  const int lane = tid & 63, wid = tid >> 6, wr = wid >> 1, wc = wid & 1, r32 = lane & 31, hi = lane >> 5;
  TILE_LOOP(t, (M / 256) * 4) {
    const int tm = t >> 2, g = t & 3;
    f32x16 acc[2][2]; zero_acc(acc);
    gemm_main<2, 2, 4, 2>(acc, (const u16*)(ws + X_PIN) + (long)tm * 256 * 512 + g * 128, 512, (const u16*)(ws + W_WGT) + g * 16384, 128, 128, lds, tid);
    char* stg = stage_base(lds, wid);
#pragma unroll
    for (int m = 0; m < 2; ++m)
#pragma unroll
      for (int n = 0; n < 2; ++n) {
        const float sc = p.pool_scale[g * 128 + wc * 64 + n * 32 + r32];
#pragma unroll
        for (int r = 0; r < 16; ++r) stage_put(stg, 32 * m + crow(r, hi), 32 * n + r32, acc[m][n][r] * sc);
      }
    stage_flush(stg, (u16*)(ws + W_XN) + (long)(tm * 256 + wr * 64) * 512 + g * 128 + wc * 64, 512, lane);
  }
}

struct EpiQ {
  static constexpr bool PERM = true, AFTER_DRAIN = false;
  u16* QB; const float2* TAB;
  __device__ __forceinline__ void operator()(const pg8::f32x4 (&acc)[2][2][4][2], const pg8::Unit& u, int wr, int wc, int fr_, int fq_) const {
    const int l_ = fresh_tid(0), fr = l_ & 15, fq = l_ >> 4;
    (void)fr_; (void)fq_;
#pragma unroll
    for (int bj = 0; bj < 2; ++bj) {
      const int c8 = PG8_COL8(u, bj), grp = u.pn * 256 + bj * 128 + wc * 32, head = grp / 320, hcol = grp - head * 320;
#pragma unroll
      for (int ai = 0; ai < 2; ++ai)
#pragma unroll
        for (int m = 0; m < 4; ++m) {
          const int row = PG8_ROW(u, ai, m);
          const pg8::f32x4 v0 = acc[ai][bj][m][0], v1 = acc[ai][bj][m][1];
          u32x4 w;
          if (hcol < 256) {
            w = (u32x4){cvtpk(v0[0] * QS, v0[1] * QS), cvtpk(v0[2] * QS, v0[3] * QS), cvtpk(v1[0] * QS, v1[1] * QS), cvtpk(v1[2] * QS, v1[3] * QS)};
          } else {
            const float2* tp = TAB + row_pos(row) * 32 + ((c8 - head * 320 - 256) >> 1);
#pragma unroll
            for (int i = 0; i < 4; ++i) {
              const float2 cs = tp[i];
              const float x1 = i < 2 ? v0[2 * i] : v1[2 * i - 4], x2 = i < 2 ? v0[2 * i + 1] : v1[2 * i - 3];
              w[i] = cvtpk((x1 * cs.x - x2 * cs.y) * QS, (x1 * cs.y + x2 * cs.x) * QS);
              __builtin_amdgcn_sched_barrier(0);
            }
          }
          *(u32x4*)(QB + (long)row * 2560 + c8) = w;
          __builtin_amdgcn_sched_barrier(0);
        }
    }
  }
};
DEVI void phase3q(const Params& p, char* lds, const int wvs) {
  const int tid = fresh_tid(wvs);
  char* ws = p.ws;
  __syncthreads();
  EpiQ E; E.QB = (u16*)(ws + X_QB); E.TAB = (const float2*)(ws + W_TAB);
  run_pg8(lds, (const u16*)(ws + X_QN_), (const u16*)(ws + W_COMBT), M, 2560, 384, E, tid);
}

using s16x4 = __attribute__((ext_vector_type(4))) short;
template <int OFF> DEVI s16x4 tr_read(int a) { s16x4 r; asm volatile("ds_read_b64_tr_b16 %0, %1 offset:%2" : "=&v"(r) : "v"(a), "i"(OFF) : "memory"); return r; }
struct TrSet { s16x4 lo[2], hi[2]; };
template <int D0> DEVI void tr_load2(TrSet& s, int a0, int a1) {
  constexpr int B = (D0 >> 1) * 8192;
  s.lo[0] = tr_read<B + 0 * 2048>(a0);        s.hi[0] = tr_read<B + 0 * 2048 + 1024>(a1);
  s.lo[1] = tr_read<B + 1 * 2048>(a0);        s.hi[1] = tr_read<B + 1 * 2048 + 1024>(a1);
}
DEVI bf16x8 pk8(s16x4 l, s16x4 h) { return (bf16x8){l[0], l[1], l[2], l[3], h[0], h[1], h[2], h[3]}; }
DEVI void pv2(f32x16& o, const TrSet& s, const bf16x8 (&pf)[2]) {
#pragma unroll
  for (int f = 0; f < 2; ++f) o = mfma(pk8(s.lo[f], s.hi[f]), pf[f], o);
}
#define WAIT_LGKM(n) asm volatile("s_waitcnt lgkmcnt(" #n ")" ::: "memory")
#define SBAR() __builtin_amdgcn_sched_barrier(0)
constexpr int KBUF = 40960;

constexpr int XP_OFF = 3 * KBUF;
constexpr int XM_OFF = XP_OFF + 8 * 2048;
constexpr int XF_OFF = XM_OFF + 8 * 256;
constexpr int ATT_LDS = XF_OFF + 64;
DEVI void raw_barrier() { asm volatile("s_waitcnt lgkmcnt(0)" ::: "memory"); __builtin_amdgcn_s_barrier(); asm volatile("" ::: "memory"); }

DEVI bool attn_job(int& seq, const bool preset, const float mref, const u16* __restrict__ Q0, const u16* __restrict__ Kt, int ntiles, bool maskfirst, u16* __restrict__ O0, char* lds, const int tid_in) {
  int tid = tid_in; asm volatile("" : "+v"(tid));
  const int lane = tid & 63, w = tid >> 6, r32 = lane & 31, hi = lane >> 5;
  const int pr = w >> 1, u = w & 1;
  const int h = 2 * pr + (r32 >> 4), qi = r32 & 15;
  const u16* qp = Q0 + ((long)qi * 8 + h) * 320 + hi * 8;
  bf16x8 qf[20];
#pragma unroll
  for (int ks = 0; ks < 20; ++ks) qf[ks] = *(const bf16x8*)(qp + ks * 16);
  f32x16 O[4];
#pragma unroll
  for (int d = 0; d < 4; ++d)
#pragma unroll
    for (int r = 0; r < 16; ++r) O[d][r] = 0.f;
  float mrun = mref, lrun = 0.f;
  const int fch = (tid & 7) ^ ((((tid >> 4) & 1) << 2) | ((tid >> 5) & 3));
  const u16* ksrc = Kt + (long)(tid >> 3) * 320 + fch * 8;
  char* lw = lds + w * 1024;
#define A_ISSUE(t_, buf_) do { _Pragma("unroll") for (int i_ = 0; i_ < 5; ++i_) glds16(ksrc + (long)(t_) * 64 * 320 + i_ * 64, lw + (buf_) * KBUF + i_ * 8192); } while (0)
  const int fr = ((r32 & 2) << 1) | ((r32 >> 2) & 3);
  const int frh = (fr ^ hi) * 16;
  const int kk = (lane & 15) >> 2, vh = (lane >> 4) & 1, cl = (lane & 3) >> 1;
  int tb[2][2];
#pragma unroll
  for (int dd = 0; dd < 2; ++dd)
#pragma unroll
    for (int hf = 0; hf < 2; ++hf)
      tb[dd][hf] = (int)(uintptr_t)lds + u * 16384 + (kk + 4 * hi) * 128 + ((((dd ^ (kk >> 1)) << 2) | ((2 * vh + cl) ^ (2 * hf + hi))) * 16) + (lane & 1) * 8;
#define xp_own (lds + XP_OFF + w * 2048 + lane * 32)
#define xp_oth (lds + XP_OFF + (w ^ 1) * 2048 + lane * 32)
#define xm_own ((float*)(lds + XM_OFF) + w * 64 + lane)
#define xm_oth ((const float*)(lds + XM_OFF) + (w ^ 1) * 64 + lane)
  A_ISSUE(0, 0);
  if (ntiles > 1) { A_ISSUE(1, 1); asm volatile("s_waitcnt vmcnt(5)" ::: "memory"); } else { WAIT_VM0(); }
  raw_barrier();
  int cbuf = 0;
#pragma unroll 1
  for (int t = 0; t < ntiles; ++t) {
    const bool more = t + 2 < ntiles;
    const int nbuf = cbuf == 0 ? 2 : cbuf - 1;
    if (more) A_ISSUE(t + 2, nbuf);
    const char* kb = lds + cbuf * KBUF;
    const char* ka = kb + (32 * u + r32) * 128;
    f32x16 s;
#pragma unroll
    for (int r = 0; r < 16; ++r) s[r] = 0.f;
    {
      const int kaddr = (int)(uintptr_t)ka;
      int kad[4];
#pragma unroll
      for (int j = 0; j < 4; ++j) kad[j] = kaddr + ((j * 32) ^ frh);
      bf16x8 fk[4];
#pragma unroll
      for (int ks = 0; ks < 3; ++ks) fk[ks] = lds_rd128(kad[ks & 3], (ks >> 2) * 8192);
#pragma unroll
      for (int ks = 0; ks < 20; ++ks) {
        if (ks + 3 < 20) fk[(ks + 3) & 3] = lds_rd128(kad[(ks + 3) & 3], ((ks + 3) >> 2) * 8192);
        const int ahead = (19 - ks) < 3 ? (19 - ks) : 3;
        if (ahead == 3) WAIT_LGKM(3); else if (ahead == 2) WAIT_LGKM(2); else if (ahead == 1) WAIT_LGKM(1); else WAIT_LGKM(0);
        SBAR();
        s = mfma(fk[ks & 3], qf[ks], s);
        SBAR();
      }
    }
    if (maskfirst && t == 0) {
#pragma unroll
      for (int r = 0; r < 16; ++r) { if (32 * u + crow(r, hi) >= 16) s[r] = -1e30f; }
    }
    if (t == 0 && !preset) {
      float mx = s[0];
#pragma unroll
      for (int r = 1; r < 16; ++r) mx = fmaxf(mx, s[r]);
      mx = fmaxf(mx, __shfl_xor(mx, 32, 64));
      *xm_own = mx;
      raw_barrier();
      mrun = fmaxf(mx, *xm_oth);
    }
    float ps = 0.f;
#pragma unroll
    for (int r = 0; r < 16; ++r) { s[r] = __builtin_amdgcn_exp2f(s[r] - mrun); ps += s[r]; }
    lrun += ps;
    u32x4 own0 = {cvtpk(s[0], s[1]), cvtpk(s[2], s[3]), cvtpk(s[4], s[5]), cvtpk(s[6], s[7])};
    u32x4 own1 = {cvtpk(s[8], s[9]), cvtpk(s[10], s[11]), cvtpk(s[12], s[13]), cvtpk(s[14], s[15])};
    *(u32x4*)xp_own = own0; *(u32x4*)(xp_own + 16) = own1;
    ++seq;
    asm volatile("s_waitcnt lgkmcnt(0)" ::: "memory");
    if (lane == 0) *(volatile int*)(lds + XF_OFF + w * 4) = seq;
    bf16x8 pf[2] = {__builtin_bit_cast(bf16x8, own0), __builtin_bit_cast(bf16x8, own1)};
    const int bo = cbuf * KBUF;
    {
      const int e0 = tb[0][0] + bo + u * 4096, e1 = tb[0][1] + bo + u * 4096, o0 = tb[1][0] + bo + u * 4096, o1 = tb[1][1] + bo + u * 4096;
      TrSet A;
      SBAR();
      tr_load2<0>(A, e0, e1); WAIT_LGKM(0); SBAR(); pv2(O[0], A, pf); SBAR();
      tr_load2<1>(A, o0, o1); WAIT_LGKM(0); SBAR(); pv2(O[1], A, pf); SBAR();
      tr_load2<2>(A, e0, e1); WAIT_LGKM(0); SBAR(); pv2(O[2], A, pf); SBAR();
      tr_load2<3>(A, o0, o1); WAIT_LGKM(0); SBAR(); pv2(O[3], A, pf); SBAR();
    }
    {
      const int faddr = (int)(uintptr_t)lds + XF_OFF + (w ^ 1) * 4;
      for (int spin = 0; spin < (1 << 22); ++spin) {
        int v; asm volatile("ds_read_b32 %0, %1\n\ts_waitcnt lgkmcnt(0)" : "=v"(v) : "v"(faddr) : "memory");
        if (__builtin_amdgcn_readfirstlane(v) - seq >= 0) break;
        __builtin_amdgcn_s_sleep(1);
      }
    }
    {
      const u32x4 oth0 = *(const u32x4*)xp_oth, oth1 = *(const u32x4*)(xp_oth + 16);
      bf16x8 pg[2] = {__builtin_bit_cast(bf16x8, oth0), __builtin_bit_cast(bf16x8, oth1)};
      const int uo = (u ^ 1) * 4096;
      const int e0 = tb[0][0] + bo + uo, e1 = tb[0][1] + bo + uo, o0 = tb[1][0] + bo + uo, o1 = tb[1][1] + bo + uo;
      TrSet A;
      asm volatile("s_waitcnt lgkmcnt(0)" ::: "memory");
      SBAR();
      tr_load2<0>(A, e0, e1); WAIT_LGKM(0); SBAR(); pv2(O[0], A, pg); SBAR();
      tr_load2<1>(A, o0, o1); WAIT_LGKM(0); SBAR(); pv2(O[1], A, pg); SBAR();
      tr_load2<2>(A, e0, e1); WAIT_LGKM(0); SBAR(); pv2(O[2], A, pg); SBAR();
      tr_load2<3>(A, o0, o1); WAIT_LGKM(0); SBAR(); pv2(O[3], A, pg); SBAR();
    }
    if (more) asm volatile("s_waitcnt vmcnt(5)" ::: "memory"); else WAIT_VM0();
    raw_barrier();
    cbuf = cbuf == 2 ? 0 : cbuf + 1;
  }
#undef A_ISSUE
  {
    const int badw = __any(!(lrun < 1.1805916e21f)) ? 1 : 0;
    volatile int* bf = (volatile int*)(lds + XF_OFF + 32);
    if (lane == 0) bf[w] = badw;
    __syncthreads();
    const int anyb = bf[0] | bf[1] | bf[2] | bf[3] | bf[4] | bf[5] | bf[6] | bf[7];
    __syncthreads();
    if (anyb) return true;
  }
  float lsum = lrun + __shfl_xor(lrun, 32, 64);
  *xm_own = lsum;
  __syncthreads();
  const float inv = 1.f / (lsum + *xm_oth);
  __syncthreads();
  u16* op = O0 + ((long)qi * 8 + h) * 256 + 128 * u + 4 * hi;
#pragma unroll
  for (int d = 0; d < 4; ++d)
#pragma unroll
    for (int g = 0; g < 4; ++g) {
      uint2 ov; ov.x = cvtpk(O[d][4 * g] * inv, O[d][4 * g + 1] * inv); ov.y = cvtpk(O[d][4 * g + 2] * inv, O[d][4 * g + 3] * inv);
      *(uint2*)(op + d * 32 + g * 8) = ov;
    }
  return false;
#undef xp_own
#undef xp_oth
#undef xm_own
#undef xm_oth
}

DEVI float attn_maxpass(const u16* __restrict__ Q0, const u16* __restrict__ Kt, int ntiles, bool maskfirst, char* lds, const int tid_in) {
  int tid = tid_in; asm volatile("" : "+v"(tid));
  const int lane = tid & 63, w = tid >> 6, r32 = lane & 31, hi = lane >> 5;
  const int h = 2 * (w >> 1) + (r32 >> 4), qi = r32 & 15;
  const u16* qp = Q0 + ((long)qi * 8 + h) * 320 + hi * 8;
  const int fch = (tid & 7) ^ ((((tid >> 4) & 1) << 2) | ((tid >> 5) & 3));
  const u16* ksrc = Kt + (long)(tid >> 3) * 320 + fch * 8;
  char* lw = lds + w * 1024;
  const int fr = ((r32 & 2) << 1) | ((r32 >> 2) & 3);
  float mrun = -1e30f;
#pragma unroll 1
  for (int t = 0; t < ntiles; ++t) {
#pragma unroll
    for (int i = 0; i < 5; ++i) glds16(ksrc + (long)t * 64 * 320 + i * 64, lw + i * 8192);
    WAIT_VM0(); __syncthreads();
    f32x16 s0, s1;
#pragma unroll
    for (int r = 0; r < 16; ++r) { s0[r] = 0.f; s1[r] = 0.f; }
    const char* ka = lds + r32 * 128;
#pragma unroll 2
    for (int ks = 0; ks < 20; ++ks) {
      const bf16x8 q = *(const bf16x8*)(qp + ks * 16);
      const int off = (ks >> 2) * 8192 + ((2 * (ks & 3) + hi) ^ fr) * 16;
      s0 = mfma(*(const bf16x8*)(ka + off), q, s0);
      s1 = mfma(*(const bf16x8*)(ka + 32 * 128 + off), q, s1);
    }
    if (maskfirst && t == 0) {
#pragma unroll
      for (int r = 0; r < 16; ++r) { if (crow(r, hi) >= 16) s0[r] = -1e30f; s1[r] = -1e30f; }
    }
#pragma unroll
    for (int r = 0; r < 16; ++r) mrun = fmaxf(mrun, fmaxf(s0[r], s1[r]));
    __syncthreads();
  }
  return fmaxf(mrun, __shfl_xor(mrun, 32, 64));
}

static_assert(ATT_LDS <= LDS_BYTES && 2 * 512 * 128 <= LDS_BYTES, "LDS");
DEVI void phase5(const Params& p, char* lds, const int wvs) {
  const int tid = fresh_tid(wvs);
  char* ws = p.ws;
  const u16* QB = (const u16*)(ws + X_QB); u16* OL = (u16*)(ws + X_OL);
  if (tid < 8) *(volatile int*)(lds + XF_OFF + tid * 4) = 0;
  __syncthreads();
  int seq = 0;
  const int ngrp = gridDim.x >> 2;
  const int xcd = blockIdx.x & 7, idx = blockIdx.x >> 3;
  const int grp = xcd + 8 * (idx >> 2), j = idx & 3;
  const int nsamp = blockIdx.x < 128 ? (int)((128 - blockIdx.x + gridDim.x - 1) / gridDim.x) : 0;
  for (int jj = -nsamp;; ++jj) {
    long qrow0; const u16* Kt; int nt; bool mask;
    if (jj < 0) {
      const int sit = (int)blockIdx.x + (jj + nsamp) * (int)gridDim.x;
      const int bd = sit >> 2, js = sit & 3;
      qrow0 = MP + bd * 64 + js * 16; Kt = (const u16*)(ws + W_KS) + (long)bd * LKS * 320; nt = 17; mask = false;
    } else {
      const int k = jj * ngrp + ((jj & 1) ? ngrp - 1 - grp : grp);
      if (k >= 512) break;
      const int c = 255 - (k >> 1), b = k & 1;
      qrow0 = (long)b * SEQ + c * 64 + j * 16; Kt = (const u16*)(ws + W_KP) + (long)b * LKP * 320; nt = c + 2; mask = true;
    }
    bool preset = false; float mref = -1e30f;
    while (true) {
      const bool bad = attn_job(seq, preset, mref, QB + qrow0 * 8 * 320, Kt, nt, mask, OL + qrow0 * 2048, lds, tid);
      if (!bad || preset) break;
      mref = attn_maxpass(QB + qrow0 * 8 * 320, Kt, nt, mask, lds, tid);
      preset = true;
    }
  }
}


DEVI void phase7(const Params& p, char* lds, const int wvs) {
  const int tid = fresh_tid(wvs);
  char* ws = p.ws;
  const int lane = tid & 63, wid = tid >> 6, wr = wid >> 1, wc = wid & 1, r32 = lane & 31, hi = lane >> 5;
  const u16* G = (const u16*)p.out; u16* MG = (u16*)(ws + X_MG);
  TILE_LOOP(tile, (MP / 256) * 8) {
    const int tm = tile >> 3, tn = tile & 7;
    f32x16 acc[2][2], acp[2][2]; zero_acc(acc); zero_acc(acp);
    gemm_main<2, 2, 4, 2, 1>(acc, (const u16*)(ws + X_OL) + (long)tm * 256 * 2048, 2048, (const u16*)(ws + W_WPT) + (long)tn * 128 * 2048, 2048, 2048, lds, tid);
    gemm_main<2, 2, 4, 2, 1>(acp, (const u16*)(ws + W_XN) + (long)tm * 256 * 512, 512, (const u16*)(ws + W_WPBT) + (long)tn * 128 * 512, 512, 512, lds, tid);
    char* stg = stage_base(lds, wid);
#pragma unroll
    for (int m = 0; m < 2; ++m)
#pragma unroll
      for (int n = 0; n < 2; ++n) {
        const int brow = tm * 256 + wr * 64 + m * 32, col = tn * 128 + wc * 64 + n * 32 + r32;
#pragma unroll
        for (int r = 0; r < 16; ++r) {
          const long row = brow + crow(r, hi);
          const float ga = __uint_as_float((unsigned)G[row * 2048 + col] << 16), gp = __uint_as_float((unsigned)G[row * 2048 + 1024 + col] << 16);
          stage_put(stg, 32 * m + crow(r, hi), 32 * n + r32, ga * acc[m][n][r] + gp * acp[m][n][r]);
        }
        SBAR();
      }
    stage_flush(stg, MG + (long)(tm * 256 + wr * 64) * 1024 + tn * 128 + wc * 64, 1024, lane);
  }
}
DEVI void phase7s(const Params& p, char* lds, const int wvs) {
  const int tid = fresh_tid(wvs);
  char* ws = p.ws;
  const int lane = tid & 63, wid = tid >> 6, r32 = lane & 31, hi = lane >> 5, wr4 = wid >> 2, wc4 = wid & 3;
  const u16* G = (const u16*)p.out; u16* MG = (u16*)(ws + X_MG);
  TILE_LOOP(tile, 256) {
    const int tm = tile >> 3, tn = tile & 7;
    f32x16 acc[1][1], acp[1][1]; zero_acc(acc); zero_acc(acp);
    gemm_main_reg<1, 1, 2, 4, 2>(acc, (const u16*)(ws + X_OL) + (long)(MP + tm * 64) * 2048, 2048, (const u16*)(ws + W_WPT) + (long)tn * 128 * 2048, 2048, 2048, lds, tid);
    gemm_main_reg<1, 1, 2, 4, 2>(acp, (const u16*)(ws + W_XN) + (long)(MP + tm * 64) * 512, 512, (const u16*)(ws + W_WPBT) + (long)tn * 128 * 512, 512, 512, lds, tid);
    const int col = tn * 128 + wc4 * 32 + r32;
#pragma unroll
    for (int r = 0; r < 16; ++r) {
      const long row = MP + tm * 64 + wr4 * 32 + crow(r, hi);
      const float ga = __uint_as_float((unsigned)G[row * 2048 + col] << 16), gp = __uint_as_float((unsigned)G[row * 2048 + 1024 + col] << 16);
      MG[row * 1024 + col] = tobf(ga * acc[0][0][r] + gp * acp[0][0][r]);
    }
  }
}

DEVI void phase8(const Params& p, char* lds, const int wvs) {
  const int tid = fresh_tid(wvs);
  char* ws = p.ws;
  {
    const int lane = tid & 63, wid = tid >> 6, wr = wid >> 2, wc = wid & 3, r32 = lane & 31, hi = lane >> 5;
    TILE_LOOP(tile, 256) {
      const int tm = tile >> 3, tn = tile & 7;
      f32x16 acc[1][1]; zero_acc(acc);
      gemm_main_reg<1, 1, 2, 4, 2>(acc, (const u16*)(ws + X_MG) + (long)(MP + tm * 64) * 1024, 1024, (const u16*)(ws + W_WOT) + (long)tn * 128 * 1024, 1024, 1024, lds, tid);
      const int col = tn * 128 + wc * 32 + r32;
#pragma unroll
      for (int r = 0; r < 16; ++r) {
        const long srow = tm * 64 + wr * 32 + crow(r, hi);
        p.out[(MP + srow) * 1024 + col] = p.x_sample[srow * 1024 + col] + acc[0][0][r];
      }
    }
  }
  EpiP8 E; E.Y = p.out; E.xp = p.x_prompt; E.xs = p.x_sample;
  run_pg8(lds, (const u16*)(ws + X_MG), (const u16*)(ws + W_WOT), MP, 1024, 1024, E, tid);
}

DEVI void phase9(const Params& p, const int wvs) {
  const int tid = fresh_tid(wvs);
  const int lane = tid & 63, w = tid >> 6;
  for (int r0 = blockIdx.x * 32 + w; r0 < M; r0 += gridDim.x * 32) {
    const float* s[4]; char* d[4]; bool ok[4], z[4];
#pragma unroll
    for (int k = 0; k < 4; ++k) { const int row = r0 + 8 * k; ok[k] = row < M; z[k] = false; s[k] = p.out + (long)row * 1024; d[k] = (char*)((u16*)(p.ws + W_XN) + (long)row * 1024); }
    rms_rows<4, true>(s, ok, z, p.g_ffn, d, lane);
  }
}
DEVI void phase12(const Params& p, const int wvs) {
  const int tid = fresh_tid(wvs);
  const int lane = tid & 63, w = tid >> 6;
  for (int r0 = blockIdx.x * 32 + w; r0 < M; r0 += gridDim.x * 32) {
    const float* s[4]; char* d[4]; bool ok[4], z[4];
#pragma unroll
    for (int k = 0; k < 4; ++k) { const int row = r0 + 8 * k; ok[k] = row < M; z[k] = false; s[k] = p.out + (long)row * 1024; d[k] = (char*)(p.out + (long)row * 1024); }
    rms_rows<4, false>(s, ok, z, p.g_final, d, lane);
  }
}

DEVI void phase10(const Params& p, char* lds, const int wvs) {
  const int tid = fresh_tid(wvs);
  char* ws = p.ws;
  EpiP10 E; E.U = (u16*)(ws + X_U);
  run_pg8(lds, (const u16*)(ws + W_XN), (const u16*)(ws + W_WUPT), M, 4096, 1024, E, tid);
}

DEVI void phase11(const Params& p, char* lds, const int wvs) {
  const int tid = fresh_tid(wvs);
  char* ws = p.ws;
  {
    const int lane = tid & 63, wid = tid >> 6, wr = wid >> 2, wc = wid & 3, r32 = lane & 31, hi = lane >> 5;
    TILE_LOOP(tile, 256) {
      const int tm = tile >> 3, tn = tile & 7;
      f32x16 acc[1][1]; zero_acc(acc);
      gemm_main_reg<1, 1, 2, 4, 2>(acc, (const u16*)(ws + X_U) + (long)(MP + tm * 64) * 4096, 4096, (const u16*)(ws + W_WDT) + (long)tn * 128 * 4096, 4096, 4096, lds, tid);
      const int col = tn * 128 + wc * 32 + r32;
#pragma unroll
      for (int r = 0; r < 16; ++r) { float* y = p.out + (long)(MP + tm * 64 + wr * 32 + crow(r, hi)) * 1024 + col; *y = *y + acc[0][0][r]; }
    }
  }
  EpiP11 E; E.Y = p.out;
  run_pg8(lds, (const u16*)(ws + X_U), (const u16*)(ws + W_WDT), MP, 1024, 4096, E, tid);
}

__global__ void __launch_bounds__(512) fwd_megakernel(Params p) {
  extern __shared__ __attribute__((aligned(16))) char lds[];
  const int wvs = __builtin_amdgcn_readfirstlane(threadIdx.x >> 6);
  phase0(p, lds, wvs);  cg::this_grid().sync();
  phase1(p, lds, wvs);  grid_barrier(p.ws, 1, wvs);
  phase2w(p, lds, wvs); phase2(p, lds, wvs);  grid_barrier(p.ws, 2, wvs);
  phase3(p, lds, wvs);  phase3q(p, lds, wvs);  grid_barrier(p.ws, 3, wvs);
  phase5(p, lds, wvs);  grid_barrier(p.ws, 4, wvs);
  phase7(p, lds, wvs);  phase7s(p, lds, wvs);  grid_barrier(p.ws, 5, wvs);
  phase8(p, lds, wvs);  grid_barrier(p.ws, 6, wvs);
  phase9(p, wvs);       grid_barrier(p.ws, 7, wvs);
  phase10(p, lds, wvs); grid_barrier(p.ws, 8, wvs);
  phase11(p, lds, wvs); grid_barrier(p.ws, 9, wvs);
  phase12(p, wvs);
}

extern "C" void kernel_launch(void* const* d_in, const int* in_sizes, int n_in, void* d_out, int out_size, void* d_ws, size_t ws_size, hipStream_t stream) {
  static int grid_blocks = 0;
  if (!grid_blocks) {
    if (ws_size < WS_LIMIT + 4096) { fprintf(stderr, "kernel_launch: ws too small: %zu\n", ws_size); return; }
    if (hipFuncSetAttribute((const void*)fwd_megakernel, hipFuncAttributeMaxDynamicSharedMemorySize, LDS_BYTES) != hipSuccess) {
      fprintf(stderr, "kernel_launch: hipFuncSetAttribute failed\n"); return; }
    int dev = 0, cus = 0, per_cu = 0;
    hipGetDevice(&dev);
    hipDeviceGetAttribute(&cus, hipDeviceAttributeMultiprocessorCount, dev);
    hipOccupancyMaxActiveBlocksPerMultiprocessor(&per_cu, fwd_megakernel, 512, LDS_BYTES);
    if (per_cu < 1) { fprintf(stderr, "kernel_launch: occupancy 0\n"); return; }
    grid_blocks = cus - cus % 32;
    if (grid_blocks < 32) { fprintf(stderr, "kernel_launch: too few CUs\n"); grid_blocks = 0; return; }
  }
  Params p{};
  const float** f = (const float**)&p;
  for (int i = 0; i < 22; ++i) f[i] = (const float*)d_in[i];
  p.out = (float*)d_out; p.ws = (char*)d_ws;
  (void)hipMemsetAsync((char*)d_ws + WS_BAR, 0, 256, stream);
  void* args[] = {&p};
  hipError_t e = hipLaunchCooperativeKernel((void*)fwd_megakernel, dim3(grid_blocks), dim3(512), args, LDS_BYTES, stream);
  if (e != hipSuccess) fprintf(stderr, "cooperative launch failed: %s (grid %d)\n", hipGetErrorString(e), grid_blocks);
}
```
